# Optimizing an MI355X kernel written in HIP

```python
import math
import jax, jax.numpy as jnp
from jax import lax
import numpy as np

D_MODEL = 1024
BATCH = 8
SEQ = 4096
DEPTH = 2

ATTN_HEADS = 8
HEAD_DIM = 64
ATTN_WIDTH = ATTN_HEADS * HEAD_DIM
Q_BLOCK = 128
POOL_WINDOWS = (2, 4, 8, 16)
POOL_GROUPS = len(POOL_WINDOWS)
POOL_WIDTH = D_MODEL - ATTN_WIDTH
POOL_GROUP_DIM = POOL_WIDTH // POOL_GROUPS
IN_WIDTH = 3 * ATTN_WIDTH + ATTN_HEADS + POOL_WIDTH
N_EXPERT_GROUPS = 4
EXPERTS_PER_GROUP = 8
TOP_K_EXPERT = 2
D_EXPERT = 256
N_MOD = 6
EPS = 1e-6
NEG_INF = -1e30
FGATE_BIAS_INIT = 3.0

kernel_name = "hybrid_fox_pool_hmoe_adaln"


def rmsnorm(x, g):
    xf = x.astype(jnp.float32)
    y = xf * lax.rsqrt(jnp.mean(xf * xf, axis=-1, keepdims=True) + EPS)
    return (y * g.astype(jnp.float32)).astype(x.dtype)


def modulate(h, shift, scale):
    return h * (1.0 + scale[:, None, :]) + shift[:, None, :]


def forgetting_attention(q, k, v, log_f):
    B, S, H, dh = q.shape
    nb = S // Q_BLOCK
    qh = q.transpose(0, 2, 1, 3)
    kh = k.transpose(0, 2, 1, 3)
    vh = v.transpose(0, 2, 1, 3)
    F = jnp.cumsum(log_f, axis=1).transpose(0, 2, 1)
    q_blocks = qh.reshape(B, H, nb, Q_BLOCK, dh).transpose(2, 0, 1, 3, 4)
    fq_blocks = F.reshape(B, H, nb, Q_BLOCK).transpose(2, 0, 1, 3)
    starts = jnp.arange(nb, dtype=jnp.int32) * Q_BLOCK
    key_pos = jnp.arange(S, dtype=jnp.int32)
    scale = 1.0 / math.sqrt(dh)

    def one_block(args):
        qb, fqb, start = args
        s = jnp.einsum('bhqd,bhkd->bhqk', qb, kh).astype(jnp.float32) * scale
        s = s + fqb[..., None] - F[:, :, None, :]
        qpos = start + jnp.arange(Q_BLOCK, dtype=jnp.int32)
        causal = key_pos[None, :] <= qpos[:, None]
        s = jnp.where(causal[None, None], s, NEG_INF)
        p = jax.nn.softmax(s, axis=-1).astype(vh.dtype)
        return jnp.einsum('bhqk,bhkd->bhqd', p, vh)

    out = lax.map(one_block, (q_blocks, fq_blocks, starts))
    return out.transpose(1, 0, 3, 2, 4).reshape(B, S, H * dh)


def trailing_mean(cs, w):
    S = cs.shape[1]
    prev = jnp.pad(cs[:, :S - w], ((0, 0), (w, 0), (0, 0)))
    cnt = jnp.minimum(jnp.arange(1, S + 1), w).astype(jnp.float32)
    return (cs - prev) / cnt[None, :, None]


def multiscale_pool(u, w_pool, pool_scale):
    B, S, _ = u.shape
    ug = u.reshape(B, S, POOL_GROUPS, POOL_GROUP_DIM)
    cs = jnp.cumsum(ug.astype(jnp.float32), axis=1)
    pooled = jnp.stack(
        [trailing_mean(cs[:, :, g, :], w) for g, w in enumerate(POOL_WINDOWS)], axis=2)
    diff = (pooled - ug.astype(jnp.float32)).astype(u.dtype)
    mixed = jnp.einsum('bsgc,gcd->bsgd', diff, w_pool)
    return mixed.reshape(B, S, POOL_WIDTH) * pool_scale


def hierarchical_moe(h, w_rg, b_rg, w_re, b_re, w_gate, w_up, w_down):
    lg = jnp.matmul(h, w_rg).astype(jnp.float32) + b_rg
    pg = jax.nn.softmax(lg, axis=-1)
    top_p, top_g = lax.top_k(pg, 1)
    le = jnp.einsum('td,gde->tge', h, w_re).astype(jnp.float32) + b_re
    le_sel = jnp.take_along_axis(le, top_g[:, :, None], axis=1)[:, 0]
    ev, ei = lax.top_k(le_sel, TOP_K_EXPERT)
    ew = jax.nn.softmax(ev, axis=-1)
    e_comb = jnp.sum(jax.nn.one_hot(ei, EXPERTS_PER_GROUP, dtype=jnp.float32) * ew[..., None], axis=1)
    g_comb = jax.nn.one_hot(top_g[:, 0], N_EXPERT_GROUPS, dtype=jnp.float32) * top_p
    comb = (g_comb[:, :, None] * e_comb[:, None, :]).astype(h.dtype)
    y = jnp.zeros_like(h)
    for g in range(N_EXPERT_GROUPS):
        a = jnp.einsum('td,edf->tef', h, w_gate[g])
        b = jnp.einsum('td,edf->tef', h, w_up[g])
        act = jax.nn.silu(a) * b * comb[:, g, :, None]
        y = y + jnp.einsum('tef,efd->td', act, w_down[g])
    return y


def setup_inputs(seed: int = 0) -> dict:
    key = jax.random.key(seed)
    ks = jax.random.split(key, 20)
    f32 = jnp.float32
    D, L = D_MODEL, DEPTH
    G, E, F = N_EXPERT_GROUPS, EXPERTS_PER_GROUP, D_EXPERT

    def nrm(k, shape, scale):
        return jax.random.normal(k, shape, f32) * scale

    return {
        "x": nrm(ks[0], (BATCH, SEQ, D), 1.0),
        "c": nrm(ks[1], (BATCH, D), 1.0),
        "norm_mix_g": 1.0 + nrm(ks[2], (L, D), 0.02),
        "norm_ffn_g": 1.0 + nrm(ks[3], (L, D), 0.02),
        "norm_final_g": 1.0 + nrm(ks[4], (D,), 0.02),
        "w_ada": nrm(ks[5], (L, D, N_MOD * D), 0.5 * D ** -0.5),
        "b_ada": nrm(ks[6], (L, N_MOD * D), 0.02),
        "w_in": nrm(ks[7], (L, D, IN_WIDTH), D ** -0.5),
        "b_fgate": FGATE_BIAS_INIT + nrm(ks[8], (L, ATTN_HEADS), 0.1),
        "w_pool": nrm(ks[9], (L, POOL_GROUPS, POOL_GROUP_DIM, POOL_GROUP_DIM), POOL_GROUP_DIM ** -0.5),
        "pool_scale": 1.0 + nrm(ks[10], (L, POOL_WIDTH), 0.1),
        "w_out": nrm(ks[11], (L, D, D), D ** -0.5),
        "w_router_group": nrm(ks[12], (L, D, G), D ** -0.5),
        "b_router_group": nrm(ks[13], (L, G), 0.01),
        "w_router_expert": nrm(ks[14], (L, G, D, E), D ** -0.5),
        "b_router_expert": nrm(ks[15], (L, G, E), 0.01),
        "w_expert_gate": nrm(ks[16], (L, G, E, D, F), D ** -0.5),
        "w_expert_up": nrm(ks[17], (L, G, E, D, F), D ** -0.5),
        "w_expert_down": nrm(ks[18], (L, G, E, F, D), F ** -0.5),
    }


def reference(x, c, norm_mix_g, norm_ffn_g, norm_final_g, w_ada, b_ada, w_in, b_fgate,
              w_pool, pool_scale, w_out, w_router_group, b_router_group, w_router_expert,
              b_router_expert, w_expert_gate, w_expert_up, w_expert_down):
    B, S, D = x.shape
    split_pts = [ATTN_WIDTH, 2 * ATTN_WIDTH, 3 * ATTN_WIDTH, 3 * ATTN_WIDTH + ATTN_HEADS]
    c_act = jax.nn.silu(c)
    for l in range(DEPTH):
        mod = jnp.matmul(c_act, w_ada[l]) + b_ada[l]
        sh_m, sc_m, gt_m, sh_f, sc_f, gt_f = jnp.split(mod, N_MOD, axis=-1)

        h = modulate(rmsnorm(x, norm_mix_g[l]), sh_m, sc_m)
        proj = jnp.matmul(h, w_in[l])
        q, k, v, f_logit, u = jnp.split(proj, split_pts, axis=-1)
        q = q.reshape(B, S, ATTN_HEADS, HEAD_DIM)
        k = k.reshape(B, S, ATTN_HEADS, HEAD_DIM)
        v = v.reshape(B, S, ATTN_HEADS, HEAD_DIM)
        log_f = jax.nn.log_sigmoid(f_logit.astype(jnp.float32) + b_fgate[l].astype(jnp.float32))
        attn_out = forgetting_attention(q, k, v, log_f)
        pool_out = multiscale_pool(u, w_pool[l], pool_scale[l])
        mix = jnp.matmul(jnp.concatenate([attn_out, pool_out.astype(attn_out.dtype)], axis=-1), w_out[l])
        x = x + gt_m[:, None, :] * mix

        h = modulate(rmsnorm(x, norm_ffn_g[l]), sh_f, sc_f)
        ffn = hierarchical_moe(h.reshape(B * S, D), w_router_group[l], b_router_group[l],
                               w_router_expert[l], b_router_expert[l], w_expert_gate[l],
                               w_expert_up[l], w_expert_down[l])
        x = x + gt_f[:, None, :] * ffn.reshape(B, S, D)
    return rmsnorm(x, norm_final_g)
```

```cpp
#include <hip/hip_runtime.h>
#include <hip/hip_bf16.h>
#include <cstdio>
#include <cstdint>
#include <cmath>

namespace pg8 {
#define PG8_LAS __attribute__((address_space(3)))
typedef unsigned short bf16_t;
typedef short bf16x8 __attribute__((ext_vector_type(8)));
typedef float f32x4 __attribute__((ext_vector_type(4)));
typedef unsigned u32x4 __attribute__((ext_vector_type(4)));
constexpr int BM = 256, BK = 64, HALF = 128, HTB = HALF * BK * 2  , STAGE_BYTES = 8 * HTB, NXCD = 8, WGM = 8;

__host__ __device__ __forceinline__ int lds_byte(int r, int c) { const int st = (r >> 4) * 2 + (c >> 5), rr = r & 15, cc = c & 31, ob = rr * 64 + cc * 2; return st * 1024 + (ob ^ (((ob >> 9) & 1) << 5)); }
__host__ __device__ __forceinline__ void stage_rc(int b, int& R, int& C) { const int st = b / 1024, sb = b % 1024, swz = sb ^ (((sb >> 9) & 1) << 5); R = (st >> 1) * 16 + swz / 64; C = (st & 1) * 32 + (swz % 64) / 2; }
__host__ __device__ __forceinline__ int perm32(int rho) { const int n = rho >> 4, i = rho & 15; return 8 * (i >> 2) + 4 * n + (i & 3); }

struct Unit { int pm, pn; };
struct Gemm { const bf16_t* A; const bf16_t* Bt; int M, N, K; };

struct StaticOrder {
    int nM, nN, nwg, G, c;
    __host__ __device__ void init(int M, int N, int G_, int c_) { nM = M / BM; nN = N / BM; nwg = nM * nN; G = G_; c = c_; }
    __host__ __device__ bool next(int i, Unit& u) const {
        const long L = (long)i * G + c; if (L >= nwg) return false;
        int wgid = (int)L; { const int q = nwg / NXCD, r = nwg % NXCD, xcd = wgid % NXCD, off = wgid / NXCD; wgid = (xcd < r ? xcd * (q + 1) : r * (q + 1) + (xcd - r) * q) + off; }
        const int nig = WGM * nN, gid = wgid / nig, fm = gid * WGM, gsz = (nM - fm) < WGM ? (nM - fm) : WGM;
        u.pm = fm + ((wgid % nig) % gsz); u.pn = (wgid % nig) / gsz; return true;
    }
    __device__ __forceinline__ void a_ready(const Unit&) const {}
    __device__ __forceinline__ void done(const Unit&) const {}
};

__device__ __forceinline__ unsigned cvt_pk_bf16(float lo, float hi) { unsigned r; asm volatile("v_cvt_pk_bf16_f32 %0, %1, %2" : "=v"(r) : "v"(lo), "v"(hi)); return r; }
typedef float f32x2 __attribute__((ext_vector_type(2)));

struct EpiQKVU {
    static constexpr bool PERM = true, AFTER_DRAIN = false;
    bf16_t* O; int ldc; int split_cols; size_t split_stride; float scale0;
    __device__ __forceinline__ void operator()(const f32x4 (&acc)[2][2][4][2], const Unit& u, int wr, int wc, int fr, int fq) const {
        const int row0 = u.pm * BM + wr * 64 + fr; int colt = u.pn * BM; bf16_t* base = O;
        float sc = 1.f; { const int t = colt / split_cols; base += (size_t)t * split_stride; colt -= t * split_cols; if (t == 0) sc = scale0; }
        const int col0 = colt + wc * 32 + 8 * fq;
#pragma unroll
        for (int ai = 0; ai < 2; ++ai)
#pragma unroll
            for (int m = 0; m < 4; ++m) { bf16_t* rowp = base + (size_t)(row0 + ai * HALF + m * 16) * ldc + col0;
#pragma unroll
                for (int bj = 0; bj < 2; ++bj) { const f32x4 v0 = acc[ai][bj][m][0] * sc, v1 = acc[ai][bj][m][1] * sc;
                    u32x4 w; w.x = cvt_pk_bf16(v0[0], v0[1]); w.y = cvt_pk_bf16(v0[2], v0[3]); w.z = cvt_pk_bf16(v1[0], v1[1]); w.w = cvt_pk_bf16(v1[2], v1[3]);
                    *(u32x4*)(rowp + bj * HALF) = w; } }
    }
};
struct EpiResGate {
    static constexpr bool PERM = false, AFTER_DRAIN = false;
    const float* base; float* out; const float* gate; int gstride;
    __device__ __forceinline__ void operator()(const f32x4 (&acc)[2][2][4][2], const Unit& u, int wr, int wc, int fr, int fq) const {
        const int row0 = u.pm * BM + wr * 64 + fr, col0 = u.pn * BM + wc * 32 + 4 * fq; const int b = (u.pm * BM) >> 12;
        f32x4 gv[2][2];
#pragma unroll
        for (int bj = 0; bj < 2; ++bj)
#pragma unroll
            for (int n = 0; n < 2; ++n) gv[bj][n] = *(const f32x4*)(gate + (size_t)b * gstride + col0 + bj * HALF + n * 16);
#pragma unroll
        for (int ai = 0; ai < 2; ++ai)
#pragma unroll
            for (int m = 0; m < 4; ++m) { const size_t off = (size_t)(row0 + ai * HALF + m * 16) * 1024 + col0;
#pragma unroll
                for (int bj = 0; bj < 2; ++bj)
#pragma unroll
                    for (int n = 0; n < 2; ++n) { const f32x4 bs = *(const f32x4*)(base + off + bj * HALF + n * 16); *(f32x4*)(out + off + bj * HALF + n * 16) = bs + gv[bj][n] * acc[ai][bj][m][n]; } }
    }
};

template <class Epi, class Sched, bool ALIGN_EPI = false, bool SP2 = false>
__device__ __forceinline__ void gemm_phase(PG8_LAS unsigned char* lds, const Gemm g, const Sched& S, const Epi& E) {
    int tid_ = threadIdx.x; asm volatile("" : "+v"(tid_));
    const int tid = tid_, wid = __builtin_amdgcn_readfirstlane(tid >> 6), lane = tid & 63, wr = wid >> 2, wc = wid & 3, fr = lane & 15, fq = lane >> 4;
    const int K = g.K, nt = K / BK;
    unsigned voffA[2], voffB[2];
#pragma unroll
    for (int i = 0; i < 2; ++i) { int R, C; stage_rc(tid * 16 + i * 8192, R, C); const int Rb = Epi::PERM ? ((R & ~31) + perm32(R & 31)) : R;
        voffA[i] = (unsigned)(R * K + C) * 2u; voffB[i] = (unsigned)(Rb * K + C) * 2u; }
    const size_t kstep = (size_t)(BK * 2);
    const size_t hstep = (size_t)HALF * K * 2;
    const size_t tstep = 2 * hstep;
    const unsigned ldsw = (unsigned)wid * 1024u;
    const int aoff = lds_byte(wr * 64 + fr, fq * 8), boff = lds_byte(wc * 32 + fr, fq * 8);
#define PG8_SA(b, h) (((b) * 2 + (h)) * HTB)
#define PG8_SB(b, h) ((4 + (b) * 2 + (h)) * HTB)
#define PG8_STAGE(bufoff, gbase, voff) do { _Pragma("unroll") for (int _i = 0; _i < 2; ++_i) \
        __builtin_amdgcn_global_load_lds((const unsigned*)((const char*)(gbase) + (voff)[_i]), (PG8_LAS unsigned*)(lds + (bufoff) + ldsw + _i * 8192), 16, 0, 0); } while (0)
#define PG8_LDA(dst, b, h) do { _Pragma("unroll") for (int m = 0; m < 4; ++m) _Pragma("unroll") for (int k = 0; k < 2; ++k) dst[m][k] = *(const PG8_LAS bf16x8*)(lds + PG8_SA(b, h) + aoff + m * 2048 + k * 1024); } while (0)
#define PG8_LDB(dst, b, h) do { _Pragma("unroll") for (int n = 0; n < 2; ++n) _Pragma("unroll") for (int k = 0; k < 2; ++k) dst[n][k] = *(const PG8_LAS bf16x8*)(lds + PG8_SB(b, h) + boff + n * 2048 + k * 1024); } while (0)
#define PG8_MMA(ai, bj, At, Bt) do { __builtin_amdgcn_s_setprio(1); _Pragma("unroll") for (int m = 0; m < 4; ++m) _Pragma("unroll") for (int n = 0; n < 2; ++n) _Pragma("unroll") for (int k = 0; k < 2; ++k) \
        acc[ai][bj][m][n] = __builtin_amdgcn_mfma_f32_16x16x32_bf16(Bt[n][k], At[m][k], acc[ai][bj][m][n], 0, 0, 0); __builtin_amdgcn_s_setprio(0); } while (0)
#define PG8_WAIT_V(n) asm volatile("s_waitcnt vmcnt(" #n ")" ::: "memory")
#define PG8_WAIT_L(n) asm volatile("s_waitcnt lgkmcnt(" #n ")" ::: "memory")
#define PG8_BAR __builtin_amdgcn_s_barrier()
#define PG8_SCHED __builtin_amdgcn_sched_barrier(0)
    Unit cur, nxt; int ui = 0;
    if (!S.next(0, cur)) return;
    f32x4 acc[2][2][4][2];
#pragma unroll
    for (int a = 0; a < 2; ++a)
#pragma unroll
        for (int b = 0; b < 2; ++b)
#pragma unroll
            for (int m = 0; m < 4; ++m)
#pragma unroll
                for (int n = 0; n < 2; ++n) acc[a][b][m][n] = (f32x4){0.f, 0.f, 0.f, 0.f};
    bf16x8 At[4][2], B0[2][2], B1[2][2];
    const char* cA = (const char*)g.A + (size_t)cur.pm * tstep; const char* cB = (const char*)g.Bt + (size_t)cur.pn * tstep;
    S.a_ready(cur);
    if constexpr (SP2) {
        PG8_STAGE(PG8_SB(0, 0), cB, voffB); PG8_STAGE(PG8_SB(0, 1), cB + hstep, voffB); PG8_STAGE(PG8_SA(0, 0), cA, voffA); PG8_STAGE(PG8_SA(0, 1), cA + hstep, voffA);
        if (wr == 1) PG8_BAR;
        PG8_WAIT_V(2); PG8_BAR;
        PG8_STAGE(PG8_SB(1, 0), cB + kstep, voffB); PG8_STAGE(PG8_SA(1, 0), cA + kstep, voffA); PG8_STAGE(PG8_SB(1, 1), cB + hstep + kstep, voffB);
        PG8_WAIT_V(6); PG8_BAR;
    } else {
        PG8_STAGE(PG8_SB(0, 0), cB, voffB); PG8_STAGE(PG8_SA(0, 0), cA, voffA); PG8_STAGE(PG8_SB(0, 1), cB + hstep, voffB); PG8_STAGE(PG8_SA(0, 1), cA + hstep, voffA);
        if (wr == 1) PG8_BAR;
        PG8_WAIT_V(4); PG8_BAR;
        PG8_STAGE(PG8_SB(1, 0), cB + kstep, voffB); PG8_STAGE(PG8_SA(1, 0), cA + kstep, voffA); PG8_STAGE(PG8_SB(1, 1), cB + hstep + kstep, voffB);
        PG8_WAIT_V(6); PG8_BAR;
    }
    for (;;) {
        const bool has_next = S.next(ui + 1, nxt);
        const char* nA = has_next ? (const char*)g.A + (size_t)nxt.pm * tstep : cA; const char* nB = has_next ? (const char*)g.Bt + (size_t)nxt.pn * tstep : cB;
        for (int t = 0; t < nt; t += 2) {
            const bool last = (t == nt - 2);
            const char* a1 = cA + (size_t)(t + 1) * kstep;
            const char* a2 = last ? nA : cA + (size_t)(t + 2) * kstep; const char* b2 = last ? nB : cB + (size_t)(t + 2) * kstep;
            const char* a3 = a2 + kstep; const char* b3 = b2 + kstep;
            if (last && has_next) S.a_ready(nxt);
            if constexpr (SP2) {
            PG8_LDB(B0, 0, 0); PG8_LDB(B1, 0, 1); PG8_SCHED; PG8_LDA(At, 0, 0); PG8_STAGE(PG8_SA(1, 1), a1 + hstep, voffA);
            PG8_WAIT_V(8); PG8_WAIT_L(0); PG8_BAR; PG8_MMA(0, 0, At, B0); PG8_MMA(0, 1, At, B1); PG8_BAR; PG8_SCHED;
            PG8_LDA(At, 0, 1); PG8_STAGE(PG8_SB(0, 0), b2, voffB); PG8_STAGE(PG8_SB(0, 1), b2 + hstep, voffB); PG8_STAGE(PG8_SA(0, 0), a2, voffA);
            PG8_WAIT_V(8); PG8_WAIT_L(0); PG8_BAR; PG8_MMA(1, 0, At, B0); PG8_MMA(1, 1, At, B1); PG8_BAR; PG8_SCHED;
            PG8_LDB(B0, 1, 0); PG8_LDB(B1, 1, 1); PG8_SCHED; PG8_LDA(At, 1, 0); PG8_STAGE(PG8_SA(0, 1), a2 + hstep, voffA);
            PG8_WAIT_V(8); PG8_WAIT_L(0); PG8_BAR; PG8_MMA(0, 0, At, B0); PG8_MMA(0, 1, At, B1); PG8_BAR; PG8_SCHED;
            PG8_LDA(At, 1, 1); PG8_STAGE(PG8_SB(1, 0), b3, voffB); PG8_STAGE(PG8_SB(1, 1), b3 + hstep, voffB); PG8_STAGE(PG8_SA(1, 0), a3, voffA);
            PG8_WAIT_V(8); PG8_WAIT_L(0); PG8_BAR; PG8_MMA(1, 0, At, B0); PG8_MMA(1, 1, At, B1); PG8_BAR; PG8_SCHED;
            } else {
            PG8_LDB(B0, 0, 0); PG8_SCHED; PG8_LDA(At, 0, 0); PG8_STAGE(PG8_SA(1, 1), a1 + hstep, voffA);
            PG8_WAIT_L(8); PG8_BAR; PG8_WAIT_L(0); PG8_MMA(0, 0, At, B0); PG8_BAR; PG8_SCHED;
            PG8_LDB(B1, 0, 1); PG8_STAGE(PG8_SB(0, 0), b2, voffB);
            PG8_BAR; PG8_WAIT_L(0); PG8_MMA(0, 1, At, B1); PG8_BAR;
            PG8_LDA(At, 0, 1); PG8_STAGE(PG8_SA(0, 0), a2, voffA);
            PG8_BAR; PG8_WAIT_L(0); PG8_MMA(1, 0, At, B0); PG8_BAR; PG8_SCHED;
            PG8_STAGE(PG8_SB(0, 1), b2 + hstep, voffB);
            PG8_WAIT_V(6); PG8_BAR; PG8_MMA(1, 1, At, B1); PG8_BAR;
            PG8_LDB(B0, 1, 0); PG8_SCHED; PG8_LDA(At, 1, 0); PG8_STAGE(PG8_SA(0, 1), a2 + hstep, voffA);
            PG8_WAIT_L(8); PG8_BAR; PG8_WAIT_L(0); PG8_MMA(0, 0, At, B0); PG8_BAR; PG8_SCHED;
            PG8_LDB(B1, 1, 1); PG8_STAGE(PG8_SB(1, 0), b3, voffB);
            PG8_BAR; PG8_WAIT_L(0); PG8_MMA(0, 1, At, B1); PG8_BAR;
            PG8_LDA(At, 1, 1); PG8_STAGE(PG8_SA(1, 0), a3, voffA);
            PG8_BAR; PG8_WAIT_L(0); PG8_MMA(1, 0, At, B0); PG8_BAR; PG8_SCHED;
            PG8_STAGE(PG8_SB(1, 1), b3 + hstep, voffB);
            PG8_WAIT_V(6); PG8_BAR; PG8_MMA(1, 1, At, B1); PG8_BAR;
            }
        }
        if constexpr (ALIGN_EPI) { if (wr == 0) PG8_BAR; }
        if constexpr (!Epi::AFTER_DRAIN) { E(acc, cur, wr, wc, fr, fq); S.done(cur); }
        if (!has_next) break;
#pragma unroll
        for (int a = 0; a < 2; ++a)
#pragma unroll
            for (int b = 0; b < 2; ++b)
#pragma unroll
                for (int m = 0; m < 4; ++m)
#pragma unroll
                    for (int n = 0; n < 2; ++n) acc[a][b][m][n] = (f32x4){0.f, 0.f, 0.f, 0.f};
        cur = nxt; cA = nA; cB = nB; ++ui;
        if constexpr (ALIGN_EPI) { if (wr == 1) PG8_BAR; }
    }
    PG8_WAIT_V(0);
    if constexpr (!ALIGN_EPI) { if (wr == 0) PG8_BAR; }
    PG8_BAR;
    if constexpr (Epi::AFTER_DRAIN) { E.fused(acc, cur, wr, wc, fr, fq, lds, wid, lane); S.done(cur); }
#undef PG8_SA
#undef PG8_SB
#undef PG8_STAGE
#undef PG8_LDA
#undef PG8_LDB
#undef PG8_MMA
#undef PG8_WAIT_V
#undef PG8_WAIT_L
#undef PG8_BAR
#undef PG8_SCHED
}

struct MUnit { int slot, e, pn, nrows; };
struct MoeSched {
    PG8_LAS const int* tstart; PG8_LAS const int* cntl; int npn, total, G, c;
    const char* W; size_t estride, pnstride;
    __device__ __forceinline__ bool next(int i, MUnit& u) const {
        const int L = i * G + c; if (L >= total) return false;
        const int tix = L / npn; u.pn = L - tix * npn;
        int e = 0;
#pragma unroll
        for (int s = 16; s >= 1; s >>= 1) if (tstart[e + s] <= tix) e += s;
        u.e = e; u.slot = i; const int r0 = (tix - tstart[e]) * 256; const int left = cntl[e] - r0; u.nrows = left < 256 ? left : 256;
        return true;
    }
    __device__ __forceinline__ int row0(int i) const { const int L = i * G + c; const int tix = L / npn; int e = 0;
#pragma unroll
        for (int s = 16; s >= 1; s >>= 1) if (tstart[e + s] <= tix) e += s;
        return (tix - tstart[e]) * 256; }
    __device__ __forceinline__ const char* b_base(const MUnit& u) const { return W + (size_t)u.e * estride + (size_t)u.pn * pnstride; }
};
template <int ESH, class Epi, class Sched>
__device__ __forceinline__ void gemm_phase_moe(PG8_LAS unsigned char* lds, const bf16_t* Abase, const int K, PG8_LAS const unsigned* ent, const Sched& S, const Epi& E) {
    int tid_ = threadIdx.x; asm volatile("" : "+v"(tid_));
    const int tid = tid_, wid = __builtin_amdgcn_readfirstlane(tid >> 6), lane = tid & 63, wr = wid >> 2, wc = wid & 3, fr = lane & 15, fq = lane >> 4;
    const int nt = K / BK;
    int RA[2]; unsigned cA2[2], voffB[2];
#pragma unroll
    for (int i = 0; i < 2; ++i) { int R, C; stage_rc(tid * 16 + i * 8192, R, C); const int Rb = Epi::PERM ? ((R & ~31) + perm32(R & 31)) : R;
        RA[i] = R; cA2[i] = (unsigned)C * 2u; voffB[i] = (unsigned)(Rb * K + C) * 2u; }
    const size_t kstep = (size_t)(BK * 2);
    const size_t hstep = (size_t)HALF * K * 2;
    const unsigned rowb = (unsigned)K * 2u;
    const unsigned ldsw = (unsigned)wid * 1024u;
    const int aoff = lds_byte(wr * 64 + fr, fq * 8), boff = lds_byte(wc * 32 + fr, fq * 8);
#define PG8_SA(b, h) (((b) * 2 + (h)) * HTB)
#define PG8_SB(b, h) ((4 + (b) * 2 + (h)) * HTB)
#define PG8_STAGE(bufoff, gbase, voff) do { _Pragma("unroll") for (int _i = 0; _i < 2; ++_i) \
        __builtin_amdgcn_global_load_lds((const unsigned*)((const char*)(gbase) + (voff)[_i]), (PG8_LAS unsigned*)(lds + (bufoff) + ldsw + _i * 8192), 16, 0, 0); } while (0)
#define PG8_LDA(dst, b, h) do { _Pragma("unroll") for (int m = 0; m < 4; ++m) _Pragma("unroll") for (int k = 0; k < 2; ++k) dst[m][k] = *(const PG8_LAS bf16x8*)(lds + PG8_SA(b, h) + aoff + m * 2048 + k * 1024); } while (0)
#define PG8_LDB(dst, b, h) do { _Pragma("unroll") for (int n = 0; n < 2; ++n) _Pragma("unroll") for (int k = 0; k < 2; ++k) dst[n][k] = *(const PG8_LAS bf16x8*)(lds + PG8_SB(b, h) + boff + n * 2048 + k * 1024); } while (0)
#define PG8_MMA(ai, bj, At, Bt) do { __builtin_amdgcn_s_setprio(1); _Pragma("unroll") for (int m = 0; m < 4; ++m) _Pragma("unroll") for (int n = 0; n < 2; ++n) _Pragma("unroll") for (int k = 0; k < 2; ++k) \
        acc[ai][bj][m][n] = __builtin_amdgcn_mfma_f32_16x16x32_bf16(Bt[n][k], At[m][k], acc[ai][bj][m][n], 0, 0, 0); __builtin_amdgcn_s_setprio(0); } while (0)
#define PG8_WAIT_V(n) asm volatile("s_waitcnt vmcnt(" #n ")" ::: "memory")
#define PG8_WAIT_L(n) asm volatile("s_waitcnt lgkmcnt(" #n ")" ::: "memory")
#define PG8_BAR __builtin_amdgcn_s_barrier()
#define PG8_SCHED __builtin_amdgcn_sched_barrier(0)
#define PG8_OFFS(dst, u) do { _Pragma("unroll") for (int _h = 0; _h < 2; ++_h) _Pragma("unroll") for (int _i = 0; _i < 2; ++_i) \
        dst[_h][_i] = (ent[(u).slot * 256 + _h * HALF + RA[_i]] >> ESH) * rowb + cA2[_i]; } while (0)
    MUnit cur, nxt; int ui = 0;
    if (!S.next(0, cur)) return;
    f32x4 acc[2][2][4][2];
#pragma unroll
    for (int a = 0; a < 2; ++a)
#pragma unroll
        for (int b = 0; b < 2; ++b)
#pragma unroll
            for (int m = 0; m < 4; ++m)
#pragma unroll
                for (int n = 0; n < 2; ++n) acc[a][b][m][n] = (f32x4){0.f, 0.f, 0.f, 0.f};
    bf16x8 At[4][2], B0[2][2], B1[2][2];
    unsigned offc[2][2], offn[2][2];
    PG8_OFFS(offc, cur);
    const char* const cA = (const char*)Abase; const char* cB = S.b_base(cur);
    PG8_STAGE(PG8_SB(0, 0), cB, voffB); PG8_STAGE(PG8_SB(0, 1), cB + hstep, voffB); PG8_STAGE(PG8_SA(0, 0), cA, offc[0]); PG8_STAGE(PG8_SA(0, 1), cA, offc[1]);
    if (wr == 1) PG8_BAR;
    PG8_WAIT_V(2); PG8_BAR;
    PG8_STAGE(PG8_SB(1, 0), cB + kstep, voffB); PG8_STAGE(PG8_SA(1, 0), cA + kstep, offc[0]); PG8_STAGE(PG8_SB(1, 1), cB + hstep + kstep, voffB);
    PG8_WAIT_V(6); PG8_BAR;
    for (;;) {
        const bool has_next = S.next(ui + 1, nxt);
        const char* nB = has_next ? S.b_base(nxt) : cB;
        if (has_next) { PG8_OFFS(offn, nxt); } else {
#pragma unroll
            for (int h = 0; h < 2; ++h)
#pragma unroll
                for (int i = 0; i < 2; ++i) offn[h][i] = offc[h][i]; }
#pragma nounroll
        for (int t = 0; t < nt; t += 2) {
            const bool last = (t == nt - 2);
            const char* a1 = cA + (size_t)(t + 1) * kstep;
            const char* a2 = last ? cA : cA + (size_t)(t + 2) * kstep; const char* b2 = last ? nB : cB + (size_t)(t + 2) * kstep;
            const char* a3 = a2 + kstep; const char* b3 = b2 + kstep;
            unsigned o2[2][2];
#pragma unroll
            for (int h = 0; h < 2; ++h)
#pragma unroll
                for (int i = 0; i < 2; ++i) o2[h][i] = last ? offn[h][i] : offc[h][i];
            PG8_LDB(B0, 0, 0); PG8_LDB(B1, 0, 1); PG8_SCHED; PG8_LDA(At, 0, 0); PG8_STAGE(PG8_SA(1, 1), a1, offc[1]);
            PG8_WAIT_V(8); PG8_WAIT_L(0); PG8_BAR; PG8_MMA(0, 0, At, B0); PG8_MMA(0, 1, At, B1); PG8_BAR; PG8_SCHED;
            PG8_LDA(At, 0, 1); PG8_STAGE(PG8_SB(0, 0), b2, voffB); PG8_STAGE(PG8_SB(0, 1), b2 + hstep, voffB); PG8_STAGE(PG8_SA(0, 0), a2, o2[0]);
            PG8_WAIT_V(8); PG8_WAIT_L(0); PG8_BAR; PG8_MMA(1, 0, At, B0); PG8_MMA(1, 1, At, B1); PG8_BAR; PG8_SCHED;
            PG8_LDB(B0, 1, 0); PG8_LDB(B1, 1, 1); PG8_SCHED; PG8_LDA(At, 1, 0); PG8_STAGE(PG8_SA(0, 1), a2, o2[1]);
            PG8_WAIT_V(8); PG8_WAIT_L(0); PG8_BAR; PG8_MMA(0, 0, At, B0); PG8_MMA(0, 1, At, B1); PG8_BAR; PG8_SCHED;
            PG8_LDA(At, 1, 1); PG8_STAGE(PG8_SB(1, 0), b3, voffB); PG8_STAGE(PG8_SB(1, 1), b3 + hstep, voffB); PG8_STAGE(PG8_SA(1, 0), a3, o2[0]);
            PG8_WAIT_V(8); PG8_WAIT_L(0); PG8_BAR; PG8_MMA(1, 0, At, B0); PG8_MMA(1, 1, At, B1); PG8_BAR; PG8_SCHED;
        }
        if (wr == 0) PG8_BAR;
        E(acc, cur, wr, wc, fr, fq);
        if (!has_next) break;
#pragma unroll
        for (int a = 0; a < 2; ++a)
#pragma unroll
            for (int b = 0; b < 2; ++b)
#pragma unroll
                for (int m = 0; m < 4; ++m)
#pragma unroll
                    for (int n = 0; n < 2; ++n) acc[a][b][m][n] = (f32x4){0.f, 0.f, 0.f, 0.f};
        cur = nxt; cB = nB; ++ui;
#pragma unroll
        for (int h = 0; h < 2; ++h)
#pragma unroll
            for (int i = 0; i < 2; ++i) offc[h][i] = offn[h][i];
        if (wr == 1) PG8_BAR;
    }
    PG8_WAIT_V(0);
    PG8_BAR;
#undef PG8_SA
#undef PG8_SB
#undef PG8_STAGE
#undef PG8_LDA
#undef PG8_LDB
#undef PG8_MMA
#undef PG8_WAIT_V
#undef PG8_WAIT_L
#undef PG8_BAR
#undef PG8_SCHED
#undef PG8_OFFS
}
struct EpiAct {
    static constexpr bool PERM = true, AFTER_DRAIN = false;
    bf16_t* ACT; PG8_LAS const unsigned* ent; PG8_LAS const float* cwt;
    __device__ __forceinline__ void operator()(const f32x4 (&acc)[2][2][4][2], const MUnit& u, int wr, int wc, int fr, int fq) const {
#pragma unroll
        for (int ai = 0; ai < 2; ++ai)
#pragma unroll
            for (int m = 0; m < 4; ++m) { const int r = ai * HALF + wr * 64 + m * 16 + fr;
                if (r < u.nrows) { const unsigned en = ent[u.slot * 256 + r]; const float w = cwt[u.slot * 256 + r];
                    float a[8];
#pragma unroll
                    for (int n = 0; n < 2; ++n)
#pragma unroll
                        for (int j = 0; j < 4; ++j) { const float g = acc[ai][0][m][n][j], up = acc[ai][1][m][n][j];
                            a[4 * n + j] = g * __builtin_amdgcn_rcpf(1.f + __builtin_amdgcn_exp2f(-1.4426950408889634f * g)) * up * w; }
                    u32x4 o; o.x = cvt_pk_bf16(a[0], a[1]); o.y = cvt_pk_bf16(a[2], a[3]); o.z = cvt_pk_bf16(a[4], a[5]); o.w = cvt_pk_bf16(a[6], a[7]);
                    *(u32x4*)(ACT + (size_t)en * 256 + u.pn * HALF + wc * 32 + 8 * fq) = o; } }
    }
};
struct EpiY {
    static constexpr bool PERM = true, AFTER_DRAIN = false;
    bf16_t* Y; size_t slot_stride; PG8_LAS const unsigned* ent;
    __device__ __forceinline__ void operator()(const f32x4 (&acc)[2][2][4][2], const MUnit& u, int wr, int wc, int fr, int fq) const {
#pragma unroll
        for (int ai = 0; ai < 2; ++ai)
#pragma unroll
            for (int m = 0; m < 4; ++m) { const int r = ai * HALF + wr * 64 + m * 16 + fr;
                if (r < u.nrows) { const unsigned en = ent[u.slot * 256 + r];
                    bf16_t* rowp = Y + (size_t)(en & 1u) * slot_stride + (size_t)(en >> 1) * 1024 + u.pn * BM + wc * 32 + 8 * fq;
#pragma unroll
                    for (int bj = 0; bj < 2; ++bj) { const f32x4 v0 = acc[ai][bj][m][0], v1 = acc[ai][bj][m][1];
                        u32x4 o; o.x = cvt_pk_bf16(v0[0], v0[1]); o.y = cvt_pk_bf16(v0[2], v0[3]); o.z = cvt_pk_bf16(v1[0], v1[1]); o.w = cvt_pk_bf16(v1[2], v1[3]);
                        *(u32x4*)(rowp + bj * HALF) = o; } } }
    }
};
}

#include <hip/hip_bf16.h>
#include <cmath>

namespace attn_body {
using bf16=__hip_bfloat16;
using bf16x8=__attribute__((ext_vector_type(8)))short;
using s16x4=__attribute__((ext_vector_type(4)))short;
using f32x16=__attribute__((ext_vector_type(16)))float;
using u32x4=__attribute__((ext_vector_type(4)))unsigned;
constexpr int BATCH=8,NHEAD=8,SEQ=4096,D=64,DM=NHEAD*D,ODM=1024;
constexpr int NW=8,QBLK=32,QB=QBLK*NW,KVBLK=64,NQB=SEQ/QB;
constexpr int ATTN_PITCH=DM, ATTN_UNIT_ROWS=QB;
__device__ __forceinline__ int crow(int r,int hi){return (r&3)+8*(r>>2)+4*hi;}
#define SBAR() __builtin_amdgcn_sched_barrier(0)
__device__ __forceinline__ void cmask(f32x16&p0,f32x16&p1,int jb,int qrel,int hi){
  const float NEG=-INFINITY; int kb=64*jb+4*hi;
  #pragma unroll
  for(int r=0;r<16;++r){int kv=kb+(r&3)+8*(r>>2); if(kv>qrel)p0[r]=NEG; if(kv+32>qrel)p1[r]=NEG;}
}

constexpr int NSLOT=3, SLOTB=8192;
constexpr int LDS_K=0, LDS_V=NSLOT*SLOTB, LDS_WS=2*NSLOT*SLOTB, LDS_OST=LDS_WS+NW*64*4, LDS_BYTES=LDS_OST+NW*4096;
constexpr int LDS_FB=86016, LDS_FB_BYTES=SEQ*4;
constexpr float C2=0.125f*1.4426950408889634f;
__device__ __forceinline__ void glds16(const void*gbase,unsigned voff,unsigned lds_dst){unsigned keep;
  asm volatile("s_mov_b32 %0, m0\n\ts_mov_b32 m0, %3\n\ts_nop 0\n\tglobal_load_lds_dwordx4 %1, %2\n\ts_mov_b32 m0, %0":"=&s"(keep):"v"(voff),"s"(gbase),"s"(lds_dst):"memory");}
__device__ __forceinline__ float max3f(float a,float b,float c){float r;asm("v_max3_f32 %0, %1, %2, %3":"=v"(r):"v"(a),"v"(b),"v"(c));return r;}
__device__ __forceinline__ float max2f(float a,float b){float r;asm("v_max_f32_e32 %0, %1, %2":"=v"(r):"v"(a),"v"(b));return r;}
__device__ __forceinline__ float fadd_s(float a,float b){float r;asm("v_add_f32_e32 %0, %1, %2":"=v"(r):"v"(a),"v"(b));return r;}
__device__ __forceinline__ float fsub_s(float a,float b){float r;asm("v_sub_f32_e32 %0, %1, %2":"=v"(r):"v"(a),"v"(b));return r;}
typedef float f32x2_t __attribute__((ext_vector_type(2))); typedef __bf16 bf16x2_t __attribute__((ext_vector_type(2)));
__device__ __forceinline__ unsigned cvtpk_s(float lo,float hi){f32x2_t v={lo,hi};bf16x2_t b=__builtin_convertvector(v,bf16x2_t);return __builtin_bit_cast(unsigned,b);}
#define WAIT_BAR(N) asm volatile("s_waitcnt vmcnt(" #N ") lgkmcnt(0)\n\ts_barrier":::"memory")

__device__ __forceinline__ void qkt(f32x16&p0,f32x16&p1,const char*Kslot,const bf16x8*qr,int r32,int hi){
  const char*kb=Kslot+hi*1024+r32*16;
  #pragma unroll
  for(int d0=0;d0<4;++d0){
    const bf16x8 b0=*reinterpret_cast<const bf16x8*>(kb+d0*2048);
    const bf16x8 b1=*reinterpret_cast<const bf16x8*>(kb+d0*2048+512);
    {p0=__builtin_amdgcn_mfma_f32_32x32x16_bf16(b0,qr[d0],p0,0,0,0);p1=__builtin_amdgcn_mfma_f32_32x32x16_bf16(b1,qr[d0],p1,0,0,0);}}
}
typedef __attribute__((address_space(3))) const char* lds_cptr;
typedef float f32x4_t __attribute__((ext_vector_type(4)));
typedef short v4i16_t __attribute__((ext_vector_type(4)));
__device__ __forceinline__ void kload8(bf16x8*kf,lds_cptr kp){
  kf[0]=*(const __attribute__((address_space(3))) bf16x8*)(kp);      kf[1]=*(const __attribute__((address_space(3))) bf16x8*)(kp+512);
  kf[2]=*(const __attribute__((address_space(3))) bf16x8*)(kp+2048); kf[3]=*(const __attribute__((address_space(3))) bf16x8*)(kp+2560);
  kf[4]=*(const __attribute__((address_space(3))) bf16x8*)(kp+4096); kf[5]=*(const __attribute__((address_space(3))) bf16x8*)(kp+4608);
  kf[6]=*(const __attribute__((address_space(3))) bf16x8*)(kp+6144); kf[7]=*(const __attribute__((address_space(3))) bf16x8*)(kp+6656);
}
__device__ __forceinline__ void kload2(bf16x8*kf,lds_cptr kp,int j){ kf[2*j]=*(const __attribute__((address_space(3))) bf16x8*)(kp+j*2048); kf[2*j+1]=*(const __attribute__((address_space(3))) bf16x8*)(kp+j*2048+512); }
__device__ __forceinline__ s16x4 vtr(lds_cptr p){ return __builtin_bit_cast(s16x4,__builtin_amdgcn_ds_read_tr16_b64_v4i16((__attribute__((address_space(3))) v4i16_t*)p)); }
__device__ __forceinline__ float rowmax(const f32x16&p0,const f32x16&p1){
  float a=max3f(p0[0],p0[1],p1[0]),b=max3f(p0[2],p0[3],p1[1]);a=max3f(a,p1[2],p1[3]);
  #pragma unroll
  for(int r=4;r<16;r+=4){a=max3f(a,p0[r],p0[r+1]);b=max3f(b,p0[r+2],p0[r+3]);a=max3f(a,p1[r],p1[r+1]);b=max3f(b,p1[r+2],p1[r+3]);}
  const float m=max2f(a,b);
  auto rr=__builtin_amdgcn_permlane32_swap(__float_as_uint(m),__float_as_uint(m),false,false);
  return max2f(__uint_as_float(rr[0]),__uint_as_float(rr[1]));
}
__device__ __forceinline__ void pv(f32x16*o,int vb,bf16x8 pa0,bf16x8 pa1,bf16x8 pa2,bf16x8 pa3){
  #pragma unroll
  for(int d0=0;d0<2;++d0){s16x4 lo[4],hi[4];
    #pragma unroll
    for(int ks=0;ks<4;++ks){
      asm volatile("ds_read_b64_tr_b16 %0,%1 offset:%c2":"=&v"(lo[ks]):"v"(vb),"i"(d0*4096+ks*1024):"memory");
      asm volatile("ds_read_b64_tr_b16 %0,%1 offset:%c2":"=&v"(hi[ks]):"v"(vb),"i"(d0*4096+ks*1024+512):"memory");}
    asm volatile("s_waitcnt lgkmcnt(0)":::"memory");SBAR();
    #define PK(k) (bf16x8){lo[k][0],lo[k][1],lo[k][2],lo[k][3],hi[k][0],hi[k][1],hi[k][2],hi[k][3]}
    o[d0]=__builtin_amdgcn_mfma_f32_32x32x16_bf16(pa0,PK(0),o[d0],0,0,0);
    o[d0]=__builtin_amdgcn_mfma_f32_32x32x16_bf16(pa1,PK(1),o[d0],0,0,0);
    o[d0]=__builtin_amdgcn_mfma_f32_32x32x16_bf16(pa2,PK(2),o[d0],0,0,0);
    o[d0]=__builtin_amdgcn_mfma_f32_32x32x16_bf16(pa3,PK(3),o[d0],0,0,0);
    #undef PK
  }
}

#ifndef ATTN_STORE16
#define ATTN_STORE16(p,v) (*(u32x4*)(p)=(v))
#endif
template<int THRL> __device__ __forceinline__ void attn_unit(int b,int h,int qb,const bf16*Q,const bf16*__restrict__ K,const bf16*__restrict__ V,bf16*O,const float*__restrict__ FCbh,char*shm){
  int tid_=threadIdx.x; asm volatile("":"+v"(tid_)); const int tid=tid_,lane=tid&63,r32=lane&31,hi=lane>>5; const int wid=__builtin_amdgcn_readfirstlane(tid>>6);
  const long rowbase=(long)b*SEQ; const int q0=qb*QB;
  const bf16*Qw=Q+(rowbase+q0+wid*QBLK)*DM+h*D;
  const bf16*Kh=K+rowbase*DM+h*D,*Vh=V+rowbase*DM+h*D;
  const unsigned lds0=(unsigned)(uintptr_t)shm;
  float*wsf=(float*)(shm+LDS_WS)+wid*64;
  const unsigned ksrc=(unsigned)((lane*DM+wid*8)*2);
  const unsigned vsrc=(unsigned)(((16*(wid&3)+(lane>>2))*DM+(wid>>2)*32+(lane&3)*8)*2);
  const unsigned kdst=lds0+LDS_K+wid*1024, vdst=lds0+LDS_V+wid*1024;
  #define DMA_K(t,slot) glds16(Kh,ksrc+(unsigned)(t)*(unsigned)(KVBLK*DM*2),(unsigned)__builtin_amdgcn_readfirstlane(kdst+(slot)))
  #define DMA_V(t,slot) glds16(Vh,vsrc+(unsigned)(t)*(unsigned)(KVBLK*DM*2),(unsigned)__builtin_amdgcn_readfirstlane(vdst+(slot)))
  const int vb0=(int)(lds0+LDS_V)+((lane>>4)&1)*32+(lane&3)*8+(4*hi+((lane&15)>>2))*64;
  const char*Kbase=shm+LDS_K; bf16x8 kf[8];
  const lds_cptr shm3=(lds_cptr)shm; const lds_cptr kp0=shm3+LDS_K+hi*1024+r32*16; const lds_cptr vp0=shm3+LDS_V+((lane>>4)&1)*32+(lane&3)*8+(4*hi+((lane&15)>>2))*64;
  const int NT=(q0+QB)/KVBLK;
  DMA_K(0,0);DMA_V(0,0);DMA_K(1,SLOTB);
  { __attribute__((address_space(3))) float* fbw=(__attribute__((address_space(3))) float*)(shm3+LDS_FB);
    for(int s_=tid*4;s_<NT*KVBLK;s_+=NW*64*4){ const f32x4_t v_=*reinterpret_cast<const f32x4_t*>(FCbh+s_); *( __attribute__((address_space(3))) f32x4_t*)(fbw+s_)=(f32x4_t){-v_[0],-v_[1],-v_[2],-v_[3]}; } }
  bf16x8 qr[4];
  #pragma unroll
  for(int d0=0;d0<4;++d0)qr[d0]=*reinterpret_cast<const bf16x8*>(&Qw[(long)r32*DM+d0*16+hi*8]);
  float mhat=0.f,l_reg=0.f;f32x16 o[2];o[0]=f32x16{};o[1]=f32x16{};
  const int qrel=wid*QBLK+r32;
  const __attribute__((address_space(3))) f32x4_t* fbq=(const __attribute__((address_space(3))) f32x4_t*)(shm3+LDS_FB+16*hi);
  #define CINIT(C0,C1,t) do{ _Pragma("unroll") for(int i_=0;i_<4;++i_){ const f32x4_t b0_=fbq[(t)*16+2*i_], b1_=fbq[(t)*16+8+2*i_]; \
      _Pragma("unroll") for(int j_=0;j_<4;++j_){ C0[4*i_+j_]=b0_[j_]-mhat; C1[4*i_+j_]=b1_[j_]-mhat; } } }while(0)
  #define CMASK(P0,P1,t) do{int jb_=(t)-(NT-4); if(jb_>=0)cmask(P0,P1,jb_,qrel,hi);}while(0)
  bool resc=false;
  #define START(P0,P1) do{ const float rm=rowmax(P0,P1); resc=false; \
    { const float dl=rm; mhat=fadd_s(mhat,dl); \
      _Pragma("unroll") for(int r=0;r<16;++r){P0[r]=fsub_s(P0[r],dl);P1[r]=fsub_s(P1[r],dl);} \
      } \
    _Pragma("unroll") for(int r=0;r<16;++r)P0[r]=__builtin_amdgcn_exp2f(P0[r]); }while(0)
  #define RESC() do{ if(resc){ asm volatile("s_waitcnt lgkmcnt(0)":::"memory"); \
      _Pragma("unroll") for(int d_=0;d_<2;++d_) _Pragma("unroll") for(int r=0;r<16;++r)o[d_][r]*=wsf[crow(r,hi)]; } }while(0)
  f32x16 pA0,pA1,pB0,pB1;
  int sl_prev=0,sl_cur=0,sl_next=SLOTB;
  #define ROT() do{sl_prev=sl_cur;sl_cur=sl_next;sl_next=(sl_next==(NSLOT-1)*SLOTB)?0:sl_next+SLOTB;}while(0)
  DMA_K(2,2*SLOTB);
  WAIT_BAR(3);
  CINIT(pA0,pA1,0); qkt(pA0,pA1,Kbase,qr,r32,hi);asm volatile("s_nop 15\n\ts_nop 7":"+v"(pA0),"+v"(pA1));CMASK(pA0,pA1,0);
  START(pA0,pA1);
  _Pragma("unroll") for(int r=0;r<16;++r)pA1[r]=__builtin_amdgcn_exp2f(pA1[r]);
  WAIT_BAR(0);
  DMA_K(3,0);DMA_V(1,SLOTB);
  ROT();
  kload8(kf,kp0+sl_cur);
  WAIT_BAR(2);
  s16x4 vlo[8],vhi[8]; u32x4 pw0,pw1,pw2,pw3;
  #define PKW(P,B) cvtpk_s(P[B],P[B+1])
  #define PAF(k) __builtin_bit_cast(bf16x8,pw##k)
  #define VFR(i) (bf16x8){vlo[i][0],vlo[i][1],vlo[i][2],vlo[i][3],vhi[i][0],vhi[i][1],vhi[i][2],vhi[i][3]}
  #define PIN(x) asm volatile("":"+v"(x))
  #define MX3(a,b,c) __builtin_fmaxf(__builtin_fmaxf((a),(b)),(c))
  #define GAPA(MF,A0,A1,A2,A3,W0,W1,PW) do{ MF; sacc+=A0; sacc+=A1; sacc+=A2; sacc+=A3; PIN(sacc); W0; W1; PIN(PW); SBAR(); }while(0)
  #define EX(v) __builtin_amdgcn_exp2f(v)
  #define GAPB(MF,X,B) do{ MF; X[B]=EX(X[B]); X[B+1]=EX(X[B+1]); X[B+2]=EX(X[B+2]); X[B+3]=EX(X[B+3]); PIN(X); SBAR(); }while(0)
  #define VRD(i) do{ vlo[i]=vtr(vp_+(((i)>>2)*4096+((i)&3)*1024)); vhi[i]=vtr(vp_+(((i)>>2)*4096+((i)&3)*1024+512)); }while(0)
  #define KRD(G,j) do{ if(G){ kload2(kf,kp0+sl_next,j); SBAR(); } }while(0)
  #define STEP(C0,C1,P0,P1,t,GK,GV,GL) do{ SBAR(); CINIT(C0,C1,t); SBAR(); \
    const lds_cptr vp_=vp0+sl_prev; \
    VRD(0); SBAR(); float sacc=(P0[0]+P0[1]); \
    GAPA(C0=__builtin_amdgcn_mfma_f32_32x32x16_bf16(kf[0],qr[0],C0,0,0,0), P0[2],P0[3],P0[4],P0[5],     pw0[0]=PKW(P0,0), pw0[1]=PKW(P0,2), pw0); \
    VRD(4); SBAR(); GAPA(C1=__builtin_amdgcn_mfma_f32_32x32x16_bf16(kf[1],qr[0],C1,0,0,0), P0[6],P0[7],P0[8],P0[9],     pw0[2]=PKW(P0,4), pw0[3]=PKW(P0,6), pw0); \
    VRD(1); SBAR(); GAPA(C0=__builtin_amdgcn_mfma_f32_32x32x16_bf16(kf[2],qr[1],C0,0,0,0),   P0[10],P0[11],P0[12],P0[13], pw1[0]=PKW(P0,8), pw1[1]=PKW(P0,10), pw1); \
    VRD(5); SBAR(); GAPA(C1=__builtin_amdgcn_mfma_f32_32x32x16_bf16(kf[3],qr[1],C1,0,0,0),   P0[14],P0[15],P1[0],P1[1],   pw1[2]=PKW(P0,12),pw1[3]=PKW(P0,14), pw1); \
    VRD(2); SBAR(); GAPA(C0=__builtin_amdgcn_mfma_f32_32x32x16_bf16(kf[4],qr[2],C0,0,0,0),   P1[2],P1[3],P1[4],P1[5],     pw2[0]=PKW(P1,0), pw2[1]=PKW(P1,2), pw2); \
    VRD(6); SBAR(); GAPA(C1=__builtin_amdgcn_mfma_f32_32x32x16_bf16(kf[5],qr[2],C1,0,0,0),   P1[6],P1[7],P1[8],P1[9],     pw2[2]=PKW(P1,4), pw2[3]=PKW(P1,6), pw2); \
    VRD(3); SBAR(); GAPA(C0=__builtin_amdgcn_mfma_f32_32x32x16_bf16(kf[6],qr[3],C0,0,0,0),   P1[10],P1[11],P1[12],P1[13], pw3[0]=PKW(P1,8), pw3[1]=PKW(P1,10), pw3); \
    VRD(7); SBAR(); GAPA(C1=__builtin_amdgcn_mfma_f32_32x32x16_bf16(kf[7],qr[3],C1,0,0,0),   P1[14],P1[15],0.f,0.f,       pw3[2]=PKW(P1,12),pw3[3]=PKW(P1,14), pw3); \
    l_reg+=sacc; \
    if(GK){DMA_K((t)+3,sl_cur);} if(GV){DMA_V((t)+1,sl_next);} \
    CMASK(C0,C1,t); \
    { float a=MX3(C0[0],C0[1],C1[0]),b=MX3(C0[2],C0[3],C1[1]); a=MX3(a,C1[2],C1[3]); \
      _Pragma("unroll") for(int r=4;r<16;r+=4){a=MX3(a,C0[r],C0[r+1]);b=MX3(b,C0[r+2],C0[r+3]);a=MX3(a,C1[r],C1[r+1]);b=MX3(b,C1[r+2],C1[r+3]);} \
      float rm=__builtin_fmaxf(a,b); { auto rr=__builtin_amdgcn_permlane32_swap(__float_as_uint(rm),__float_as_uint(rm),false,false); rm=__builtin_fmaxf(__uint_as_float(rr[0]),__uint_as_float(rr[1])); } \
      resc=false; \
      if(__builtin_expect(__any(rm>(float)THRL),0)){ const float dl=__builtin_fmaxf(rm,0.f); mhat+=dl; \
        _Pragma("unroll") for(int r=0;r<16;++r){C0[r]-=dl;C1[r]-=dl;} \
        const float f=__builtin_amdgcn_exp2f(-dl); l_reg*=f; if(hi==0)wsf[r32]=f; resc=true; } } \
    SBAR(); \
    GAPB(o[0]=__builtin_amdgcn_mfma_f32_32x32x16_bf16(PAF(0),VFR(0),o[0],0,0,0), C0,0); \
    GAPB(o[1]=__builtin_amdgcn_mfma_f32_32x32x16_bf16(PAF(0),VFR(4),o[1],0,0,0), C0,4); \
    KRD(GL,0); GAPB(o[0]=__builtin_amdgcn_mfma_f32_32x32x16_bf16(PAF(1),VFR(1),o[0],0,0,0), C0,8); \
    KRD(GL,1); GAPB(o[1]=__builtin_amdgcn_mfma_f32_32x32x16_bf16(PAF(1),VFR(5),o[1],0,0,0), C0,12); \
    KRD(GL,2); GAPB(o[0]=__builtin_amdgcn_mfma_f32_32x32x16_bf16(PAF(2),VFR(2),o[0],0,0,0), C1,0); \
    KRD(GL,3); GAPB(o[1]=__builtin_amdgcn_mfma_f32_32x32x16_bf16(PAF(2),VFR(6),o[1],0,0,0), C1,4); \
    GAPB(o[0]=__builtin_amdgcn_mfma_f32_32x32x16_bf16(PAF(3),VFR(3),o[0],0,0,0), C1,8); \
    GAPB(o[1]=__builtin_amdgcn_mfma_f32_32x32x16_bf16(PAF(3),VFR(7),o[1],0,0,0), C1,12); \
    }while(0)
  int t=1;
  #undef CMASK
  #define CMASK(P0,P1,t) do{}while(0)
  for(;t+5<NT;t+=2){
    STEP(pB0,pB1,pA0,pA1,t,true,true,true);     WAIT_BAR(2); RESC(); ROT();
    STEP(pA0,pA1,pB0,pB1,t+1,true,true,true);   WAIT_BAR(2); RESC(); ROT();
  }
  #undef CMASK
  #define CMASK(P0,P1,t) do{int jb_=(t)-(NT-4); if(jb_>=0)cmask(P0,P1,jb_,qrel,hi);}while(0)
  #define ENDW(tt) do{ if((tt)+3<NT){WAIT_BAR(2);} else if((tt)+2<NT){WAIT_BAR(1);} else {WAIT_BAR(0);} }while(0)
  for(;t+1<NT;t+=2){
    STEP(pB0,pB1,pA0,pA1,t,(t+3<NT),(t+1<NT),(t+1<NT));       ENDW(t);   RESC(); ROT();
    STEP(pA0,pA1,pB0,pB1,t+1,(t+4<NT),(t+2<NT),(t+2<NT));     ENDW(t+1); RESC(); ROT();
  }
  STEP(pB0,pB1,pA0,pA1,NT-1,false,false,false); RESC();
  { float sacc=pB0[0]+pB0[1]; _Pragma("unroll") for(int r=2;r<16;++r)sacc+=pB0[r]; _Pragma("unroll") for(int r=0;r<16;++r)sacc+=pB1[r]; l_reg+=sacc;
    pw0=(u32x4){PKW(pB0,0),PKW(pB0,2),PKW(pB0,4),PKW(pB0,6)};pw1=(u32x4){PKW(pB0,8),PKW(pB0,10),PKW(pB0,12),PKW(pB0,14)};pw2=(u32x4){PKW(pB1,0),PKW(pB1,2),PKW(pB1,4),PKW(pB1,6)};pw3=(u32x4){PKW(pB1,8),PKW(pB1,10),PKW(pB1,12),PKW(pB1,14)};
    SBAR(); pv(o,vb0+sl_cur,PAF(0),PAF(1),PAF(2),PAF(3)); }
  #undef PKW
  #undef PAF
  #undef VFR
  #undef PIN
  #undef MX3
  #undef GAPA
  #undef GAPB
  #undef EX
  #undef VRD
  #undef KRD
  #undef STEP
  #undef ENDW
  {auto rr=__builtin_amdgcn_permlane32_swap(__float_as_uint(l_reg),__float_as_uint(l_reg),false,false);l_reg=__uint_as_float(rr[0])+__uint_as_float(rr[1]);}
  if(hi==0)wsf[32+r32]=l_reg;asm volatile("s_waitcnt lgkmcnt(0)":::"memory");
  float rli[16];
  #pragma unroll
  for(int r=0;r<16;++r)rli[r]=__builtin_amdgcn_rcpf(wsf[32+crow(r,hi)]);
  bf16*Ow=O+(rowbase+q0+wid*QBLK)*ODM+h*D;
  { bf16*stg=(bf16*)(shm+LDS_OST)+wid*2048;
    #pragma unroll
    for(int r=0;r<16;++r){const int orow=crow(r,hi);
      #pragma unroll
      for(int d0=0;d0<2;++d0)stg[orow*64+d0*32+r32]=__float2bfloat16(o[d0][r]*rli[r]);}
    asm volatile("s_waitcnt lgkmcnt(0)":::"memory");
    #pragma unroll
    for(int i=0;i<4;++i){const int row=i*8+(lane>>3),ch=lane&7; const u32x4 v=*(const u32x4*)(stg+row*64+ch*8); ATTN_STORE16(Ow+(long)row*ODM+ch*8,v);} }
  asm volatile("s_waitcnt lgkmcnt(0)\n\ts_barrier":::"memory");
  #undef DMA_K
  #undef DMA_V
  #undef CMASK
  #undef START
  #undef RESC
  #undef ROT
  #undef CINIT
}
constexpr int ATTN_LDS_BYTES=LDS_FB+LDS_FB_BYTES;
struct AttnTensors { const bf16* Q; const bf16* K; const bf16* V; bf16* O; const float* FC; };
struct AttnUnit { int bh; int qb; };
struct StaticOrder {
  int vcu;
  __device__ __forceinline__ explicit StaticOrder(int vcu_):vcu(vcu_){}
  __device__ __forceinline__ bool next(int i,AttnUnit&u)const{ if(i>=4||vcu>=256)return false; const int s=vcu&3; u.bh=vcu>>2; u.qb=(i==0)?s:(i==1)?7-s:(i==2)?8+s:15-s; return true; }
};
template<class Sched,int THRL=8> __device__ __forceinline__ void attn_phase(char*lds,const AttnTensors&T,const Sched&S){
  AttnUnit u;
  for(int i=0;S.next(i,u);++i){ attn_unit<THRL>(u.bh/NHEAD,u.bh%NHEAD,u.qb,T.Q,T.K,T.V,T.O,T.FC+(long)u.bh*SEQ,lds); }
}
#undef SBAR
#undef WAIT_BAR
}

constexpr int NWAVES = 8;
#ifndef MK_PER_PHASE
#define MK_PER_PHASE 1
#endif
constexpr int BATCH = 8, SEQ = 4096, T = BATCH * SEQ, D = 1024, NL = 2, NH = 8, HD = 64, AW = 512, PW = 512, INW = 2056, NG = 4, NE = 8, NX = 32, FE = 256;
constexpr float RMS_EPS = 1e-6f;
constexpr int NPH = 16;
constexpr size_t MiB = 1u << 20;
constexpr size_t WS_CTL = 0, CTL_ZERO_BYTES = 1 * MiB;
constexpr size_t WS_MOD = 1 * MiB;
constexpr size_t WS_FRF = 1 * MiB + 512 * 1024;
constexpr size_t WS_RRF = WS_FRF + 128 * 1024;
constexpr size_t WS_FL = 2 * MiB;
constexpr size_t WS_FC = 3 * MiB;
constexpr size_t WS_CW = 4 * MiB;
constexpr size_t WS_LIST = 5 * MiB;
constexpr size_t WS_WIN = 10 * MiB, WS_WOUT = 18 * MiB, WS_WGU = 22 * MiB, WS_WD = 86 * MiB;
constexpr size_t WS_H = 118 * MiB;
constexpr size_t WS_QKVU = 182 * MiB;
constexpr size_t WS_AO = 310 * MiB;
constexpr size_t WS_END = 374 * MiB;
constexpr int CW_TMO = 0, CW_CODE = 1, CW_BAR = 4096, CW_CNT = 16384;
constexpr int RING_OFF = 0, RING_BYTES = 131072;
constexpr int LDSCTL_OFF = RING_BYTES, MISC_OFF = LDSCTL_OFF + 320;
constexpr int ENT_OFF = LDSCTL_OFF + 1024, ENT_UNITS = 6;
constexpr int CWT_OFF = ENT_OFF + ENT_UNITS * 1024;
constexpr int TST_OFF = CWT_OFF + 3 * 1024;
constexpr int LDS_BYTES = 147456;
static_assert(TST_OFF + 65 * 4 <= LDS_BYTES && MISC_OFF + 128 <= ENT_OFF, "LDS map");

#define GAS __attribute__((address_space(1)))
#define LAS __attribute__((address_space(3)))
typedef unsigned short bf16;
typedef unsigned v4u __attribute__((ext_vector_type(4)));
typedef float f32x4 __attribute__((ext_vector_type(4)));
typedef short bf16x8 __attribute__((ext_vector_type(8)));
typedef GAS unsigned gu32;
typedef GAS unsigned long long gu64;
#define RLX_AGENT __ATOMIC_RELAXED, __HIP_MEMORY_SCOPE_AGENT
#define LDS_WAIT() asm volatile("s_waitcnt lgkmcnt(0)" ::: "memory")
#define VM_WAIT() asm volatile("s_waitcnt vmcnt(0)" ::: "memory")
__device__ __forceinline__ unsigned long long rt() { return __builtin_amdgcn_s_memrealtime(); }
__device__ __forceinline__ unsigned f2bf(float f) { unsigned u = __builtin_bit_cast(unsigned, f); return (u + 0x7fffu + ((u >> 16) & 1u)) >> 16; }
__device__ __forceinline__ unsigned pk2(float lo, float hi) { return f2bf(lo) | (f2bf(hi) << 16); }

#define XB_TMO      128
#define XB_XCNT(j)  (256  + 64 * (j))
#define XB_XSUB(j)  (1280 + 64 * (j))
#define XB_XGEN(j)  (2304 + 64 * (j))
#define XB_TOP      3328
#define XB_TOPGEN   3392
#define XCD_BAR_WORDS 3456
#define XB_SPIN_CAP (1u << 18)

__device__ __forceinline__ unsigned xb_ld(unsigned* p)              { return __hip_atomic_load(p, __ATOMIC_RELAXED, __HIP_MEMORY_SCOPE_AGENT); }
__device__ __forceinline__ unsigned xb_add(unsigned* p, unsigned v) { return __hip_atomic_fetch_add(p, v, __ATOMIC_RELAXED, __HIP_MEMORY_SCOPE_AGENT); }
__device__ __forceinline__ unsigned xb_xcc_id() { return (unsigned)__builtin_amdgcn_s_getreg((3 << 11) | 20) & 0xFu; }
#define XB_SPIN(cond, bar) do { unsigned _sp = 0; while (cond) { __builtin_amdgcn_s_sleep(1); \
    if ((++_sp & 255u) == 0u) { if (xb_ld(&(bar)[XB_TMO])) break; if (_sp > XB_SPIN_CAP) { atomicAdd(&(bar)[XB_TMO], 1u); break; } } } } while (0)

struct XcdBarrier {
    unsigned* bar; unsigned x;
    volatile LAS unsigned* st;
};

__device__ __forceinline__ XcdBarrier xcd_barrier_post(unsigned* bar, volatile LAS unsigned* st) {
    XcdBarrier b; b.bar = bar; b.x = xb_xcc_id(); b.st = st;
    if (threadIdx.x == 0) (void)xb_add(&bar[XB_XCNT(b.x)], 1u);
    return b;
}
__device__ __forceinline__ void xcd_barrier_complete(unsigned* bar, unsigned x, unsigned& nloc, unsigned& nx) {
    const unsigned G = gridDim.x * gridDim.y * gridDim.z;
    unsigned sum, cnt, mine, sp = 0u;
    for (;;) {
        sum = 0u; cnt = 0u; mine = 0u;
#pragma unroll
        for (unsigned j = 0; j < 16; ++j) { const unsigned c = xb_ld(&bar[XB_XCNT(j)]); sum += c; cnt += (c > 0u) ? 1u : 0u; mine = (j == x) ? c : mine; }
        if (sum == G) break;
        __builtin_amdgcn_s_sleep(1);
        if ((++sp & 255u) == 0u) { if (xb_ld(&bar[XB_TMO])) break; if (sp > XB_SPIN_CAP) { atomicAdd(&bar[XB_TMO], 1u); break; } }
    }
    nloc = mine > 0u ? mine : 1u; nx = cnt > 0u ? cnt : 1u;
}

__device__ __forceinline__ void xcd_barrier(const XcdBarrier& b) {
    asm volatile("s_waitcnt vmcnt(0)" ::: "memory");
    __syncthreads();
    if (threadIdx.x == 0) {
        unsigned* bar = b.bar;
        __builtin_amdgcn_s_waitcnt(0);
        unsigned nloc = b.st[0], nx = b.st[1];
        if (nloc == 0u) { xcd_barrier_complete(bar, b.x, nloc, nx); b.st[0] = nloc; b.st[1] = nx; }
        const unsigned old = xb_add(&bar[XB_XSUB(b.x)], 1u);
        const unsigned gen = old / nloc;
        if (old + 1u == (gen + 1u) * nloc) {
            __builtin_amdgcn_fence(__ATOMIC_RELEASE, "agent");
            asm volatile("s_waitcnt vmcnt(0)" ::: "memory");
            const unsigned og = xb_add(&bar[XB_TOP], 1u);
            const unsigned tg = og / nx;
            if (og + 1u == (tg + 1u) * nx) xb_add(&bar[XB_TOPGEN], 1u);
            else XB_SPIN(xb_ld(&bar[XB_TOPGEN]) == tg, bar);
            __builtin_amdgcn_fence(__ATOMIC_ACQUIRE, "agent");
            xb_add(&bar[XB_XGEN(b.x)], 1u);
            asm volatile("s_waitcnt vmcnt(0)" ::: "memory");
        } else {
            XB_SPIN(xb_ld(&bar[XB_XGEN(b.x)]) == gen, bar);
            __builtin_amdgcn_fence(__ATOMIC_ACQUIRE, "agent");
            asm volatile("s_waitcnt vmcnt(0)" ::: "memory");
        }
    }
    __syncthreads();
}

struct Frame {
    LAS unsigned char* lds;
    volatile LAS unsigned* MISC;
    gu32* ctl;
    int tid, lane, wave;
    int vcu, G;
};
typedef unsigned u32x4v __attribute__((ext_vector_type(4)));
__device__ __forceinline__ float bflo(unsigned w) { return __builtin_bit_cast(float, w << 16); }
__device__ __forceinline__ float bfhi(unsigned w) { return __builtin_bit_cast(float, w & 0xffff0000u); }
__device__ __forceinline__ unsigned cvtpk(float lo, float hi) { unsigned r; asm volatile("v_cvt_pk_bf16_f32 %0, %1, %2" : "=v"(r) : "v"(lo), "v"(hi)); return r; }

__device__ __forceinline__ void transpose_item(const float* W, int ldw, bf16* WT, int ldt, int k0, int n0src, int dstrow0, LAS float* scr, int lane) {
#pragma unroll 8
    for (int i = 0; i < 32; ++i) { const int kk = 2 * i + (lane >> 5); scr[kk * 33 + (lane & 31)] = W[(size_t)(k0 + kk) * ldw + n0src + (lane & 31)]; }
    LDS_WAIT(); asm volatile("" ::: "memory");
    const int c = lane & 7;
#pragma unroll
    for (int j = 0; j < 4; ++j) { const int n = (lane >> 3) + 8 * j; const LAS float* s = scr + (8 * c) * 33 + n;
        v4u o; o.x = pk2(s[0 * 33], s[1 * 33]); o.y = pk2(s[2 * 33], s[3 * 33]); o.z = pk2(s[4 * 33], s[5 * 33]); o.w = pk2(s[6 * 33], s[7 * 33]);
        *(GAS v4u*)(WT + (size_t)(dstrow0 + n) * ldt + k0 + 8 * c) = o; }
    LDS_WAIT(); asm volatile("" ::: "memory");
}
struct In {
    const float *x, *c, *g_mix, *g_ffn, *g_fin, *w_ada, *b_ada, *w_in, *b_fg, *w_pool, *pool_scale, *w_out, *w_rg, *b_rg, *w_re, *b_re, *w_eg, *w_eu, *w_ed;
};
__device__ __forceinline__ void p0_prologue(Frame& F, const In& I, unsigned char* ws) {
    bf16* WinT = (bf16*)(ws + WS_WIN); bf16* WoutT = (bf16*)(ws + WS_WOUT); bf16* WguT = (bf16*)(ws + WS_WGU); bf16* WdT = (bf16*)(ws + WS_WD);
    float* MOD = (float*)(ws + WS_MOD);
    if (F.vcu < 64) {
        const int l = F.vcu >> 5, g = (F.vcu >> 3) & 3, nb = F.vcu & 7;
        LAS float* ApT = (LAS float*)F.lds;
        const float* wp = I.w_pool + (size_t)(l * 4 + g) * 128 * 128; const float* ps = I.pool_scale + l * 512 + g * 128;
        for (int q = F.tid; q < 128 * 128; q += NWAVES * 64) { const int c = q >> 7, d = q & 127; ApT[d * 128 + c] = wp[q] * ps[d]; }
        __syncthreads();
        const int n = 128 * nb + (F.tid & 127), cq = F.tid >> 7;
        const float* wo = I.w_out + (size_t)l * D * D + (size_t)(512 + 128 * g) * D + n;
        float acc[32];
#pragma unroll
        for (int i = 0; i < 32; ++i) acc[i] = 0.f;
        for (int d = 0; d < 128; ++d) { const float bv = wo[(size_t)d * D];
#pragma unroll
            for (int i = 0; i < 8; ++i) { const f32x4 a = *(const LAS f32x4*)(ApT + d * 128 + 32 * cq + 4 * i);
                acc[4 * i + 0] += a[0] * bv; acc[4 * i + 1] += a[1] * bv; acc[4 * i + 2] += a[2] * bv; acc[4 * i + 3] += a[3] * bv; } }
        bf16* dst = WoutT + (size_t)l * D * D + (size_t)n * D + 512 + 128 * g + 32 * cq;
#pragma unroll
        for (int i = 0; i < 4; ++i) { v4u o; o.x = pk2(acc[8 * i + 0], acc[8 * i + 1]); o.y = pk2(acc[8 * i + 2], acc[8 * i + 3]); o.z = pk2(acc[8 * i + 4], acc[8 * i + 5]); o.w = pk2(acc[8 * i + 6], acc[8 * i + 7]);
            *(GAS v4u*)(dst + 8 * i) = o; }
        __syncthreads();
    } else if (F.vcu < 256) {
        const int it = F.vcu - 64, l = it / 96, n0 = 64 * (it % 96);
        LAS float* cT = (LAS float*)F.lds;
        LAS float* part = (LAS float*)(F.lds + 32768);
        for (int q = F.tid; q < 8 * 1024; q += NWAVES * 64) { const int b = q >> 10, k = q & 1023; const float v = I.c[q]; cT[k * 8 + b] = v / (1.f + __expf(-v)); }
        __syncthreads();
        const float* w = I.w_ada + (size_t)l * D * 6144 + n0 + F.lane;
        float acc[8];
#pragma unroll
        for (int b = 0; b < 8; ++b) acc[b] = 0.f;
#pragma unroll 8
        for (int kk = 0; kk < 128; ++kk) { const int k = F.wave * 128 + kk; const float wv = w[(size_t)k * 6144];
            const f32x4 c0 = *(const LAS f32x4*)(cT + k * 8), c1 = *(const LAS f32x4*)(cT + k * 8 + 4);
            acc[0] += c0[0] * wv; acc[1] += c0[1] * wv; acc[2] += c0[2] * wv; acc[3] += c0[3] * wv; acc[4] += c1[0] * wv; acc[5] += c1[1] * wv; acc[6] += c1[2] * wv; acc[7] += c1[3] * wv; }
#pragma unroll
        for (int b = 0; b < 8; ++b) part[(F.wave * 8 + b) * 64 + F.lane] = acc[b];
        __syncthreads();
        { const int b = F.wave; float s = I.b_ada[l * 6144 + n0 + F.lane];
#pragma unroll
            for (int sl = 0; sl < 8; ++sl) s += part[(sl * 8 + b) * 64 + F.lane];
            MOD[(size_t)(l * 8 + b) * 6144 + n0 + F.lane] = s; }
        __syncthreads();
    }
    { const int q = F.vcu * (NWAVES * 64) + F.tid;
      if (q < NL * 32 * 4 * 64) {
        const int l = q >> 13, c = (q >> 8) & 31, nb4 = (q >> 6) & 3, ln = q & 63; const int n = ln & 15, k0 = 32 * c + 8 * (ln >> 4);
        float v[8];
#pragma unroll
        for (int j = 0; j < 8; ++j) { const int k = k0 + j; float w = 0.f;
            if (nb4 == 3) { if (n < 8) w = I.w_in[(size_t)l * D * INW + (size_t)k * INW + 1536 + n]; }
            else { const int col = 16 * nb4 + n;
                if (col < 4) w = I.w_rg[(size_t)l * D * 4 + k * 4 + col];
                else if (col < 36) { const int g = (col - 4) >> 3, e = (col - 4) & 7; w = I.w_re[((size_t)(l * 4 + g) * D + k) * 8 + e]; } }
            v[j] = w; }
        unsigned hi[4], lo[4];
#pragma unroll
        for (int j = 0; j < 4; ++j) { hi[j] = pk2(v[2 * j], v[2 * j + 1]); lo[j] = pk2(v[2 * j] - bflo(hi[j]), v[2 * j + 1] - bfhi(hi[j])); }
        v4u* dst = (nb4 == 3) ? (v4u*)(ws + WS_FRF) + ((size_t)(l * 32 + c) * 2) * 64 + ln : (v4u*)(ws + WS_RRF) + (((size_t)(l * 32 + c) * 3 + nb4) * 2) * 64 + ln;
        dst[0] = (v4u){hi[0], hi[1], hi[2], hi[3]}; dst[64] = (v4u){lo[0], lo[1], lo[2], lo[3]};
      } }
    LAS float* scr = (LAS float*)(F.lds + RING_OFF + F.wave * 16384);
    const int gw = F.vcu * NWAVES + F.wave, NGW = F.G * NWAVES;
    constexpr int IT_IN = 1024, IT_OUT = 256, IT_E = 4096, IT_L = IT_IN + IT_OUT + 3 * IT_E;
    for (int it = gw; it < NL * IT_L; it += NGW) {
        const int l = it / IT_L; int r = it - l * IT_L;
        if (r < IT_IN) { const int kb = r >> 6, nb = r & 63; const int n0 = 32 * nb;
            transpose_item(I.w_in + (size_t)l * D * INW, INW, WinT + (size_t)l * 2048 * D, D, 64 * kb, n0 < 1536 ? n0 : n0 + 8, n0, scr, F.lane); continue; }
        r -= IT_IN;
        if (r < IT_OUT) { const int kb = r >> 5, nb = r & 31;
            transpose_item(I.w_out + (size_t)l * D * D, D, WoutT + (size_t)l * D * D, D, 64 * kb, 32 * nb, 32 * nb, scr, F.lane); continue; }
        r -= IT_OUT;
        if (r < 2 * IT_E) { const int up = r >= IT_E; if (up) r -= IT_E; const int e = r >> 7, q = r & 127, kb = q >> 3, nb = q & 7, n0 = 32 * nb;
            transpose_item((up ? I.w_eu : I.w_eg) + (size_t)(l * NX + e) * D * FE, FE, WguT + (size_t)(l * NX + e) * 512 * D, D, 64 * kb, n0, 256 * (n0 >> 7) + (n0 & 127) + (up ? 128 : 0), scr, F.lane); continue; }
        r -= 2 * IT_E;
        { const int e = r >> 7, q = r & 127, kb = q >> 5, nb = q & 31;
            transpose_item(I.w_ed + (size_t)(l * NX + e) * FE * D, D, WdT + (size_t)(l * NX + e) * D * FE, FE, 64 * kb, 32 * nb, 32 * nb, scr, F.lane); }
    }
}

struct NormArgs {
    const float* xin; float* xw;
    const bf16* Y0; const bf16* Y1; const float* gate;
    const float* gamma; const float* scale; const float* shift;
    bf16* H; const v4u* frag;
    const float* bias0; const float* bias1;
    float* FL; float* CW; unsigned* LIST; gu32* cnt;
};
template <bool ADD_Y, bool WRITE_X, int NB, bool FINAL>
__device__ __forceinline__ void norm_phase(Frame& F, const NormArgs& A) {
    LAS float* gm = (LAS float*)F.lds; LAS float* shl = gm + 1024; LAS float* gtl = shl + 1024;
    LAS float* LG = (LAS float*)(F.lds + 16384);
    LAS int* lcnt = (LAS int*)(F.lds + 40960); LAS int* gbase = lcnt + 32;
    const int tok0 = F.vcu * 128, b = tok0 >> 12;
    for (int k = F.tid; k < 1024; k += NWAVES * 64) {
        gm[k] = FINAL ? A.gamma[k] : A.gamma[k] * (1.f + A.scale[(size_t)b * 6144 + k]); shl[k] = FINAL ? 0.f : A.shift[(size_t)b * 6144 + k];
        if (ADD_Y) gtl[k] = A.gate[(size_t)b * 6144 + k]; }
    if (NB == 3 && F.tid < 32) lcnt[F.tid] = 0;
    __syncthreads();
    const int i16 = F.lane & 15, kq = F.lane >> 4; const int tok = tok0 + F.wave * 16 + i16;
    const float* xr = A.xin + (size_t)tok * D + 8 * kq; float* xwr = A.xw + (size_t)tok * D + 8 * kq;
    float ss = 0.f;
#pragma unroll 4
    for (int c = 0; c < 32; ++c) {
        f32x4 a0 = *(const f32x4*)(xr + 32 * c), a1 = *(const f32x4*)(xr + 32 * c + 4);
        if (ADD_Y) { const v4u y0 = *(const v4u*)(A.Y0 + (size_t)tok * D + 32 * c + 8 * kq), y1 = *(const v4u*)(A.Y1 + (size_t)tok * D + 32 * c + 8 * kq);
            const f32x4 g0 = *(const LAS f32x4*)(gtl + 32 * c + 8 * kq), g1 = *(const LAS f32x4*)(gtl + 32 * c + 8 * kq + 4);
            a0[0] += g0[0] * (bflo(y0.x) + bflo(y1.x)); a0[1] += g0[1] * (bfhi(y0.x) + bfhi(y1.x)); a0[2] += g0[2] * (bflo(y0.y) + bflo(y1.y)); a0[3] += g0[3] * (bfhi(y0.y) + bfhi(y1.y));
            a1[0] += g1[0] * (bflo(y0.z) + bflo(y1.z)); a1[1] += g1[1] * (bfhi(y0.z) + bfhi(y1.z)); a1[2] += g1[2] * (bflo(y0.w) + bflo(y1.w)); a1[3] += g1[3] * (bfhi(y0.w) + bfhi(y1.w)); }
        if (WRITE_X) { *(f32x4*)(xwr + 32 * c) = a0; *(f32x4*)(xwr + 32 * c + 4) = a1; }
        ss += (a0[0] * a0[0] + a0[1] * a0[1]) + (a0[2] * a0[2] + a0[3] * a0[3]) + (a1[0] * a1[0] + a1[1] * a1[1]) + (a1[2] * a1[2] + a1[3] * a1[3]);
    }
    ss += __shfl_xor(ss, 16); ss += __shfl_xor(ss, 32);
    const float rstd = 1.0f / sqrtf(ss * (1.0f / D) + RMS_EPS);
    const float* xr2 = WRITE_X ? (const float*)xwr : xr;
    f32x4 acc[NB > 0 ? NB : 1];
#pragma unroll
    for (int nb = 0; nb < (NB > 0 ? NB : 1); ++nb) acc[nb] = (f32x4){0.f, 0.f, 0.f, 0.f};
#pragma unroll 2
    for (int c = 0; c < 32; ++c) {
        const f32x4 a0 = *(const f32x4*)(xr2 + 32 * c), a1 = *(const f32x4*)(xr2 + 32 * c + 4);
        const f32x4 m0 = *(const LAS f32x4*)(gm + 32 * c + 8 * kq), m1 = *(const LAS f32x4*)(gm + 32 * c + 8 * kq + 4);
        const f32x4 s0 = *(const LAS f32x4*)(shl + 32 * c + 8 * kq), s1 = *(const LAS f32x4*)(shl + 32 * c + 8 * kq + 4);
        const f32x4 h0 = a0 * rstd * m0 + s0, h1 = a1 * rstd * m1 + s1;
        if (FINAL) { *(f32x4*)(xwr + 32 * c) = h0; *(f32x4*)(xwr + 32 * c + 4) = h1; }
        else {
            v4u hi; hi.x = cvtpk(h0[0], h0[1]); hi.y = cvtpk(h0[2], h0[3]); hi.z = cvtpk(h1[0], h1[1]); hi.w = cvtpk(h1[2], h1[3]);
            *(v4u*)(A.H + (size_t)tok * D + 32 * c + 8 * kq) = hi;
            if constexpr (NB > 0) {
                v4u lo; lo.x = cvtpk(h0[0] - bflo(hi.x), h0[1] - bfhi(hi.x)); lo.y = cvtpk(h0[2] - bflo(hi.y), h0[3] - bfhi(hi.y));
                lo.z = cvtpk(h1[0] - bflo(hi.z), h1[1] - bfhi(hi.z)); lo.w = cvtpk(h1[2] - bflo(hi.w), h1[3] - bfhi(hi.w));
                const bf16x8 Ah = __builtin_bit_cast(bf16x8, hi), Al = __builtin_bit_cast(bf16x8, lo);
#pragma unroll
                for (int nb = 0; nb < NB; ++nb) {
                    const bf16x8 Bh = __builtin_bit_cast(bf16x8, A.frag[((size_t)(c * NB + nb) * 2 + 0) * 64 + F.lane]), Bl = __builtin_bit_cast(bf16x8, A.frag[((size_t)(c * NB + nb) * 2 + 1) * 64 + F.lane]);
                    acc[nb] = __builtin_amdgcn_mfma_f32_16x16x32_bf16(Ah, Bh, acc[nb], 0, 0, 0);
                    acc[nb] = __builtin_amdgcn_mfma_f32_16x16x32_bf16(Al, Bh, acc[nb], 0, 0, 0);
                    acc[nb] = __builtin_amdgcn_mfma_f32_16x16x32_bf16(Ah, Bl, acc[nb], 0, 0, 0); }
            }
        }
    }
    if constexpr (NB == 1) {
        if (i16 < 8) { const float bb = A.bias0[i16];
#pragma unroll
            for (int r = 0; r < 4; ++r) { const float z = acc[0][r] + bb; const float ls = fminf(z, 0.f) - log1pf(__expf(-fabsf(z)));
                A.FL[(size_t)(tok0 + F.wave * 16 + 4 * kq + r) * 8 + i16] = ls; } }
    }
    if constexpr (NB == 3) {
        LAS float* lg = LG + F.wave * 768;
#pragma unroll
        for (int nb = 0; nb < 3; ++nb)
#pragma unroll
            for (int r = 0; r < 4; ++r) lg[(4 * kq + r) * 48 + 16 * nb + i16] = acc[nb][r];
        LDS_WAIT(); asm volatile("" ::: "memory");
        int e0 = 0, e1 = 0, r0 = 0, r1 = 0; float w0 = 0.f, w1 = 0.f;
        if (F.lane < 16) {
            const LAS float* row = lg + F.lane * 48;
            const float l0 = row[0] + A.bias0[0], l1 = row[1] + A.bias0[1], l2 = row[2] + A.bias0[2], l3 = row[3] + A.bias0[3];
            int g = 0; float mx = l0; if (l1 > mx) { mx = l1; g = 1; } if (l2 > mx) { mx = l2; g = 2; } if (l3 > mx) { mx = l3; g = 3; }
            const float top_p = 1.f / (__expf(l0 - mx) + __expf(l1 - mx) + __expf(l2 - mx) + __expf(l3 - mx));
            float v1 = -INFINITY, v2 = -INFINITY; int i1 = 0, i2 = 0;
#pragma unroll
            for (int j = 0; j < 8; ++j) { const float v = row[4 + 8 * g + j] + A.bias1[8 * g + j];
                if (v > v1) { v2 = v1; i2 = i1; v1 = v; i1 = j; } else if (v > v2) { v2 = v; i2 = j; } }
            const float e21 = __expf(v2 - v1), ew1 = 1.f / (1.f + e21);
            w0 = top_p * ew1; w1 = top_p * (e21 * ew1); e0 = 8 * g + i1; e1 = 8 * g + i2;
            r0 = __hip_atomic_fetch_add(lcnt + e0, 1, __ATOMIC_RELAXED, __HIP_MEMORY_SCOPE_WORKGROUP);
            r1 = __hip_atomic_fetch_add(lcnt + e1, 1, __ATOMIC_RELAXED, __HIP_MEMORY_SCOPE_WORKGROUP);
        }
        __syncthreads();
        if (F.tid < 32) gbase[F.tid] = (int)__hip_atomic_fetch_add(A.cnt + 64 * F.tid, (unsigned)lcnt[F.tid], __ATOMIC_RELAXED, __HIP_MEMORY_SCOPE_AGENT);
        __syncthreads();
        if (F.lane < 16) { const int tk = tok0 + F.wave * 16 + F.lane;
            A.LIST[(size_t)e0 * T + gbase[e0] + r0] = 2u * tk; A.LIST[(size_t)e1 * T + gbase[e1] + r1] = 2u * tk + 1u;
            A.CW[2 * tk] = w0; A.CW[2 * tk + 1] = w1; }
    }
    __syncthreads();
}

__device__ __forceinline__ void cumsum_unit(Frame& F, int bh, const float* FL, float* FC) {
    LAS double* wsum = (LAS double*)F.lds;
    const int b = bh >> 3, h = bh & 7;
    double p[8]; double run = 0.0;
#pragma unroll
    for (int j = 0; j < 8; ++j) { run += (double)FL[((size_t)b * SEQ + 8 * F.tid + j) * 8 + h]; p[j] = run; }
    double s = run;
#pragma unroll
    for (int o = 1; o < 64; o <<= 1) { const double nb = __shfl_up(s, o); if (F.lane >= o) s += nb; }
    if (F.lane == 63) wsum[F.wave] = s;
    __syncthreads();
    double off = s - run;
    for (int w = 0; w < F.wave; ++w) off += wsum[w];
#pragma unroll
    for (int j = 0; j < 8; ++j) FC[(size_t)bh * SEQ + 8 * F.tid + j] = (float)((off + p[j]) * 1.4426950408889634);
    __syncthreads();
}
__device__ __forceinline__ void pooldiff_unit(Frame& F, const bf16* U, bf16* AO) {
    const int cc = F.tid & 63, tl = F.tid >> 6; const int w = 2 << (cc >> 4);
    const int t0 = F.vcu * 128 + 16 * tl, pos0 = t0 & (SEQ - 1);
    const bf16* up = U + 8 * cc;
    float sum[8];
#pragma unroll
    for (int j = 0; j < 8; ++j) sum[j] = 0.f;
#define ADD8(sgn, tt) do { const v4u v_ = *(const v4u*)(up + (size_t)(tt) * 512); \
        sum[0] += sgn bflo(v_.x); sum[1] += sgn bfhi(v_.x); sum[2] += sgn bflo(v_.y); sum[3] += sgn bfhi(v_.y); sum[4] += sgn bflo(v_.z); sum[5] += sgn bfhi(v_.z); sum[6] += sgn bflo(v_.w); sum[7] += sgn bfhi(v_.w); } while (0)
    for (int j = 1; j < w; ++j) if (pos0 - j >= 0) ADD8(+, t0 - j);
    for (int s = 0; s < 16; ++s) { const int t = t0 + s, pos = pos0 + s;
        const v4u v = *(const v4u*)(up + (size_t)t * 512);
        const float u0 = bflo(v.x), u1 = bfhi(v.x), u2 = bflo(v.y), u3 = bfhi(v.y), u4 = bflo(v.z), u5 = bfhi(v.z), u6 = bflo(v.w), u7 = bfhi(v.w);
        sum[0] += u0; sum[1] += u1; sum[2] += u2; sum[3] += u3; sum[4] += u4; sum[5] += u5; sum[6] += u6; sum[7] += u7;
        const float rc = 1.0f / (float)((pos + 1) < w ? (pos + 1) : w);
        v4u o; o.x = pk2(sum[0] * rc - u0, sum[1] * rc - u1); o.y = pk2(sum[2] * rc - u2, sum[3] * rc - u3); o.z = pk2(sum[4] * rc - u4, sum[5] * rc - u5); o.w = pk2(sum[6] * rc - u6, sum[7] * rc - u7);
        *(v4u*)(AO + (size_t)t * D + 512 + 8 * cc) = o;
        if (pos - w + 1 >= 0) ADD8(-, t - w + 1); }
#undef ADD8
}

template <bool WITH_CW>
__device__ __forceinline__ void moe_tables(Frame& F, pg8::MoeSched& S, int l, int npn, const char* W, size_t estride, size_t pnstride, const unsigned* LIST, const float* CW) {
    LAS unsigned* ent = (LAS unsigned*)(F.lds + ENT_OFF); LAS float* cwt = (LAS float*)(F.lds + CWT_OFF);
    LAS int* tstart = (LAS int*)(F.lds + TST_OFF); LAS int* cntl = tstart + 33;
    if (F.tid < 32) { const unsigned c = __hip_atomic_load(F.ctl + CW_CNT + 64 * (l * 32 + F.tid), RLX_AGENT); cntl[F.tid] = (int)(c < (unsigned)T ? c : (unsigned)T); }
    __syncthreads();
    if (F.tid == 0) { int s = 0; for (int e = 0; e < 32; ++e) { tstart[e] = s; s += (cntl[e] + 255) >> 8; } tstart[32] = s; }
    __syncthreads();
    S.tstart = tstart; S.cntl = cntl; S.G = F.G; S.c = F.vcu; S.npn = npn; S.W = W; S.estride = estride; S.pnstride = pnstride; S.total = tstart[32] * npn;
    pg8::MUnit u;
    for (int i = 0; i < ENT_UNITS && S.next(i, u); ++i) { const int r0 = S.row0(i);
        for (int r = F.tid; r < 256; r += NWAVES * 64) { const unsigned en = LIST[(size_t)u.e * T + r0 + (r < u.nrows ? r : 0)]; ent[i * 256 + r] = en; if (WITH_CW) cwt[i * 256 + r] = CW[en]; } }
    __syncthreads();
}
struct Args { In in; float* out; unsigned char* ws; int ph_lo, ph_hi; };
typedef const __attribute__((address_space(4))) Args* KArgP;
__device__ __forceinline__ KArgP KA() { KArgP p = (KArgP)__builtin_amdgcn_kernarg_segment_ptr(); asm volatile("" : "+s"(p)); return p; }
#define WSP   (KA()->ws)
#define XRES  (KA()->out)
#define MODP  ((float*)(WSP + WS_MOD))
#define HB    ((bf16*)(WSP + WS_H))
#define QB_   ((bf16*)(WSP + WS_QKVU))
#define YB    ((bf16*)(WSP + WS_QKVU))
#define AOB   ((bf16*)(WSP + WS_AO))
#define ACTB  ((bf16*)(WSP + WS_AO))
#define FLP   ((float*)(WSP + WS_FL))
#define FCP   ((float*)(WSP + WS_FC))
#define CWP   ((float*)(WSP + WS_CW))
#define LISTP ((unsigned*)(WSP + WS_LIST))
__global__ void __launch_bounds__(NWAVES * 64, 2) mk_fwd(Args args_unused) {
    extern __shared__ __attribute__((aligned(16))) unsigned char lds[];
    Frame F;
    F.lds = (LAS unsigned char*)lds;
    F.MISC = (volatile LAS unsigned*)(F.lds + MISC_OFF);
    F.tid = threadIdx.x; F.lane = F.tid & 63; F.wave = __builtin_amdgcn_readfirstlane(F.tid >> 6);
    F.G = gridDim.x; { const int bx = blockIdx.x; F.vcu = (F.G % 8 == 0) ? (bx % 8) * (F.G / 8) + bx / 8 : bx; }
    F.ctl = (gu32*)(KA()->ws + WS_CTL);
    for (int u = F.tid; u < (LDS_BYTES - LDSCTL_OFF) / 4; u += NWAVES * 64) ((LAS unsigned*)(F.lds + LDSCTL_OFF))[u] = 0u;
    __syncthreads();
    XcdBarrier bar; bar.bar = (unsigned*)(F.ctl + CW_BAR); bar.x = 0; bar.st = nullptr;
    if (!MK_PER_PHASE) bar = xcd_barrier_post((unsigned*)(F.ctl + CW_BAR), F.MISC + 8);
#define GRID_BAR() do { if (!MK_PER_PHASE) { XcdBarrier b_ = bar; unsigned* p_ = b_.bar; unsigned x_ = b_.x; asm volatile("" : "+s"(p_), "+s"(x_)); b_.bar = p_; b_.x = x_; xcd_barrier(b_); } } while (0)
    const int lo = KA()->ph_lo, hi = KA()->ph_hi;
#ifndef PHASE_MASK
#define PHASE_MASK 0xFFFF
#endif
#define IN(k) ((((PHASE_MASK) >> ((k) > 7 && (k) < 15 ? (k) - 7 : (k))) & 1) && lo <= (k) && (k) < hi)
#define SEAM(k) do { if (IN(k) && IN((k) + 1)) GRID_BAR(); } while (0)
#define PHASE_BEGIN() do { int w_ = F.wave, v_ = F.vcu, g_ = F.G; asm volatile("" : "+v"(F.tid), "+v"(F.lane), "+v"(w_), "+v"(v_), "+v"(g_)); \
        F.wave = __builtin_amdgcn_readfirstlane(w_); F.vcu = __builtin_amdgcn_readfirstlane(v_); F.G = __builtin_amdgcn_readfirstlane(g_); } while (0)
    if (IN(0)) { PHASE_BEGIN(); const In I = *(const In*)(const void*)(&KA()->in); p0_prologue(F, I, WSP); SEAM(0); }

#pragma nounroll
    for (int l = 0; l < NL; ++l) {
        const int pb = 1 + 7 * l;
        if (IN(pb + 0)) { PHASE_BEGIN();
            const float* modl = MODP + (size_t)l * 8 * 6144; float* X = XRES;
            NormArgs A{}; A.gamma = KA()->in.g_mix + l * D; A.scale = modl + 1024; A.shift = modl; A.H = HB; A.frag = (const v4u*)(WSP + WS_FRF) + (size_t)l * 32 * 2 * 64;
            A.bias0 = KA()->in.b_fg + l * 8; A.FL = FLP;
            if (l == 0) { A.xin = KA()->in.x; A.xw = X; norm_phase<false, false, 1, false>(F, A); }
            else { A.xin = X; A.xw = X; A.Y0 = YB; A.Y1 = YB + (size_t)T * D; A.gate = MODP + (size_t)(l - 1) * 8 * 6144 + 5120; norm_phase<true, true, 1, false>(F, A); }
            SEAM(pb + 0);
        }
        if (IN(pb + 1)) { PHASE_BEGIN();
            pg8::Gemm g{HB, (const bf16*)(WSP + WS_WIN) + (size_t)l * 2048 * D, T, 2048, D}; pg8::StaticOrder S; S.init(T, 2048, F.G, (int)blockIdx.x);
            pg8::EpiQKVU E{QB_, 512, 512, (size_t)T * 512, attn_body::C2};
            pg8::gemm_phase<pg8::EpiQKVU, pg8::StaticOrder, true, true>(F.lds + RING_OFF, g, S, E);
            if (F.vcu < 64) cumsum_unit(F, F.vcu, FLP, FCP);
            SEAM(pb + 1);
        }
        if (IN(pb + 2)) { PHASE_BEGIN();
            pooldiff_unit(F, QB_ + (size_t)3 * T * 512, AOB);
            const attn_body::AttnTensors AT{(const attn_body::bf16*)QB_, (const attn_body::bf16*)(QB_ + (size_t)T * 512), (const attn_body::bf16*)(QB_ + (size_t)2 * T * 512), (attn_body::bf16*)AOB, FCP};
            const attn_body::StaticOrder S(F.vcu);
            attn_body::attn_phase<attn_body::StaticOrder>((char*)lds + RING_OFF, AT, S);
            SEAM(pb + 2);
        }
        if (IN(pb + 3)) { PHASE_BEGIN();
            pg8::Gemm g{AOB, (const bf16*)(WSP + WS_WOUT) + (size_t)l * D * D, T, D, D}; pg8::StaticOrder S; S.init(T, D, F.G, (int)blockIdx.x);
            float* X = XRES; pg8::EpiResGate E{l == 0 ? KA()->in.x : (const float*)X, X, MODP + (size_t)l * 8 * 6144 + 2048, 6144};
            pg8::gemm_phase<pg8::EpiResGate, pg8::StaticOrder, true, true>(F.lds + RING_OFF, g, S, E);
            SEAM(pb + 3);
        }
        if (IN(pb + 4)) { PHASE_BEGIN();
            const float* modl = MODP + (size_t)l * 8 * 6144; float* X = XRES;
            NormArgs A{}; A.xin = X; A.xw = X; A.gamma = KA()->in.g_ffn + l * D; A.scale = modl + 4096; A.shift = modl + 3072; A.H = HB;
            A.frag = (const v4u*)(WSP + WS_RRF) + (size_t)l * 32 * 3 * 2 * 64; A.bias0 = KA()->in.b_rg + l * 4; A.bias1 = KA()->in.b_re + l * 32; A.CW = CWP; A.LIST = LISTP; A.cnt = F.ctl + CW_CNT + 64 * (l * 32);
            norm_phase<false, false, 3, false>(F, A);
            SEAM(pb + 4);
        }
        if (IN(pb + 5)) { PHASE_BEGIN();
            pg8::MoeSched S; moe_tables<true>(F, S, l, 2, (const char*)(WSP + WS_WGU) + (size_t)l * NX * 512 * D * 2, (size_t)512 * D * 2, (size_t)256 * D * 2, LISTP, CWP);
            LAS unsigned* ent = (LAS unsigned*)(F.lds + ENT_OFF); LAS float* cwt = (LAS float*)(F.lds + CWT_OFF);
            pg8::EpiAct E{ACTB, ent, cwt}; pg8::gemm_phase_moe<1, pg8::EpiAct, pg8::MoeSched>(F.lds + RING_OFF, HB, D, ent, S, E);
            SEAM(pb + 5);
        }
        if (IN(pb + 6)) { PHASE_BEGIN();
            pg8::MoeSched S; moe_tables<false>(F, S, l, 4, (const char*)(WSP + WS_WD) + (size_t)l * NX * D * FE * 2, (size_t)D * FE * 2, (size_t)256 * FE * 2, LISTP, CWP);
            LAS unsigned* ent = (LAS unsigned*)(F.lds + ENT_OFF);
            pg8::EpiY E{YB, (size_t)T * D, ent}; pg8::gemm_phase_moe<0, pg8::EpiY, pg8::MoeSched>(F.lds + RING_OFF, ACTB, FE, ent, S, E);
            SEAM(pb + 6);
        }
    }
    if (IN(NPH - 1)) { PHASE_BEGIN();
        float* X = XRES; NormArgs A{}; A.xin = X; A.xw = X; A.Y0 = YB; A.Y1 = YB + (size_t)T * D; A.gate = MODP + (size_t)(NL - 1) * 8 * 6144 + 5120; A.gamma = KA()->in.g_fin;
        norm_phase<true, true, 0, true>(F, A);
    }
#undef IN
#undef SEAM
#undef GRID_BAR
}

extern "C" void kernel_launch(void* const* d_in, const int* in_sizes, int n_in, void* d_out, int out_size, void* d_ws, size_t ws_size, hipStream_t stream) {
    static int grid = 0;
    if (grid == 0) {
        if (n_in != 19 || in_sizes[0] != T * D || out_size != T * D || ws_size < WS_END) { fprintf(stderr, "kernel_launch: shape/workspace mismatch: n_in %d in0 %d out %d ws %zu (need %zu); nothing launched\n", n_in, n_in > 0 ? in_sizes[0] : -1, out_size, ws_size, (size_t)WS_END); grid = -1; return; }
        int dev = 0, cus = 0, per_cu = 0;
        if (hipGetDevice(&dev) != hipSuccess || hipDeviceGetAttribute(&cus, hipDeviceAttributeMultiprocessorCount, dev) != hipSuccess) { fprintf(stderr, "kernel_launch: device query failed\n"); grid = -1; return; }
        if (hipFuncSetAttribute((const void*)mk_fwd, hipFuncAttributeMaxDynamicSharedMemorySize, LDS_BYTES) != hipSuccess) { fprintf(stderr, "kernel_launch: hipFuncSetAttribute failed\n"); grid = -1; return; }
        if (hipOccupancyMaxActiveBlocksPerMultiprocessor(&per_cu, (const void*)mk_fwd, NWAVES * 64, LDS_BYTES) != hipSuccess || per_cu < 1) fprintf(stderr, "kernel_launch: note: occupancy query reports %d workgroups per CU\n", per_cu);
        (void)hipGetLastError();
        grid = cus;
        if (grid != 256) { fprintf(stderr, "kernel_launch: built for 256 CUs, device has %d; nothing launched\n", cus); grid = -1; return; }
    }
    if (grid < 0) return;
    if (hipMemsetAsync((char*)d_ws + WS_CTL, 0, CTL_ZERO_BYTES, stream) != hipSuccess) { fprintf(stderr, "kernel_launch: hipMemsetAsync failed\n"); return; }
    Args a{};
    const float** ip = (const float**)&a.in;
    for (int i = 0; i < 19; ++i) ip[i] = (const float*)d_in[i];
    a.out = (float*)d_out; a.ws = (unsigned char*)d_ws;
#if MK_PER_PHASE
    for (int p = 0; p < NPH; ++p) { a.ph_lo = p; a.ph_hi = p + 1; hipLaunchKernelGGL(mk_fwd, dim3(grid), dim3(NWAVES * 64), LDS_BYTES, stream, a); }
#else
    a.ph_lo = 0; a.ph_hi = NPH; hipLaunchKernelGGL(mk_fwd, dim3(grid), dim3(NWAVES * 64), LDS_BYTES, stream, a);
#endif
    const hipError_t le = hipPeekAtLastError();
    if (le != hipSuccess) fprintf(stderr, "kernel_launch: launch failed: %s\n", hipGetErrorName(le));
}
```

```cpp
#ifndef PROBE_STEPS
#define PROBE_STEPS 0
#endif
#ifndef PROBE_BASE
#define PROBE_BASE 0
#endif
#ifndef PROBE_Q
#define PROBE_Q 10
#endif
#include <hip/hip_runtime.h>
#include <hip/hip_bf16.h>
#include <cstdio>
#include <cstdint>
#include <cmath>

namespace pg8 {
#define PG8_LAS __attribute__((address_space(3)))
typedef unsigned short bf16_t;
typedef short bf16x8 __attribute__((ext_vector_type(8)));
typedef float f32x4 __attribute__((ext_vector_type(4)));
typedef unsigned u32x4 __attribute__((ext_vector_type(4)));
constexpr int BM = 256, BK = 64, HALF = 128, HTB = HALF * BK * 2  , STAGE_BYTES = 8 * HTB, NXCD = 8, WGM = 8;

__host__ __device__ __forceinline__ int lds_byte(int r, int c) { const int st = (r >> 4) * 2 + (c >> 5), rr = r & 15, cc = c & 31, ob = rr * 64 + cc * 2; return st * 1024 + (ob ^ (((ob >> 9) & 1) << 5)); }
__host__ __device__ __forceinline__ void stage_rc(int b, int& R, int& C) { const int st = b / 1024, sb = b % 1024, swz = sb ^ (((sb >> 9) & 1) << 5); R = (st >> 1) * 16 + swz / 64; C = (st & 1) * 32 + (swz % 64) / 2; }
__host__ __device__ __forceinline__ int perm32(int rho) { const int n = rho >> 4, i = rho & 15; return 8 * (i >> 2) + 4 * n + (i & 3); }

struct Unit { int pm, pn; };
struct Gemm { const bf16_t* A; const bf16_t* Bt; int M, N, K; };

struct StaticOrder {
    int nM, nN, nwg, G, c;
    __host__ __device__ void init(int M, int N, int G_, int c_) { nM = M / BM; nN = N / BM; nwg = nM * nN; G = G_; c = c_; }
    __host__ __device__ bool next(int i, Unit& u) const {
        const long L = (long)i * G + c; if (L >= nwg) return false;
        int wgid = (int)L; { const int q = nwg / NXCD, r = nwg % NXCD, xcd = wgid % NXCD, off = wgid / NXCD; wgid = (xcd < r ? xcd * (q + 1) : r * (q + 1) + (xcd - r) * q) + off; }
        const int nig = WGM * nN, gid = wgid / nig, fm = gid * WGM, gsz = (nM - fm) < WGM ? (nM - fm) : WGM;
        u.pm = fm + ((wgid % nig) % gsz); u.pn = (wgid % nig) / gsz; return true;
    }
    __device__ __forceinline__ void a_ready(const Unit&) const {}
    __device__ __forceinline__ void done(const Unit&) const {}
};

__device__ __forceinline__ unsigned cvt_pk_bf16(float lo, float hi) { unsigned r; asm volatile("v_cvt_pk_bf16_f32 %0, %1, %2" : "=v"(r) : "v"(lo), "v"(hi)); return r; }
typedef float f32x2 __attribute__((ext_vector_type(2)));

__device__ __forceinline__ float lane_read(float v, int src_lane) { return __builtin_bit_cast(float, __builtin_amdgcn_ds_bpermute(src_lane << 2, __builtin_bit_cast(int, v))); }
#ifndef MK_WT_STORES
#define MK_WT_STORES 0
#endif
#if MK_WT_STORES
#define STORE16_WT(p, v) asm volatile("global_store_dwordx4 %0, %1, off sc1\n\ts_nop 1" :: "v"(p), "v"(v) : "memory")
#else
#define STORE16_WT(p, v) (*(u32x4*)(p) = (v))
#endif
struct EpiQKVU {
    static constexpr bool PERM = true, AFTER_DRAIN = false;
    bf16_t* O; int ldc; int split_cols; size_t split_stride; float scale0;
    unsigned* nrm;
    __device__ __forceinline__ void operator()(const f32x4 (&acc)[2][2][4][2], const Unit& u, int wr, int wc, int fr, int fq) const {
        const int row0 = u.pm * BM + wr * 64 + fr; int colt = u.pn * BM; bf16_t* base = O;
        const int t = colt / split_cols; float sc = 1.f; { base += (size_t)t * split_stride; colt -= t * split_cols; if (t == 0) sc = scale0; }
        const int col0 = colt + wc * 32 + 8 * fq;
        if (t < 2) {
            const int b = (u.pm * BM) >> 12, tile0 = ((u.pm * BM) & 4095) >> 6;
#pragma unroll
            for (int ai = 0; ai < 2; ++ai)
#pragma unroll
                for (int bj = 0; bj < 2; ++bj) { float mx = 0.f;
#pragma unroll
                    for (int m = 0; m < 4; ++m) { const f32x4 v0 = acc[ai][bj][m][0] * sc, v1 = acc[ai][bj][m][1] * sc;
                        float ssq = (v0[0] * v0[0] + v0[1] * v0[1]) + (v0[2] * v0[2] + v0[3] * v0[3]) + (v1[0] * v1[0] + v1[1] * v1[1]) + (v1[2] * v1[2] + v1[3] * v1[3]);
                        { auto r16_ = __builtin_amdgcn_permlane16_swap(__float_as_uint(ssq), __float_as_uint(ssq), false, false); ssq = __uint_as_float(r16_[0]) + __uint_as_float(r16_[1]);
                          auto r32_ = __builtin_amdgcn_permlane32_swap(__float_as_uint(ssq), __float_as_uint(ssq), false, false); ssq = __uint_as_float(r32_[0]) + __uint_as_float(r32_[1]); }
                        mx = fmaxf(mx, ssq); }
#define PG8_DPPF(V, CTRL) __builtin_bit_cast(float, __builtin_amdgcn_update_dpp(0, __builtin_bit_cast(int, V), CTRL, 0xf, 0xf, false))
                    mx = fmaxf(mx, PG8_DPPF(mx, 0xB1)); mx = fmaxf(mx, PG8_DPPF(mx, 0x4E)); mx = fmaxf(mx, PG8_DPPF(mx, 0x141)); mx = fmaxf(mx, PG8_DPPF(mx, 0x140));
#undef PG8_DPPF
                    if (fr == 0 && fq == 0) { const int head = (colt >> 6) + 2 * bj + (wc >> 1);
                        nrm[((size_t)((t * 64 + b * 8 + head) * 64 + tile0 + 2 * ai + wr)) * 2 + (wc & 1)] = __float_as_uint(mx); } }
        }
#pragma unroll
        for (int ai = 0; ai < 2; ++ai)
#pragma unroll
            for (int m = 0; m < 4; ++m) { bf16_t* rowp = base + (size_t)(row0 + ai * HALF + m * 16) * ldc + col0;
#pragma unroll
                for (int bj = 0; bj < 2; ++bj) { const f32x4 v0 = acc[ai][bj][m][0] * sc, v1 = acc[ai][bj][m][1] * sc;
                    u32x4 w; w.x = cvt_pk_bf16(v0[0], v0[1]); w.y = cvt_pk_bf16(v0[2], v0[3]); w.z = cvt_pk_bf16(v1[0], v1[1]); w.w = cvt_pk_bf16(v1[2], v1[3]);
                    STORE16_WT(rowp + bj * HALF, w); } }
    }
};
struct EpiDelta {
    static constexpr bool PERM = true, AFTER_DRAIN = false;
    bf16_t* O; const float* gate; int gstride;
    __device__ __forceinline__ void operator()(const f32x4 (&acc)[2][2][4][2], const Unit& u, int wr, int wc, int fr, int fq) const {
        const int row0 = u.pm * BM + wr * 64 + fr, col0 = u.pn * BM + wc * 32 + 8 * fq; const int b = (u.pm * BM) >> 12;
        f32x4 gv[2][2];
#pragma unroll
        for (int bj = 0; bj < 2; ++bj)
#pragma unroll
            for (int n = 0; n < 2; ++n) gv[bj][n] = *(const f32x4*)(gate + (size_t)b * gstride + col0 + bj * HALF + 4 * n);
#pragma unroll
        for (int ai = 0; ai < 2; ++ai)
#pragma unroll
            for (int m = 0; m < 4; ++m) { bf16_t* rowp = O + (size_t)(row0 + ai * HALF + m * 16) * 1024 + col0;
#pragma unroll
                for (int bj = 0; bj < 2; ++bj) { const f32x4 v0 = acc[ai][bj][m][0] * gv[bj][0], v1 = acc[ai][bj][m][1] * gv[bj][1];
                    u32x4 w; w.x = cvt_pk_bf16(v0[0], v0[1]); w.y = cvt_pk_bf16(v0[2], v0[3]); w.z = cvt_pk_bf16(v1[0], v1[1]); w.w = cvt_pk_bf16(v1[2], v1[3]);
                    STORE16_WT(rowp + bj * HALF, w); } }
    }
};
struct EpiMid {
    static constexpr bool PERM = true, AFTER_DRAIN = false;
    bf16_t* O; const bf16_t* X; const float* gate; int gstride;
    __device__ __forceinline__ void operator()(const f32x4 (&acc)[2][2][4][2], const Unit& u, int wr, int wc, int fr, int fq) const {
        const int row0 = u.pm * BM + wr * 64 + fr, col0 = u.pn * BM + wc * 32 + 8 * fq; const int b = (u.pm * BM) >> 12;
        u32x4 xr[2][4][2];
#pragma unroll
        for (int ai = 0; ai < 2; ++ai)
#pragma unroll
            for (int m = 0; m < 4; ++m)
#pragma unroll
                for (int bj = 0; bj < 2; ++bj) xr[ai][m][bj] = *(const u32x4*)(X + (size_t)(row0 + ai * HALF + m * 16) * 1024 + col0 + bj * HALF);
        f32x4 gv[2][2];
#pragma unroll
        for (int bj = 0; bj < 2; ++bj)
#pragma unroll
            for (int n = 0; n < 2; ++n) gv[bj][n] = *(const f32x4*)(gate + (size_t)b * gstride + col0 + bj * HALF + 4 * n);
        asm volatile("" ::: "memory"); __builtin_amdgcn_sched_barrier(0);
#pragma unroll
        for (int ai = 0; ai < 2; ++ai)
#pragma unroll
            for (int m = 0; m < 4; ++m) { bf16_t* rowp = O + (size_t)(row0 + ai * HALF + m * 16) * 1024 + col0;
#pragma unroll
                for (int bj = 0; bj < 2; ++bj) { const u32x4 xv = xr[ai][m][bj];
                    const f32x4 x0 = {__uint_as_float(xv.x << 16), __uint_as_float(xv.x & 0xffff0000u), __uint_as_float(xv.y << 16), __uint_as_float(xv.y & 0xffff0000u)};
                    const f32x4 x1 = {__uint_as_float(xv.z << 16), __uint_as_float(xv.z & 0xffff0000u), __uint_as_float(xv.w << 16), __uint_as_float(xv.w & 0xffff0000u)};
                    const f32x4 v0 = x0 + acc[ai][bj][m][0] * gv[bj][0], v1 = x1 + acc[ai][bj][m][1] * gv[bj][1];
                    u32x4 w; w.x = cvt_pk_bf16(v0[0], v0[1]); w.y = cvt_pk_bf16(v0[2], v0[3]); w.z = cvt_pk_bf16(v1[0], v1[1]); w.w = cvt_pk_bf16(v1[2], v1[3]);
                    STORE16_WT(rowp + bj * HALF, w); } }
    }
};
struct EpiResGate {
    static constexpr bool PERM = false, AFTER_DRAIN = false;
    const float* base; float* out; const float* gate; int gstride;
    __device__ __forceinline__ void operator()(const f32x4 (&acc)[2][2][4][2], const Unit& u, int wr, int wc, int fr, int fq) const {
        const int row0 = u.pm * BM + wr * 64 + fr, col0 = u.pn * BM + wc * 32 + 4 * fq; const int b = (u.pm * BM) >> 12;
        f32x4 gv[2][2];
#pragma unroll
        for (int bj = 0; bj < 2; ++bj)
#pragma unroll
            for (int n = 0; n < 2; ++n) gv[bj][n] = *(const f32x4*)(gate + (size_t)b * gstride + col0 + bj * HALF + n * 16);
#pragma unroll
        for (int ai = 0; ai < 2; ++ai) {
            f32x4 bs[4][2][2];
#pragma unroll
            for (int m = 0; m < 4; ++m) { const size_t off = (size_t)(row0 + ai * HALF + m * 16) * 1024 + col0;
#pragma unroll
                for (int bj = 0; bj < 2; ++bj)
#pragma unroll
                    for (int n = 0; n < 2; ++n) bs[m][bj][n] = *(const f32x4*)(base + off + bj * HALF + n * 16); }
            asm volatile("" ::: "memory");
#pragma unroll
            for (int m = 0; m < 4; ++m) { const size_t off = (size_t)(row0 + ai * HALF + m * 16) * 1024 + col0;
#pragma unroll
                for (int bj = 0; bj < 2; ++bj)
#pragma unroll
                    for (int n = 0; n < 2; ++n) *(f32x4*)(out + off + bj * HALF + n * 16) = bs[m][bj][n] + gv[bj][n] * acc[ai][bj][m][n]; }
            asm volatile("" ::: "memory");
        }
    }
};

template <class Epi, class Sched, bool ALIGN_EPI = false, bool SP2 = false>
__device__ __forceinline__ void gemm_phase(PG8_LAS unsigned char* lds, const Gemm g, const Sched& S, const Epi& E) {
    int tid_ = threadIdx.x; asm volatile("" : "+v"(tid_));
    const int tid = tid_, wid = __builtin_amdgcn_readfirstlane(tid >> 6), lane = tid & 63, wr = wid >> 2, wc = wid & 3, fr = lane & 15, fq = lane >> 4;
    const int K = g.K, nt = K / BK;
    unsigned voffA[2], voffB[2];
#pragma unroll
    for (int i = 0; i < 2; ++i) { int R, C; stage_rc(tid * 16 + i * 8192, R, C); const int Rb = Epi::PERM ? ((R & ~31) + perm32(R & 31)) : R;
        voffA[i] = (unsigned)(R * K + C) * 2u; voffB[i] = (unsigned)(Rb * K + C) * 2u; }
    const size_t kstep = (size_t)(BK * 2);
    const size_t hstep = (size_t)HALF * K * 2;
    const size_t tstep = 2 * hstep;
    const unsigned ldsw = (unsigned)wid * 1024u;
    const int aoff = lds_byte(wr * 64 + fr, fq * 8), boff = lds_byte(wc * 32 + fr, fq * 8);
#define PG8_SA(b, h) (((b) * 2 + (h)) * HTB)
#define PG8_SB(b, h) ((4 + (b) * 2 + (h)) * HTB)
#define PG8_STAGE(bufoff, gbase, voff) do { _Pragma("unroll") for (int _i = 0; _i < 2; ++_i) \
        __builtin_amdgcn_global_load_lds((const unsigned*)((const char*)(gbase) + (voff)[_i]), (PG8_LAS unsigned*)(lds + (bufoff) + ldsw + _i * 8192), 16, 0, 0); } while (0)
#define PG8_LDA(dst, b, h) do { _Pragma("unroll") for (int m = 0; m < 4; ++m) _Pragma("unroll") for (int k = 0; k < 2; ++k) dst[m][k] = *(const PG8_LAS bf16x8*)(lds + PG8_SA(b, h) + aoff + m * 2048 + k * 1024); } while (0)
#define PG8_LDB(dst, b, h) do { _Pragma("unroll") for (int n = 0; n < 2; ++n) _Pragma("unroll") for (int k = 0; k < 2; ++k) dst[n][k] = *(const PG8_LAS bf16x8*)(lds + PG8_SB(b, h) + boff + n * 2048 + k * 1024); } while (0)
#define PG8_MMA(ai, bj, At, Bt) do { __builtin_amdgcn_s_setprio(1); _Pragma("unroll") for (int m = 0; m < 4; ++m) _Pragma("unroll") for (int n = 0; n < 2; ++n) _Pragma("unroll") for (int k = 0; k < 2; ++k) \
        acc[ai][bj][m][n] = __builtin_amdgcn_mfma_f32_16x16x32_bf16(Bt[n][k], At[m][k], acc[ai][bj][m][n], 0, 0, 0); __builtin_amdgcn_s_setprio(0); } while (0)
#define PG8_WAIT_V(n) asm volatile("s_waitcnt vmcnt(" #n ")" ::: "memory")
#define PG8_WAIT_L(n) asm volatile("s_waitcnt lgkmcnt(" #n ")" ::: "memory")
#define PG8_BAR __builtin_amdgcn_s_barrier()
#define PG8_SCHED __builtin_amdgcn_sched_barrier(0)
    Unit cur, nxt; int ui = 0;
    if (!S.next(0, cur)) return;
    f32x4 acc[2][2][4][2];
#pragma unroll
    for (int a = 0; a < 2; ++a)
#pragma unroll
        for (int b = 0; b < 2; ++b)
#pragma unroll
            for (int m = 0; m < 4; ++m)
#pragma unroll
                for (int n = 0; n < 2; ++n) acc[a][b][m][n] = (f32x4){0.f, 0.f, 0.f, 0.f};
    bf16x8 At[4][2], B0[2][2], B1[2][2];
    const char* cA = (const char*)g.A + (size_t)cur.pm * tstep; const char* cB = (const char*)g.Bt + (size_t)cur.pn * tstep;
    S.a_ready(cur);
    if constexpr (SP2) {
        PG8_STAGE(PG8_SB(0, 0), cB, voffB); PG8_STAGE(PG8_SB(0, 1), cB + hstep, voffB); PG8_STAGE(PG8_SA(0, 0), cA, voffA); PG8_STAGE(PG8_SA(0, 1), cA + hstep, voffA);
        if (wr == 1) PG8_BAR;
        PG8_WAIT_V(2); PG8_BAR;
        PG8_STAGE(PG8_SB(1, 0), cB + kstep, voffB); PG8_STAGE(PG8_SA(1, 0), cA + kstep, voffA); PG8_STAGE(PG8_SB(1, 1), cB + hstep + kstep, voffB);
        PG8_WAIT_V(6); PG8_BAR;
    } else {
        PG8_STAGE(PG8_SB(0, 0), cB, voffB); PG8_STAGE(PG8_SA(0, 0), cA, voffA); PG8_STAGE(PG8_SB(0, 1), cB + hstep, voffB); PG8_STAGE(PG8_SA(0, 1), cA + hstep, voffA);
        if (wr == 1) PG8_BAR;
        PG8_WAIT_V(4); PG8_BAR;
        PG8_STAGE(PG8_SB(1, 0), cB + kstep, voffB); PG8_STAGE(PG8_SA(1, 0), cA + kstep, voffA); PG8_STAGE(PG8_SB(1, 1), cB + hstep + kstep, voffB);
        PG8_WAIT_V(6); PG8_BAR;
    }
    for (;;) {
        const bool has_next = S.next(ui + 1, nxt);
        const char* nA = has_next ? (const char*)g.A + (size_t)nxt.pm * tstep : cA; const char* nB = has_next ? (const char*)g.Bt + (size_t)nxt.pn * tstep : cB;
        for (int t = 0; t < nt; t += 2) {
            const bool last = (t == nt - 2);
            const char* a1 = cA + (size_t)(t + 1) * kstep;
            const char* a2 = last ? nA : cA + (size_t)(t + 2) * kstep; const char* b2 = last ? nB : cB + (size_t)(t + 2) * kstep;
            const char* a3 = a2 + kstep; const char* b3 = b2 + kstep;
            if (last && has_next) S.a_ready(nxt);
            if constexpr (SP2) {
            PG8_LDB(B0, 0, 0); PG8_LDB(B1, 0, 1); PG8_SCHED; PG8_LDA(At, 0, 0); PG8_STAGE(PG8_SA(1, 1), a1 + hstep, voffA);
            PG8_WAIT_V(8); PG8_WAIT_L(0); PG8_BAR; PG8_MMA(0, 0, At, B0); PG8_MMA(0, 1, At, B1); PG8_BAR; PG8_SCHED;
            PG8_LDA(At, 0, 1); PG8_STAGE(PG8_SB(0, 0), b2, voffB); PG8_STAGE(PG8_SB(0, 1), b2 + hstep, voffB); PG8_STAGE(PG8_SA(0, 0), a2, voffA);
            PG8_WAIT_V(8); PG8_WAIT_L(0); PG8_BAR; PG8_MMA(1, 0, At, B0); PG8_MMA(1, 1, At, B1); PG8_BAR; PG8_SCHED;
            PG8_LDB(B0, 1, 0); PG8_LDB(B1, 1, 1); PG8_SCHED; PG8_LDA(At, 1, 0); PG8_STAGE(PG8_SA(0, 1), a2 + hstep, voffA);
            PG8_WAIT_V(8); PG8_WAIT_L(0); PG8_BAR; PG8_MMA(0, 0, At, B0); PG8_MMA(0, 1, At, B1); PG8_BAR; PG8_SCHED;
            PG8_LDA(At, 1, 1); PG8_STAGE(PG8_SB(1, 0), b3, voffB); PG8_STAGE(PG8_SB(1, 1), b3 + hstep, voffB); PG8_STAGE(PG8_SA(1, 0), a3, voffA);
            PG8_WAIT_V(8); PG8_WAIT_L(0); PG8_BAR; PG8_MMA(1, 0, At, B0); PG8_MMA(1, 1, At, B1); PG8_BAR; PG8_SCHED;
            } else {
            PG8_LDB(B0, 0, 0); PG8_SCHED; PG8_LDA(At, 0, 0); PG8_STAGE(PG8_SA(1, 1), a1 + hstep, voffA);
            PG8_WAIT_L(8); PG8_BAR; PG8_WAIT_L(0); PG8_MMA(0, 0, At, B0); PG8_BAR; PG8_SCHED;
            PG8_LDB(B1, 0, 1); PG8_STAGE(PG8_SB(0, 0), b2, voffB);
            PG8_BAR; PG8_WAIT_L(0); PG8_MMA(0, 1, At, B1); PG8_BAR;
            PG8_LDA(At, 0, 1); PG8_STAGE(PG8_SA(0, 0), a2, voffA);
            PG8_BAR; PG8_WAIT_L(0); PG8_MMA(1, 0, At, B0); PG8_BAR; PG8_SCHED;
            PG8_STAGE(PG8_SB(0, 1), b2 + hstep, voffB);
            PG8_WAIT_V(6); PG8_BAR; PG8_MMA(1, 1, At, B1); PG8_BAR;
            PG8_LDB(B0, 1, 0); PG8_SCHED; PG8_LDA(At, 1, 0); PG8_STAGE(PG8_SA(0, 1), a2 + hstep, voffA);
            PG8_WAIT_L(8); PG8_BAR; PG8_WAIT_L(0); PG8_MMA(0, 0, At, B0); PG8_BAR; PG8_SCHED;
            PG8_LDB(B1, 1, 1); PG8_STAGE(PG8_SB(1, 0), b3, voffB);
            PG8_BAR; PG8_WAIT_L(0); PG8_MMA(0, 1, At, B1); PG8_BAR;
            PG8_LDA(At, 1, 1); PG8_STAGE(PG8_SA(1, 0), a3, voffA);
            PG8_BAR; PG8_WAIT_L(0); PG8_MMA(1, 0, At, B0); PG8_BAR; PG8_SCHED;
            PG8_STAGE(PG8_SB(1, 1), b3 + hstep, voffB);
            PG8_WAIT_V(6); PG8_BAR; PG8_MMA(1, 1, At, B1); PG8_BAR;
            }
        }
        if constexpr (ALIGN_EPI) { if (wr == 0) PG8_BAR; }
        if constexpr (!Epi::AFTER_DRAIN) { E(acc, cur, wr, wc, fr, fq); S.done(cur); }
        if (!has_next) break;
#pragma unroll
        for (int a = 0; a < 2; ++a)
#pragma unroll
            for (int b = 0; b < 2; ++b)
#pragma unroll
                for (int m = 0; m < 4; ++m)
#pragma unroll
                    for (int n = 0; n < 2; ++n) acc[a][b][m][n] = (f32x4){0.f, 0.f, 0.f, 0.f};
        cur = nxt; cA = nA; cB = nB; ++ui;
        if constexpr (ALIGN_EPI) { if (wr == 1) PG8_BAR; }
    }
    PG8_WAIT_V(0);
    if constexpr (!ALIGN_EPI) { if (wr == 0) PG8_BAR; }
    PG8_BAR;
    if constexpr (Epi::AFTER_DRAIN) { E.fused(acc, cur, wr, wc, fr, fq, lds, wid, lane); S.done(cur); }
#undef PG8_SA
#undef PG8_SB
#undef PG8_STAGE
#undef PG8_LDA
#undef PG8_LDB
#undef PG8_MMA
#undef PG8_WAIT_V
#undef PG8_WAIT_L
#undef PG8_BAR
#undef PG8_SCHED
}

struct MUnit { int slot, e, pn, nrows, tile; };
struct MoeSched {
    PG8_LAS const int* ut; int nunits;
    const char* W; size_t estride, pnstride;
    unsigned rdy;
    unsigned* pub; unsigned* tmo;
    __device__ __forceinline__ bool next(int i, MUnit& u) const {
        if (i >= nunits) return false;
        u.slot = i; u.e = ut[4 * i]; u.pn = ut[4 * i + 1]; u.nrows = ut[4 * i + 2]; u.tile = ut[4 * i + 3]; return true; }
    __device__ __forceinline__ const char* b_base(const MUnit& u) const { return W + (size_t)u.e * estride + (size_t)u.pn * pnstride; }
    __device__ __forceinline__ void publish(int tile, int lane) const { if (lane == 0) __hip_atomic_fetch_add(pub + 64 * tile, 1u, __ATOMIC_RELAXED, __HIP_MEMORY_SCOPE_AGENT); }
    __device__ __forceinline__ void a_ready(const MUnit& u, int wid, int lane) const {
        if ((rdy >> u.slot) & 1u) return;
        if (wid == 0) {
            unsigned polls = 0;
            while ((unsigned)__builtin_amdgcn_readfirstlane(__hip_atomic_load(pub + 64 * u.tile, __ATOMIC_RELAXED, __HIP_MEMORY_SCOPE_AGENT)) < 16u) {
                if ((++polls & 255u) == 0u && __builtin_amdgcn_readfirstlane(__hip_atomic_load(tmo, __ATOMIC_RELAXED, __HIP_MEMORY_SCOPE_AGENT)) != 0u) break;
                if (polls > (1u << 14)) { if (lane == 0) __hip_atomic_store(tmo, 1u, __ATOMIC_RELAXED, __HIP_MEMORY_SCOPE_AGENT); break; }
                __builtin_amdgcn_s_sleep(2); }
            __builtin_amdgcn_fence(__ATOMIC_ACQUIRE, "agent");
            asm volatile("s_waitcnt vmcnt(0)" ::: "memory");
        }
        asm volatile("" ::: "memory"); __builtin_amdgcn_s_barrier(); asm volatile("" ::: "memory");
    }
};
template <int ESH, bool PUBLISH, bool WAITA, class Epi, class Sched>
__device__ __forceinline__ void gemm_phase_moe(PG8_LAS unsigned char* lds, const bf16_t* Abase, const int K, PG8_LAS const unsigned* ent, const Sched& S, const Epi& E) {
    int tid_ = threadIdx.x; asm volatile("" : "+v"(tid_));
    const int tid = tid_, wid = __builtin_amdgcn_readfirstlane(tid >> 6), lane = tid & 63, wr = wid >> 2, wc = wid & 3, fr = lane & 15, fq = lane >> 4;
    const int nt = K / BK;
    int RA[2]; unsigned cA2[2], voffB[2];
#pragma unroll
    for (int i = 0; i < 2; ++i) { int R, C; stage_rc(tid * 16 + i * 8192, R, C); const int Rb = Epi::PERM ? ((R & ~31) + perm32(R & 31)) : R;
        RA[i] = R; cA2[i] = (unsigned)C * 2u; voffB[i] = (unsigned)(Rb * K + C) * 2u; }
    const size_t kstep = (size_t)(BK * 2);
    const size_t hstep = (size_t)HALF * K * 2;
    const unsigned rowb = (unsigned)K * 2u;
    const unsigned ldsw = (unsigned)wid * 1024u;
    const int aoff = lds_byte(wr * 64 + fr, fq * 8), boff = lds_byte(wc * 32 + fr, fq * 8);
#define PG8_SA(b, h) (((b) * 2 + (h)) * HTB)
#define PG8_SB(b, h) ((4 + (b) * 2 + (h)) * HTB)
#define PG8_STAGE(bufoff, gbase, voff) do { _Pragma("unroll") for (int _i = 0; _i < 2; ++_i) \
        __builtin_amdgcn_global_load_lds((const unsigned*)((const char*)(gbase) + (voff)[_i]), (PG8_LAS unsigned*)(lds + (bufoff) + ldsw + _i * 8192), 16, 0, 0); } while (0)
#define PG8_LDA(dst, b, h) do { _Pragma("unroll") for (int m = 0; m < 4; ++m) _Pragma("unroll") for (int k = 0; k < 2; ++k) dst[m][k] = *(const PG8_LAS bf16x8*)(lds + PG8_SA(b, h) + aoff + m * 2048 + k * 1024); } while (0)
#define PG8_LDB(dst, b, h) do { _Pragma("unroll") for (int n = 0; n < 2; ++n) _Pragma("unroll") for (int k = 0; k < 2; ++k) dst[n][k] = *(const PG8_LAS bf16x8*)(lds + PG8_SB(b, h) + boff + n * 2048 + k * 1024); } while (0)
#define PG8_MMA(ai, bj, At, Bt) do { __builtin_amdgcn_s_setprio(1); _Pragma("unroll") for (int m = 0; m < 4; ++m) _Pragma("unroll") for (int n = 0; n < 2; ++n) _Pragma("unroll") for (int k = 0; k < 2; ++k) \
        acc[ai][bj][m][n] = __builtin_amdgcn_mfma_f32_16x16x32_bf16(Bt[n][k], At[m][k], acc[ai][bj][m][n], 0, 0, 0); __builtin_amdgcn_s_setprio(0); } while (0)
#define PG8_WAIT_V(n) asm volatile("s_waitcnt vmcnt(" #n ")" ::: "memory")
#define PG8_WAIT_L(n) asm volatile("s_waitcnt lgkmcnt(" #n ")" ::: "memory")
#define PG8_BAR __builtin_amdgcn_s_barrier()
#define PG8_SCHED __builtin_amdgcn_sched_barrier(0)
#define PG8_OFFS(dst, u) do { _Pragma("unroll") for (int _h = 0; _h < 2; ++_h) _Pragma("unroll") for (int _i = 0; _i < 2; ++_i) \
        dst[_h][_i] = (ent[(u).slot * 256 + _h * HALF + RA[_i]] >> ESH) * rowb + cA2[_i]; } while (0)
    MUnit cur, nxt; int ui = 0; int pend = -1;
    if (!S.next(0, cur)) return;
    if constexpr (WAITA) S.a_ready(cur, wid, lane);
    f32x4 acc[2][2][4][2];
#pragma unroll
    for (int a = 0; a < 2; ++a)
#pragma unroll
        for (int b = 0; b < 2; ++b)
#pragma unroll
            for (int m = 0; m < 4; ++m)
#pragma unroll
                for (int n = 0; n < 2; ++n) acc[a][b][m][n] = (f32x4){0.f, 0.f, 0.f, 0.f};
    bf16x8 At[4][2], B0[2][2], B1[2][2];
    unsigned offc[2][2], offn[2][2];
    PG8_OFFS(offc, cur);
    const char* const cA = (const char*)Abase; const char* cB = S.b_base(cur);
    PG8_STAGE(PG8_SB(0, 0), cB, voffB); PG8_STAGE(PG8_SB(0, 1), cB + hstep, voffB); PG8_STAGE(PG8_SA(0, 0), cA, offc[0]); PG8_STAGE(PG8_SA(0, 1), cA, offc[1]);
    if (wr == 1) PG8_BAR;
    PG8_WAIT_V(2); PG8_BAR;
    PG8_STAGE(PG8_SB(1, 0), cB + kstep, voffB); PG8_STAGE(PG8_SA(1, 0), cA + kstep, offc[0]); PG8_STAGE(PG8_SB(1, 1), cB + hstep + kstep, voffB);
    PG8_WAIT_V(6); PG8_BAR;
    for (;;) {
        const bool has_next = S.next(ui + 1, nxt);
        const char* nB = has_next ? S.b_base(nxt) : cB;
        if (has_next) { PG8_OFFS(offn, nxt); } else {
#pragma unroll
            for (int h = 0; h < 2; ++h)
#pragma unroll
                for (int i = 0; i < 2; ++i) offn[h][i] = offc[h][i]; }
#pragma nounroll
        for (int t = 0; t < nt; t += 2) {
            const bool last = (t == nt - 2);
            if constexpr (WAITA) { if (last && has_next) S.a_ready(nxt, wid, lane); }
            const char* a1 = cA + (size_t)(t + 1) * kstep;
            const char* a2 = last ? cA : cA + (size_t)(t + 2) * kstep; const char* b2 = last ? nB : cB + (size_t)(t + 2) * kstep;
            const char* a3 = a2 + kstep; const char* b3 = b2 + kstep;
            unsigned o2[2][2];
#pragma unroll
            for (int h = 0; h < 2; ++h)
#pragma unroll
                for (int i = 0; i < 2; ++i) o2[h][i] = last ? offn[h][i] : offc[h][i];
            PG8_LDB(B0, 0, 0); PG8_LDB(B1, 0, 1); PG8_SCHED; PG8_LDA(At, 0, 0); PG8_STAGE(PG8_SA(1, 1), a1, offc[1]);
            PG8_WAIT_V(8); PG8_WAIT_L(0); PG8_BAR; PG8_MMA(0, 0, At, B0); PG8_MMA(0, 1, At, B1); PG8_BAR; PG8_SCHED;
            PG8_LDA(At, 0, 1); PG8_STAGE(PG8_SB(0, 0), b2, voffB); PG8_STAGE(PG8_SB(0, 1), b2 + hstep, voffB); PG8_STAGE(PG8_SA(0, 0), a2, o2[0]);
            PG8_WAIT_V(8); PG8_WAIT_L(0);
            if constexpr (PUBLISH) { if (t == 0 && pend >= 0) { S.publish(pend, lane); pend = -1; } }
            PG8_BAR; PG8_MMA(1, 0, At, B0); PG8_MMA(1, 1, At, B1); PG8_BAR; PG8_SCHED;
            PG8_LDB(B0, 1, 0); PG8_LDB(B1, 1, 1); PG8_SCHED; PG8_LDA(At, 1, 0); PG8_STAGE(PG8_SA(0, 1), a2, o2[1]);
            PG8_WAIT_V(8); PG8_WAIT_L(0); PG8_BAR; PG8_MMA(0, 0, At, B0); PG8_MMA(0, 1, At, B1); PG8_BAR; PG8_SCHED;
            PG8_LDA(At, 1, 1); PG8_STAGE(PG8_SB(1, 0), b3, voffB); PG8_STAGE(PG8_SB(1, 1), b3 + hstep, voffB); PG8_STAGE(PG8_SA(1, 0), a3, o2[0]);
            PG8_WAIT_V(8); PG8_WAIT_L(0); PG8_BAR; PG8_MMA(1, 0, At, B0); PG8_MMA(1, 1, At, B1); PG8_BAR; PG8_SCHED;
        }
        if (wr == 0) PG8_BAR;
        E(acc, cur, wr, wc, fr, fq);
        if constexpr (PUBLISH) pend = cur.tile;
        if (!has_next) break;
#pragma unroll
        for (int a = 0; a < 2; ++a)
#pragma unroll
            for (int b = 0; b < 2; ++b)
#pragma unroll
                for (int m = 0; m < 4; ++m)
#pragma unroll
                    for (int n = 0; n < 2; ++n) acc[a][b][m][n] = (f32x4){0.f, 0.f, 0.f, 0.f};
        cur = nxt; cB = nB; ++ui;
#pragma unroll
        for (int h = 0; h < 2; ++h)
#pragma unroll
            for (int i = 0; i < 2; ++i) offc[h][i] = offn[h][i];
        if (wr == 1) PG8_BAR;
    }
    PG8_WAIT_V(0);
    if constexpr (PUBLISH) { if (pend >= 0) S.publish(pend, lane); }
    PG8_BAR;
#undef PG8_SA
#undef PG8_SB
#undef PG8_STAGE
#undef PG8_LDA
#undef PG8_LDB
#undef PG8_MMA
#undef PG8_WAIT_V
#undef PG8_WAIT_L
#undef PG8_BAR
#undef PG8_SCHED
#undef PG8_OFFS
}
struct EpiAct {
    static constexpr bool PERM = true, AFTER_DRAIN = false;
    bf16_t* ACT; PG8_LAS const unsigned* ent; PG8_LAS const float* cwt;
    __device__ __forceinline__ void operator()(const f32x4 (&acc)[2][2][4][2], const MUnit& u, int wr, int wc, int fr, int fq) const {
#pragma unroll
        for (int ai = 0; ai < 2; ++ai)
#pragma unroll
            for (int m = 0; m < 4; ++m) { const int r = ai * HALF + wr * 64 + m * 16 + fr;
                if (r < u.nrows) { const unsigned en = ent[u.slot * 256 + r]; const float w = cwt[u.slot * 256 + r];
                    float a[8];
#pragma unroll
                    for (int n = 0; n < 2; ++n)
#pragma unroll
                        for (int j = 0; j < 4; ++j) { const float g = acc[ai][0][m][n][j], up = acc[ai][1][m][n][j];
                            a[4 * n + j] = g * __builtin_amdgcn_rcpf(1.f + __builtin_amdgcn_exp2f(-1.4426950408889634f * g)) * up * w; }
                    u32x4 o; o.x = cvt_pk_bf16(a[0], a[1]); o.y = cvt_pk_bf16(a[2], a[3]); o.z = cvt_pk_bf16(a[4], a[5]); o.w = cvt_pk_bf16(a[6], a[7]);
                    asm volatile("global_store_dwordx4 %0, %1, off sc1\n\ts_nop 1" :: "v"(ACT + (size_t)en * 256 + u.pn * HALF + wc * 32 + 8 * fq), "v"(o) : "memory"); } }
    }
};
struct EpiY {
    static constexpr bool PERM = true, AFTER_DRAIN = false;
    unsigned char* Y; size_t slot_stride; PG8_LAS const unsigned* ent;
    __device__ __forceinline__ void operator()(const f32x4 (&acc)[2][2][4][2], const MUnit& u, int wr, int wc, int fr, int fq) const {
#pragma unroll
        for (int ai = 0; ai < 2; ++ai)
#pragma unroll
            for (int m = 0; m < 4; ++m) { const int r = ai * HALF + wr * 64 + m * 16 + fr;
                if (r < u.nrows) { const unsigned en = ent[u.slot * 256 + r];
                    unsigned char* rowp = Y + (size_t)(en & 1u) * slot_stride + (size_t)(en >> 1) * 1024 + u.pn * BM + wc * 32 + 8 * fq;
#pragma unroll
                    for (int bj = 0; bj < 2; ++bj) { const f32x4 v0 = acc[ai][bj][m][0] * 16.f, v1 = acc[ai][bj][m][1] * 16.f;
                        int w0 = __builtin_amdgcn_cvt_pk_fp8_f32(v0[0], v0[1], 0, false); w0 = __builtin_amdgcn_cvt_pk_fp8_f32(v0[2], v0[3], w0, true);
                        int w1 = __builtin_amdgcn_cvt_pk_fp8_f32(v1[0], v1[1], 0, false); w1 = __builtin_amdgcn_cvt_pk_fp8_f32(v1[2], v1[3], w1, true);
                        typedef unsigned u32x2e __attribute__((ext_vector_type(2)));
                        *(u32x2e*)(rowp + bj * HALF) = (u32x2e){(unsigned)w0, (unsigned)w1}; } } }
    }
};
}

#include <hip/hip_bf16.h>
#include <cmath>

namespace attn_body {
using bf16=__hip_bfloat16;
using bf16x8=__attribute__((ext_vector_type(8)))short;
using s16x4=__attribute__((ext_vector_type(4)))short;
using f32x16=__attribute__((ext_vector_type(16)))float;
using u32x4=__attribute__((ext_vector_type(4)))unsigned;
constexpr int BATCH=8,NHEAD=8,SEQ=4096,D=64,DM=NHEAD*D,ODM=1024;
constexpr int NW=8,QBLK=32,QB=QBLK*NW,KVBLK=64,NQB=SEQ/QB;
constexpr int ATTN_PITCH=DM, ATTN_UNIT_ROWS=QB;
__device__ __forceinline__ int crow(int r,int hi){return (r&3)+8*(r>>2)+4*hi;}
#define SBAR() __builtin_amdgcn_sched_barrier(0)
__device__ __forceinline__ void cmask(f32x16&p0,f32x16&p1,int jb,int qrel,int hi){
  const float NEG=-INFINITY; int kb=64*jb+4*hi;
  #pragma unroll
  for(int r=0;r<16;++r){int kv=kb+(r&3)+8*(r>>2); if(kv>qrel)p0[r]=NEG; if(kv+32>qrel)p1[r]=NEG;}
}

constexpr int NSLOT=3, SLOTB=8192;
constexpr int LDS_K=0, LDS_V=NSLOT*SLOTB, LDS_WS=2*NSLOT*SLOTB, LDS_OST=LDS_WS+NW*64*4, LDS_BYTES=LDS_OST+NW*4096;
constexpr float SKIP_L2=-80.f;
constexpr int LDS_TICKET=85504;
constexpr int LDS_FB=86016, LDS_FB_BYTES=SEQ*8;
constexpr float C2=0.125f*1.4426950408889634f;
__device__ __forceinline__ void glds16(const void*gbase,unsigned voff,unsigned lds_dst){unsigned keep;
  asm volatile("s_mov_b32 %0, m0\n\ts_mov_b32 m0, %3\n\ts_nop 0\n\tglobal_load_lds_dwordx4 %1, %2\n\ts_mov_b32 m0, %0":"=&s"(keep):"v"(voff),"s"(gbase),"s"(lds_dst):"memory");}
__device__ __forceinline__ float max3f(float a,float b,float c){float r;asm("v_max3_f32 %0, %1, %2, %3":"=v"(r):"v"(a),"v"(b),"v"(c));return r;}
__device__ __forceinline__ float max2f(float a,float b){float r;asm("v_max_f32_e32 %0, %1, %2":"=v"(r):"v"(a),"v"(b));return r;}
__device__ __forceinline__ float fadd_s(float a,float b){float r;asm("v_add_f32_e32 %0, %1, %2":"=v"(r):"v"(a),"v"(b));return r;}
__device__ __forceinline__ float fsub_s(float a,float b){float r;asm("v_sub_f32_e32 %0, %1, %2":"=v"(r):"v"(a),"v"(b));return r;}
typedef float f32x2_t __attribute__((ext_vector_type(2))); typedef __bf16 bf16x2_t __attribute__((ext_vector_type(2)));
__device__ __forceinline__ unsigned cvtpk_s(float lo,float hi){f32x2_t v={lo,hi};bf16x2_t b=__builtin_convertvector(v,bf16x2_t);return __builtin_bit_cast(unsigned,b);}
#define WAIT_BAR(N) asm volatile("s_waitcnt vmcnt(" #N ") lgkmcnt(0)\n\ts_barrier":::"memory")

__device__ __forceinline__ void qkt(f32x16&p0,f32x16&p1,const char*Kslot,const bf16x8*qr,int r32,int hi){
  const char*kb=Kslot+hi*1024+r32*16;
  #pragma unroll
  for(int d0=0;d0<4;++d0){
    const bf16x8 b0=*reinterpret_cast<const bf16x8*>(kb+d0*2048);
    const bf16x8 b1=*reinterpret_cast<const bf16x8*>(kb+d0*2048+512);
    {p0=__builtin_amdgcn_mfma_f32_32x32x16_bf16(b0,qr[d0],p0,0,0,0);p1=__builtin_amdgcn_mfma_f32_32x32x16_bf16(b1,qr[d0],p1,0,0,0);}}
}
typedef __attribute__((address_space(3))) const char* lds_cptr;
typedef float f32x4_t __attribute__((ext_vector_type(4)));
typedef short v4i16_t __attribute__((ext_vector_type(4)));
__device__ __forceinline__ void kload8(bf16x8*kf,lds_cptr kp){
  kf[0]=*(const __attribute__((address_space(3))) bf16x8*)(kp);      kf[1]=*(const __attribute__((address_space(3))) bf16x8*)(kp+512);
  kf[2]=*(const __attribute__((address_space(3))) bf16x8*)(kp+2048); kf[3]=*(const __attribute__((address_space(3))) bf16x8*)(kp+2560);
  kf[4]=*(const __attribute__((address_space(3))) bf16x8*)(kp+4096); kf[5]=*(const __attribute__((address_space(3))) bf16x8*)(kp+4608);
  kf[6]=*(const __attribute__((address_space(3))) bf16x8*)(kp+6144); kf[7]=*(const __attribute__((address_space(3))) bf16x8*)(kp+6656);
}
__device__ __forceinline__ void kload2(bf16x8*kf,lds_cptr kp,int j){ kf[2*j]=*(const __attribute__((address_space(3))) bf16x8*)(kp+j*2048); kf[2*j+1]=*(const __attribute__((address_space(3))) bf16x8*)(kp+j*2048+512); }
__device__ __forceinline__ s16x4 vtr(lds_cptr p){ return __builtin_bit_cast(s16x4,__builtin_amdgcn_ds_read_tr16_b64_v4i16((__attribute__((address_space(3))) v4i16_t*)p)); }
__device__ __forceinline__ float rowmax(const f32x16&p0,const f32x16&p1){
  float a=max3f(p0[0],p0[1],p1[0]),b=max3f(p0[2],p0[3],p1[1]);a=max3f(a,p1[2],p1[3]);
  #pragma unroll
  for(int r=4;r<16;r+=4){a=max3f(a,p0[r],p0[r+1]);b=max3f(b,p0[r+2],p0[r+3]);a=max3f(a,p1[r],p1[r+1]);b=max3f(b,p1[r+2],p1[r+3]);}
  const float m=max2f(a,b);
  auto rr=__builtin_amdgcn_permlane32_swap(__float_as_uint(m),__float_as_uint(m),false,false);
  return max2f(__uint_as_float(rr[0]),__uint_as_float(rr[1]));
}
__device__ __forceinline__ void pv(f32x16*o,int vb,bf16x8 pa0,bf16x8 pa1,bf16x8 pa2,bf16x8 pa3){
  #pragma unroll
  for(int d0=0;d0<2;++d0){s16x4 lo[4],hi[4];
    #pragma unroll
    for(int ks=0;ks<4;++ks){
      asm volatile("ds_read_b64_tr_b16 %0,%1 offset:%c2":"=&v"(lo[ks]):"v"(vb),"i"(d0*4096+ks*1024):"memory");
      asm volatile("ds_read_b64_tr_b16 %0,%1 offset:%c2":"=&v"(hi[ks]):"v"(vb),"i"(d0*4096+ks*1024+512):"memory");}
    asm volatile("s_waitcnt lgkmcnt(0)":::"memory");SBAR();
    #define PK(k) (bf16x8){lo[k][0],lo[k][1],lo[k][2],lo[k][3],hi[k][0],hi[k][1],hi[k][2],hi[k][3]}
    o[d0]=__builtin_amdgcn_mfma_f32_32x32x16_bf16(pa0,PK(0),o[d0],0,0,0);
    o[d0]=__builtin_amdgcn_mfma_f32_32x32x16_bf16(pa1,PK(1),o[d0],0,0,0);
    o[d0]=__builtin_amdgcn_mfma_f32_32x32x16_bf16(pa2,PK(2),o[d0],0,0,0);
    o[d0]=__builtin_amdgcn_mfma_f32_32x32x16_bf16(pa3,PK(3),o[d0],0,0,0);
    #undef PK
  }
}

#ifndef ATTN_STORE16
#define ATTN_STORE16(p,v) STORE16_WT(p,v)
#endif
struct AttnBase { const char* ws; size_t q,k,v,o,fc,bt,nrm,qat,pq; };
template<int THRL> __device__ __forceinline__ int attn_units(const int x,int rank,const AttnBase&AB,const int maxu,int&ndone,int&steps,char*shm){
  typedef float f32x4_l __attribute__((ext_vector_type(4)));
  typedef unsigned v2u_t __attribute__((ext_vector_type(2)));
  #define WAVE_CONSTS() \
  int tid_=threadIdx.x; asm volatile("":"+v"(tid_)); const int tid=tid_,lane=tid&63,r32=lane&31,hi=lane>>5; const int wid=__builtin_amdgcn_readfirstlane(tid>>6); \
  const unsigned lds0=(unsigned)(uintptr_t)shm; \
  float*wsf=(float*)(shm+LDS_WS)+wid*64; \
  const unsigned ksrc=(unsigned)((lane*DM+wid*8)*2); \
  const unsigned vsrc=(unsigned)(((16*(wid&3)+(lane>>2))*DM+(wid>>2)*32+(lane&3)*8)*2); \
  const unsigned kdst=lds0+LDS_K+wid*1024, vdst=lds0+LDS_V+wid*1024; \
  const int vb0=(int)(lds0+LDS_V)+((lane>>4)&1)*32+(lane&3)*8+(4*hi+((lane&15)>>2))*64; \
  const char*Kbase=shm+LDS_K; \
  const lds_cptr shm3=(lds_cptr)shm; const lds_cptr kp0=shm3+LDS_K+hi*1024+r32*16; const lds_cptr vp0=shm3+LDS_V+((lane>>4)&1)*32+(lane&3)*8+(4*hi+((lane&15)>>2))*64; \
  const int qrel=wid*QBLK+r32; \
  const lds_cptr fbx=shm3+LDS_FB+(r32*8); \
  const u32x4 qxu_=hi?(u32x4){0u,0u,0u,0u}:(u32x4){0x3f803f80u,0x00003f80u,0u,0u}; const bf16x8 qx=__builtin_bit_cast(bf16x8,qxu_);
  #define DMA_K(t,slot) glds16(Kh,ksrc+(unsigned)(NTF-1-(t))*(unsigned)(KVBLK*DM*2),(unsigned)__builtin_amdgcn_readfirstlane(kdst+(slot)))
  #define DMA_V(t,slot) glds16(Vh,vsrc+(unsigned)(NTF-1-(t))*(unsigned)(KVBLK*DM*2),(unsigned)__builtin_amdgcn_readfirstlane(vdst+(slot)))
  int qb,q0,h,NTF,kend; long rowbase; const bf16*Kh,*Vh;
  float su_bt,su_fcj,su_fc0; unsigned su_k0,su_k1,su_q[8],su_u[8]; f32x4_l su_v0,su_v1; bf16x8 qr[4];
  #define NRMW(p,i) __hip_atomic_load((p)+(i),__ATOMIC_RELAXED,__HIP_MEMORY_SCOPE_AGENT)
  #define UNIT_ISSUE(RK) do{ const int u_=(RK),bq_=u_&7; qb=15-(u_>>3); const int bh_=bq_*8+((x-bq_)&7); h=bh_%NHEAD; rowbase=(long)(bh_/NHEAD)*SEQ; q0=qb*QB; kend=q0+QB; NTF=(q0+QB)/KVBLK; \
    const char*w_=AB.ws; asm volatile("":"+s"(w_)); const bf16*Q=(const bf16*)(w_+AB.q),*K=(const bf16*)(w_+AB.k),*V=(const bf16*)(w_+AB.v); const float*FC=(const float*)(w_+AB.fc),*BT=(const float*)(w_+AB.bt); const unsigned*nrm=(const unsigned*)(w_+AB.nrm); \
    const float*FCbh=FC+(long)bh_*SEQ; su_bt=lane<32?BT[bh_*32+lane]:0.f; \
    const unsigned*su_qn=nrm+((size_t)bh_*64)*2,*su_kn=nrm+((size_t)(64+bh_)*64)*2; \
    su_k0=NRMW(su_kn,2*lane);su_k1=NRMW(su_kn,2*lane+1); \
    _Pragma("unroll") for(int r=0;r<8;++r){ su_q[r]=NRMW(su_qn,8*qb+r); su_u[r]=NRMW(su_kn,8*qb+r); } \
    su_fcj=FCbh[64*lane+63];su_fc0=FCbh[256*qb]; \
    su_v0=(f32x4_l){0.f,0.f,0.f,0.f};su_v1=(f32x4_l){0.f,0.f,0.f,0.f}; \
    if(tid*4<kend)su_v0=*reinterpret_cast<const f32x4_l*>(FCbh+tid*4); \
    if(tid*4+NW*256<kend)su_v1=*reinterpret_cast<const f32x4_l*>(FCbh+tid*4+NW*256); \
    asm volatile("":::"memory"); __builtin_amdgcn_sched_barrier(0); \
    const bf16*Qw=Q+(rowbase+q0+wid*QBLK)*DM+h*D; Kh=K+rowbase*DM+h*D;Vh=V+rowbase*DM+h*D; \
    DMA_K(0,0);DMA_V(0,0);DMA_K(1,SLOTB); \
    _Pragma("unroll") for(int d0=0;d0<4;++d0)qr[d0]=*reinterpret_cast<const bf16x8*>(&Qw[(long)r32*DM+d0*16+hi*8]); \
    DMA_K(2,2*SLOTB); }while(0)
  #define XFR(v) __builtin_bit_cast(bf16x8,(u32x4){(v)[0],(v)[1],(v)[0],(v)[1]})
  #define CINIT(C0,C1,t) do{ const v2u_t a_=*(const __attribute__((address_space(3))) v2u_t*)(fbx+(NTF-1-(t))*512), b_=*(const __attribute__((address_space(3))) v2u_t*)(fbx+(NTF-1-(t))*512+256); \
      C0=__builtin_amdgcn_mfma_f32_32x32x16_bf16(XFR(a_),qx,negm,0,0,0); C1=__builtin_amdgcn_mfma_f32_32x32x16_bf16(XFR(b_),qx,negm,0,0,0); }while(0)
  #define CMASK(P0,P1,t) do{int jb_=3-(t); if(jb_>=0)cmask(P0,P1,jb_,qrel,hi);}while(0)
  #define START(P0,P1) do{ const float rm=rowmax(P0,P1); resc=false; \
    { const float dl=__builtin_fmaxf(rm,lower_); mhat=fadd_s(mhat,dl); \
      _Pragma("unroll") for(int r=0;r<16;++r){P0[r]=fsub_s(P0[r],dl);P1[r]=fsub_s(P1[r],dl);} \
      _Pragma("unroll") for(int r=0;r<16;++r)negm[r]=-mhat; asm volatile("":"+v"(negm)); } \
    _Pragma("unroll") for(int r=0;r<16;++r)P0[r]=__builtin_amdgcn_exp2f(P0[r]); }while(0)
  #define RESC() do{ if(resc){ asm volatile("s_waitcnt lgkmcnt(0)":::"memory"); \
      _Pragma("unroll") for(int d_=0;d_<2;++d_) _Pragma("unroll") for(int r=0;r<16;++r)o[d_][r]*=wsf[crow(r,hi)]; } }while(0)
  #define ROT() do{sl_prev=sl_cur;sl_cur=sl_next;sl_next=(sl_next==(NSLOT-1)*SLOTB)?0:sl_next+SLOTB;}while(0)
  { WAVE_CONSTS(); (void)wsf;(void)vb0;(void)Kbase;(void)kp0;(void)vp0;(void)qrel;(void)fbx;(void)qx; UNIT_ISSUE(rank); }
  int nrank,nu=0; bool pst=false;
  #pragma nounroll
  for(;;){
  WAVE_CONSTS(); bf16x8 kf[8];
  float mhat=0.f,l_reg=0.f;f32x16 o[2];o[0]=f32x16{};o[1]=f32x16{};f32x16 negm=f32x16{};asm volatile("":"+v"(negm));
  bool resc=false;
  f32x16 pA0,pA1,pB0,pB1;
  int sl_prev=0,sl_cur=0,sl_next=SLOTB;
  int j0; float cb; bool nomax;
  { float sc_=su_bt;
    #define DPPF0(V,CTRL,RM) __builtin_bit_cast(float,__builtin_amdgcn_update_dpp(0,__builtin_bit_cast(int,V),CTRL,RM,0xf,true))
    sc_+=DPPF0(sc_,0x111,0xf); sc_+=DPPF0(sc_,0x112,0xf); sc_+=DPPF0(sc_,0x114,0xf); sc_+=DPPF0(sc_,0x118,0xf);
    sc_+=DPPF0(sc_,0x142,0xa);
    #undef DPPF0
    const float offv=sc_-su_bt;
    const float kn2=__uint_as_float(su_k0)+__uint_as_float(su_k1);
    float qn2=0.f,ku2=0.f;
    #pragma unroll
    for(int r=0;r<4;++r){ qn2=fmaxf(qn2,__uint_as_float(su_q[2*r])+__uint_as_float(su_q[2*r+1])); ku2=fmaxf(ku2,__uint_as_float(su_u[2*r])+__uint_as_float(su_u[2*r+1])); }
    const float Qm=sqrtf(qn2)*1.01f,Kj=sqrtf(kn2)*1.01f,Ku=sqrtf(ku2)*1.01f; cb=Qm*Ku;
    const float fbj=-(su_fcj+pg8::lane_read(offv,lane>>1)),fb0=-(su_fc0+pg8::lane_read(offv,2*qb));
    const bool needed=(lane>=4*qb)||!(Qm*(Kj+Ku)+fbj-fb0<SKIP_L2);
    j0=__builtin_amdgcn_readfirstlane((int)(__builtin_ctzll(__ballot(needed)))&~1);
    nomax=(__ballot((lane>=j0)&&(lane<NTF)&&!(Qm*(Kj+Ku)<=78.f))==0ull);
    __attribute__((address_space(3))) u32x4* tb=(__attribute__((address_space(3))) u32x4*)(shm3+LDS_FB);
    #pragma unroll
    for(int k_=0;k_<2;++k_){ const int s_=tid*4+k_*NW*256;
      if(s_<kend){ const f32x4_l v_=(k_?su_v1:su_v0)+pg8::lane_read(offv,s_>>7); unsigned w0[4],w1[4];
        #pragma unroll
        for(int i_=0;i_<4;++i_){ const float f=-v_[i_]; const unsigned hb=cvtpk_s(f,0.f)&0xffffu; const float r1=f-__uint_as_float(hb<<16); const unsigned mb=cvtpk_s(r1,0.f)&0xffffu; const float r2=r1-__uint_as_float(mb<<16);
          w0[i_]=hb|(mb<<16); w1[i_]=cvtpk_s(r2,0.f)&0xffffu; }
        tb[s_/2]=(u32x4){w0[0],w1[0],w0[1],w1[1]}; tb[s_/2+1]=(u32x4){w0[2],w1[2],w0[3],w1[3]}; } }
  }
  const int NT=NTF-j0;
#if PROBE_STEPS
  steps+=NT;
#endif
  if(pst){WAIT_BAR(4);}else{WAIT_BAR(3);}
  float lower_; { const v2u_t e_=*(const __attribute__((address_space(3))) v2u_t*)(shm3+LDS_FB+(q0+qrel)*8); lower_=(__uint_as_float(e_[0]<<16)+__uint_as_float(e_[0]&0xffff0000u))+__uint_as_float(e_[1]<<16)-cb; }
  CINIT(pA0,pA1,0); qkt(pA0,pA1,Kbase,qr,r32,hi);asm volatile("s_nop 15\n\ts_nop 7":"+v"(pA0),"+v"(pA1));CMASK(pA0,pA1,0);
  START(pA0,pA1);
  _Pragma("unroll") for(int r=0;r<16;++r)pA1[r]=__builtin_amdgcn_exp2f(pA1[r]);
  if(pst){WAIT_BAR(4);}else{WAIT_BAR(0);}
  DMA_K(3,0);DMA_V(1,SLOTB);
  ROT();
  kload8(kf,kp0+sl_cur);
  WAIT_BAR(2);
  s16x4 vlo[8],vhi[8]; u32x4 pw0,pw1,pw2,pw3;
  #define PKW(P,B) cvtpk_s(P[B],P[B+1])
  #define PAF(k) __builtin_bit_cast(bf16x8,pw##k)
  #define VFR(i) (bf16x8){vlo[i][0],vlo[i][1],vlo[i][2],vlo[i][3],vhi[i][0],vhi[i][1],vhi[i][2],vhi[i][3]}
  #define PIN(x) asm volatile("":"+v"(x))
  #define MX3(a,b,c) __builtin_fmaxf(__builtin_fmaxf((a),(b)),(c))
  #define GAPA(MF,A0,A1,A2,A3,W0,W1,PW) do{ MF; sacc+=A0; sacc+=A1; sacc+=A2; sacc+=A3; PIN(sacc); W0; W1; PIN(PW); SBAR(); }while(0)
  #define EX(v) __builtin_amdgcn_exp2f(v)
  #define GAPB(MF,X,B) do{ MF; X[B]=EX(X[B]); X[B+1]=EX(X[B+1]); X[B+2]=EX(X[B+2]); X[B+3]=EX(X[B+3]); PIN(X); SBAR(); }while(0)
  #define VRD(i) do{ vlo[i]=vtr(vp_+(((i)>>2)*4096+((i)&3)*1024)); vhi[i]=vtr(vp_+(((i)>>2)*4096+((i)&3)*1024+512)); }while(0)
  #define KRD(G,j) do{ if(G){ kload2(kf,kp0+sl_next,j); SBAR(); } }while(0)
  #define STEP(C0,C1,P0,P1,t,GK,GV,GL) STEPX(C0,C1,P0,P1,t,GK,GV,GL,true)
  #define STEPX(C0,C1,P0,P1,t,GK,GV,GL,MX) do{ SBAR(); CINIT(C0,C1,t); SBAR(); \
    const lds_cptr vp_=vp0+sl_prev; \
    VRD(0); SBAR(); float sacc=(P0[0]+P0[1]); \
    GAPA(C0=__builtin_amdgcn_mfma_f32_32x32x16_bf16(kf[0],qr[0],C0,0,0,0), P0[2],P0[3],P0[4],P0[5],     pw0[0]=PKW(P0,0), pw0[1]=PKW(P0,2), pw0); \
    VRD(4); SBAR(); GAPA(C1=__builtin_amdgcn_mfma_f32_32x32x16_bf16(kf[1],qr[0],C1,0,0,0), P0[6],P0[7],P0[8],P0[9],     pw0[2]=PKW(P0,4), pw0[3]=PKW(P0,6), pw0); \
    VRD(1); SBAR(); GAPA(C0=__builtin_amdgcn_mfma_f32_32x32x16_bf16(kf[2],qr[1],C0,0,0,0),   P0[10],P0[11],P0[12],P0[13], pw1[0]=PKW(P0,8), pw1[1]=PKW(P0,10), pw1); \
    VRD(5); SBAR(); GAPA(C1=__builtin_amdgcn_mfma_f32_32x32x16_bf16(kf[3],qr[1],C1,0,0,0),   P0[14],P0[15],P1[0],P1[1],   pw1[2]=PKW(P0,12),pw1[3]=PKW(P0,14), pw1); \
    VRD(2); SBAR(); GAPA(C0=__builtin_amdgcn_mfma_f32_32x32x16_bf16(kf[4],qr[2],C0,0,0,0),   P1[2],P1[3],P1[4],P1[5],     pw2[0]=PKW(P1,0), pw2[1]=PKW(P1,2), pw2); \
    VRD(6); SBAR(); GAPA(C1=__builtin_amdgcn_mfma_f32_32x32x16_bf16(kf[5],qr[2],C1,0,0,0),   P1[6],P1[7],P1[8],P1[9],     pw2[2]=PKW(P1,4), pw2[3]=PKW(P1,6), pw2); \
    VRD(3); SBAR(); GAPA(C0=__builtin_amdgcn_mfma_f32_32x32x16_bf16(kf[6],qr[3],C0,0,0,0),   P1[10],P1[11],P1[12],P1[13], pw3[0]=PKW(P1,8), pw3[1]=PKW(P1,10), pw3); \
    VRD(7); SBAR(); GAPA(C1=__builtin_amdgcn_mfma_f32_32x32x16_bf16(kf[7],qr[3],C1,0,0,0),   P1[14],P1[15],0.f,0.f,       pw3[2]=PKW(P1,12),pw3[3]=PKW(P1,14), pw3); \
    l_reg+=sacc; \
    if(GK){DMA_K((t)+3,sl_cur);} if(GV){DMA_V((t)+1,sl_next);} \
    CMASK(C0,C1,t); \
    if(!(MX)){ resc=false; } else \
    { float a=MX3(C0[0],C0[1],C1[0]),b=MX3(C0[2],C0[3],C1[1]); a=MX3(a,C1[2],C1[3]); \
      _Pragma("unroll") for(int r=4;r<16;r+=4){a=MX3(a,C0[r],C0[r+1]);b=MX3(b,C0[r+2],C0[r+3]);a=MX3(a,C1[r],C1[r+1]);b=MX3(b,C1[r+2],C1[r+3]);} \
      float rm=__builtin_fmaxf(a,b); { auto rr=__builtin_amdgcn_permlane32_swap(__float_as_uint(rm),__float_as_uint(rm),false,false); rm=__builtin_fmaxf(__uint_as_float(rr[0]),__uint_as_float(rr[1])); } \
      resc=false; \
      if(__builtin_expect(__any(rm>(float)THRL),0)){ const float dl=__builtin_fmaxf(rm,0.f); mhat+=dl; \
        _Pragma("unroll") for(int r=0;r<16;++r){C0[r]-=dl;C1[r]-=dl;} \
        _Pragma("unroll") for(int r=0;r<16;++r)negm[r]=-mhat; asm volatile("":"+v"(negm)); \
        const float f=__builtin_amdgcn_exp2f(-dl); l_reg*=f; if(hi==0)wsf[r32]=f; resc=true; } } \
    SBAR(); \
    GAPB(o[0]=__builtin_amdgcn_mfma_f32_32x32x16_bf16(PAF(0),VFR(0),o[0],0,0,0), C0,0); \
    GAPB(o[1]=__builtin_amdgcn_mfma_f32_32x32x16_bf16(PAF(0),VFR(4),o[1],0,0,0), C0,4); \
    KRD(GL,0); GAPB(o[0]=__builtin_amdgcn_mfma_f32_32x32x16_bf16(PAF(1),VFR(1),o[0],0,0,0), C0,8); \
    KRD(GL,1); GAPB(o[1]=__builtin_amdgcn_mfma_f32_32x32x16_bf16(PAF(1),VFR(5),o[1],0,0,0), C0,12); \
    KRD(GL,2); GAPB(o[0]=__builtin_amdgcn_mfma_f32_32x32x16_bf16(PAF(2),VFR(2),o[0],0,0,0), C1,0); \
    KRD(GL,3); GAPB(o[1]=__builtin_amdgcn_mfma_f32_32x32x16_bf16(PAF(2),VFR(6),o[1],0,0,0), C1,4); \
    GAPB(o[0]=__builtin_amdgcn_mfma_f32_32x32x16_bf16(PAF(3),VFR(3),o[0],0,0,0), C1,8); \
    GAPB(o[1]=__builtin_amdgcn_mfma_f32_32x32x16_bf16(PAF(3),VFR(7),o[1],0,0,0), C1,12); \
    }while(0)
  int t=1;
  #define ENDW(tt) do{ if((tt)+3<NT){WAIT_BAR(2);} else if((tt)+2<NT){WAIT_BAR(1);} else {WAIT_BAR(0);} }while(0)
  #define GUARDED_PAIR() do{ \
    STEP(pB0,pB1,pA0,pA1,t,(t+3<NT),(t+1<NT),(t+1<NT));       ENDW(t);   RESC(); ROT(); \
    STEP(pA0,pA1,pB0,pB1,t+1,(t+4<NT),(t+2<NT),(t+2<NT));     ENDW(t+1); RESC(); ROT(); }while(0)
  for(;t<5&&t+1<NT;t+=2){ GUARDED_PAIR(); }
  #undef CMASK
  #define CMASK(P0,P1,t) do{}while(0)
  for(;t+5<NT;t+=2){
    STEPX(pB0,pB1,pA0,pA1,t,true,true,true,!nomax);     WAIT_BAR(2); RESC(); ROT();
    STEPX(pA0,pA1,pB0,pB1,t+1,true,true,true,!nomax);   WAIT_BAR(2); RESC(); ROT();
  }
  #undef CMASK
  #define CMASK(P0,P1,t) do{int jb_=3-(t); if(jb_>=0)cmask(P0,P1,jb_,qrel,hi);}while(0)
  for(;t+1<NT;t+=2){ GUARDED_PAIR(); }
  unsigned su_tk=0u; { const char*w_=AB.ws; asm volatile("":"+s"(w_)); if(tid==0)su_tk=__hip_atomic_fetch_add((unsigned*)(w_+AB.qat)+64*x,1u,__ATOMIC_RELAXED,__HIP_MEMORY_SCOPE_AGENT); }
  STEP(pB0,pB1,pA0,pA1,NT-1,false,false,false); RESC();
  { float sacc=pB0[0]+pB0[1]; _Pragma("unroll") for(int r=2;r<16;++r)sacc+=pB0[r]; _Pragma("unroll") for(int r=0;r<16;++r)sacc+=pB1[r]; l_reg+=sacc;
    pw0=(u32x4){PKW(pB0,0),PKW(pB0,2),PKW(pB0,4),PKW(pB0,6)};pw1=(u32x4){PKW(pB0,8),PKW(pB0,10),PKW(pB0,12),PKW(pB0,14)};pw2=(u32x4){PKW(pB1,0),PKW(pB1,2),PKW(pB1,4),PKW(pB1,6)};pw3=(u32x4){PKW(pB1,8),PKW(pB1,10),PKW(pB1,12),PKW(pB1,14)};
    SBAR(); pv(o,vb0+sl_cur,PAF(0),PAF(1),PAF(2),PAF(3)); }
  bf16*Ow; { const char*w_=AB.ws; asm volatile("":"+s"(w_)); Ow=(bf16*)(w_+AB.o)+(rowbase+q0+wid*QBLK)*ODM+h*D; }
  if(tid==0)*(volatile __attribute__((address_space(3))) unsigned*)(shm3+LDS_TICKET)=su_tk;
  asm volatile("s_waitcnt vmcnt(0) lgkmcnt(0)\n\ts_barrier":::"memory");
  nrank=32+__builtin_amdgcn_readfirstlane((int)*(volatile __attribute__((address_space(3))) unsigned*)(shm3+LDS_TICKET));
  #define UNIT_EPILOGUE() do{ \
  {auto rr=__builtin_amdgcn_permlane32_swap(__float_as_uint(l_reg),__float_as_uint(l_reg),false,false);l_reg=__uint_as_float(rr[0])+__uint_as_float(rr[1]);} \
  if(hi==0)wsf[32+r32]=l_reg;asm volatile("s_waitcnt lgkmcnt(0)":::"memory"); \
  float rli[16]; \
  _Pragma("unroll") \
  for(int r=0;r<16;++r)rli[r]=__builtin_amdgcn_rcpf(wsf[32+crow(r,hi)]); \
  { bf16*stg=(bf16*)(shm+LDS_OST)+wid*2048; \
    _Pragma("unroll") \
    for(int r=0;r<16;++r){const int orow=crow(r,hi); \
      _Pragma("unroll") \
      for(int d0=0;d0<2;++d0)stg[orow*64+d0*32+r32]=__float2bfloat16(o[d0][r]*rli[r]);} \
    asm volatile("s_waitcnt lgkmcnt(0)":::"memory"); \
    asm volatile("s_waitcnt vmcnt(0)":"+v"(qr[0]),"+v"(qr[1]),"+v"(qr[2]),"+v"(qr[3])::"memory"); \
    _Pragma("unroll") \
    for(int i=0;i<4;++i){const int row=i*8+(lane>>3),ch=lane&7; const u32x4 v=*(const u32x4*)(stg+row*64+ch*8); ATTN_STORE16(Ow+(long)row*ODM+ch*8,v);} } \
  }while(0)
  ++nu; const bool go_=(nrank<128)&&(nu<maxu);
  if(go_){ UNIT_ISSUE(nrank); }
  else{ qb=0;q0=0;h=0;NTF=0;kend=0;rowbase=0;Kh=nullptr;Vh=nullptr; su_bt=0.f;su_fcj=0.f;su_fc0=0.f;su_k0=0u;su_k1=0u;
    _Pragma("unroll") for(int r=0;r<8;++r){su_q[r]=0u;su_u[r]=0u;} su_v0=(f32x4_l){0.f,0.f,0.f,0.f};su_v1=su_v0;
    _Pragma("unroll") for(int d0=0;d0<4;++d0)qr[d0]=bf16x8{}; }
  UNIT_EPILOGUE();
  if(!go_)break;
  pst=true;
  }
  ndone+=nu;
  #undef UNIT_EPILOGUE
  #undef PKW
  #undef PAF
  #undef VFR
  #undef PIN
  #undef MX3
  #undef GAPA
  #undef GAPB
  #undef EX
  #undef VRD
  #undef KRD
  #undef STEP
  #undef STEPX
  #undef ENDW
  #undef GUARDED_PAIR
  #undef UNIT_ISSUE
  #undef WAVE_CONSTS
  #undef NRMW
  #undef DMA_K
  #undef DMA_V
  #undef CMASK
  #undef START
  #undef RESC
  #undef ROT
  #undef CINIT
  #undef XFR
  asm volatile("s_barrier":::"memory");
  return nrank;
}
constexpr int ATTN_LDS_BYTES=LDS_FB+LDS_FB_BYTES;
struct AttnTensors { const bf16* Q; const bf16* K; const bf16* V; bf16* O; const float* FC; const float* BT; };
struct AttnUnit { int bh; int qb; };
struct StaticOrder {
  int vcu;
  __device__ __forceinline__ explicit StaticOrder(int vcu_):vcu(vcu_){}
  __device__ __forceinline__ bool next(int i,AttnUnit&u)const{ if(i>=4||vcu>=256)return false; const int s=vcu&3; u.bh=vcu>>2; u.qb=(i==0)?s:(i==1)?7-s:(i==2)?8+s:15-s; return true; }
};
__device__ __forceinline__ int skip_tiles(const unsigned*nrm,const float*FCbh,const float offv,int bh,int qb,int lane,float&cb){
  const unsigned*qn=nrm+((size_t)bh*64)*2,*kn=nrm+((size_t)(64+bh)*64)*2;
  #define NRM2(p,i) (__uint_as_float(__hip_atomic_load((p)+2*(i),__ATOMIC_RELAXED,__HIP_MEMORY_SCOPE_AGENT))+__uint_as_float(__hip_atomic_load((p)+2*(i)+1,__ATOMIC_RELAXED,__HIP_MEMORY_SCOPE_AGENT)))
  const float kn2=NRM2(kn,lane);
  float qn2=0.f,ku2=0.f;
  #pragma unroll
  for(int r=0;r<4;++r){ qn2=fmaxf(qn2,NRM2(qn,4*qb+r)); ku2=fmaxf(ku2,NRM2(kn,4*qb+r)); }
  #undef NRM2
  const float Qm=sqrtf(qn2)*1.01f,Kj=sqrtf(kn2)*1.01f,Ku=sqrtf(ku2)*1.01f; cb=Qm*Ku;
  const float fbj=-(FCbh[64*lane+63]+pg8::lane_read(offv,lane>>1)),fb0=-(FCbh[256*qb]+pg8::lane_read(offv,2*qb));
  const bool needed=(lane>=4*qb)||!(Qm*(Kj+Ku)+fbj-fb0<-152.f);
  const unsigned long long mask=__ballot(needed);
  return (int)(__builtin_ctzll(mask))&~1;
}
template<int THRL=32,class Hook> __device__ __forceinline__ void attn_phase(char*lds,const AttnBase&AB,const int vcu,const int tid,Hook&hk){
#if PROBE_STEPS
  unsigned long long pa_=0ull,pb_=0ull,pc_=0ull;
#endif
  int x=vcu>>5,rank=vcu&31,steps=0,ndone=0;
  const int cvt_after=vcu&3; bool cvt_done=false,fin=false;
  volatile __attribute__((address_space(3))) int* tk=(volatile __attribute__((address_space(3))) int*)((lds_cptr)lds+LDS_TICKET);
  const bool young_=__builtin_amdgcn_readfirstlane(tid)>=256; if(young_)__builtin_amdgcn_s_setprio(1);
  #pragma nounroll
  for(;;){
    if(!cvt_done&&(fin||ndone>=cvt_after)){ if(young_)__builtin_amdgcn_s_setprio(0);
#if PROBE_STEPS
      const unsigned long long pq_=__builtin_amdgcn_s_memrealtime();
#endif
      hk.convert();
#if PROBE_STEPS
      pc_=__builtin_amdgcn_s_memrealtime()-pq_;
#endif
      if(young_)__builtin_amdgcn_s_setprio(1); cvt_done=true; }
    if(fin)break;
    if(rank<128){ rank=attn_units<THRL>(x,rank,AB,cvt_done?(1<<20):cvt_after-ndone,ndone,steps,lds); continue; }
    unsigned*qbase; { const char*w_=AB.ws; asm volatile("":"+s"(w_)); qbase=(unsigned*)(w_+AB.qat); }
    int t2_=threadIdx.x; asm volatile("":"+v"(t2_)); const int lane=t2_&63;
    if(t2_<64){ unsigned c=96u; if(lane<8)c=__hip_atomic_load(qbase+64*lane,__ATOMIC_RELAXED,__HIP_MEMORY_SCOPE_AGENT);
      int key=c<96u?(int)(((96u-c)<<3)|(unsigned)lane):0;
      #pragma unroll
      for(int o_=1;o_<8;o_<<=1){ const int t_=__builtin_amdgcn_ds_bpermute((lane^o_)<<2,key); key=key>t_?key:t_; }
      int xv=-1,rk=0;
      if(key>0){ xv=key&7; unsigned old=0u; if(lane==0)old=__hip_atomic_fetch_add(qbase+64*xv,1u,__ATOMIC_RELAXED,__HIP_MEMORY_SCOPE_AGENT); rk=32+(int)old; }
      if(lane==0){ tk[1]=xv; tk[2]=rk; } }
    __syncthreads();
    const int xv=__builtin_amdgcn_readfirstlane(tk[1]),rk=__builtin_amdgcn_readfirstlane(tk[2]);
    __syncthreads();
    if(xv<0){fin=true;continue;}
    x=xv; rank=rk;
  }
  if(young_)__builtin_amdgcn_s_setprio(0);
  { unsigned*pq; { const char*w_=AB.ws; asm volatile("":"+s"(w_)); pq=(unsigned*)(w_+AB.pq); }
    #pragma nounroll
    for(;;){ int t3_=threadIdx.x; asm volatile("":"+v"(t3_));
      if(t3_==0)tk[1]=(int)__hip_atomic_fetch_add(pq,1u,__ATOMIC_RELAXED,__HIP_MEMORY_SCOPE_AGENT);
      __syncthreads(); const int it=__builtin_amdgcn_readfirstlane(tk[1]); __syncthreads();
      if(it>=256)break;
      hk.block(it); } }
  hk.steps=steps;
#if PROBE_STEPS
  if(PROBE_STEPS==7)hk.steps=(int)((pb_-pa_)/10ull);
  if(PROBE_STEPS==8)hk.steps=(int)(pc_/10ull);
#endif
}
#undef SBAR
#undef WAIT_BAR
}

constexpr int NWAVES = 8;
#ifndef MK_PER_PHASE
#define MK_PER_PHASE 0
#endif
constexpr int BATCH = 8, SEQ = 4096, T = BATCH * SEQ, D = 1024, NL = 2, NH = 8, HD = 64, AW = 512, PW = 512, INW = 2056, NG = 4, NE = 8, NX = 32, FE = 256;
constexpr float RMS_EPS = 1e-6f;
constexpr int NPH = 16;
constexpr size_t MiB = 1u << 20;
constexpr size_t WS_CTL = 0, CTL_ZERO_BYTES = 1 * MiB;
constexpr size_t WS_MOD = 1 * MiB;
constexpr size_t WS_FRF = 1 * MiB + 512 * 1024;
constexpr size_t WS_RRF = WS_FRF + 128 * 1024;
constexpr size_t WS_FL = 2 * MiB;
constexpr size_t WS_FC = 3 * MiB;
constexpr size_t WS_CW = 4 * MiB;
constexpr size_t WS_LIST = 5 * MiB;
constexpr size_t WS_WIN = 10 * MiB, WS_WOUT = 18 * MiB, WS_WGU = 22 * MiB, WS_WD = 86 * MiB;
constexpr size_t WS_H = 118 * MiB;
constexpr size_t WS_QKVU = 182 * MiB;
constexpr size_t WS_AO = 310 * MiB;
constexpr size_t WS_DL = 374 * MiB;
constexpr size_t WS_XB = 438 * MiB;
constexpr size_t WS_END = 502 * MiB;
constexpr int CW_TIL = 98304, TIL_STRIDE = 320 * 64;
constexpr int CW_NRM = 32768, NRM_WORDS = 2 * 64 * 64 * 2;
constexpr int CW_PQ = 13312;
constexpr int CW_QAT = 12288;
constexpr int CW_TMO = 0, CW_CODE = 1, CW_BAR = 4096, CW_CNT = 16384;
constexpr int RING_OFF = 0, RING_BYTES = 131072;
constexpr int LDSCTL_OFF = RING_BYTES, MISC_OFF = LDSCTL_OFF + 320;
constexpr int ENT_OFF = LDSCTL_OFF + 1024, ENT_UNITS = 8;
constexpr int CWT_OFF = ENT_OFF + ENT_UNITS * 1024;
constexpr int TST_OFF = CWT_OFF + 3 * 1024;
constexpr int LDS_BYTES = 147456;
static_assert(TST_OFF + (65 + 4 * ENT_UNITS + 2) * 4 <= LDS_BYTES && MISC_OFF + 128 <= ENT_OFF, "LDS map");

#define GAS __attribute__((address_space(1)))
#define LAS __attribute__((address_space(3)))
typedef unsigned short bf16;
typedef unsigned v4u __attribute__((ext_vector_type(4)));
typedef float f32x4 __attribute__((ext_vector_type(4)));
typedef short bf16x8 __attribute__((ext_vector_type(8)));
typedef GAS unsigned gu32;
typedef GAS unsigned long long gu64;
#define RLX_AGENT __ATOMIC_RELAXED, __HIP_MEMORY_SCOPE_AGENT
#define LDS_WAIT() asm volatile("s_waitcnt lgkmcnt(0)" ::: "memory")
#define VM_WAIT() asm volatile("s_waitcnt vmcnt(0)" ::: "memory")
__device__ __forceinline__ unsigned long long rt() { return __builtin_amdgcn_s_memrealtime(); }
__device__ __forceinline__ unsigned f2bf(float f) { unsigned u = __builtin_bit_cast(unsigned, f); return (u + 0x7fffu + ((u >> 16) & 1u)) >> 16; }
__device__ __forceinline__ unsigned pk2(float lo, float hi) { return f2bf(lo) | (f2bf(hi) << 16); }

#define XB_TMO      128
#define XB_XCNT(j)  (256  + 64 * (j))
#define XB_XSUB(j)  (1280 + 64 * (j))
#define XB_XGEN(j)  (2304 + 64 * (j))
#define XB_TOP      3328
#define XB_TOPGEN   3392
#define XCD_BAR_WORDS 3456
#define XB_SPIN_CAP (1u << 18)

__device__ __forceinline__ unsigned xb_ld(unsigned* p)              { return __hip_atomic_load(p, __ATOMIC_RELAXED, __HIP_MEMORY_SCOPE_AGENT); }
__device__ __forceinline__ unsigned xb_add(unsigned* p, unsigned v) { return __hip_atomic_fetch_add(p, v, __ATOMIC_RELAXED, __HIP_MEMORY_SCOPE_AGENT); }
__device__ __forceinline__ unsigned xb_xcc_id() { return (unsigned)__builtin_amdgcn_s_getreg((3 << 11) | 20) & 0xFu; }
#define XB_SPIN(cond, bar) do { unsigned _sp = 0; while (cond) { __builtin_amdgcn_s_sleep(1); \
    if ((++_sp & 255u) == 0u) { if (xb_ld(&(bar)[XB_TMO])) break; if (_sp > XB_SPIN_CAP) { atomicAdd(&(bar)[XB_TMO], 1u); break; } } } } while (0)

struct XcdBarrier {
    unsigned* bar; unsigned x;
    volatile LAS unsigned* st;
};

__device__ __forceinline__ XcdBarrier xcd_barrier_post(unsigned* bar, volatile LAS unsigned* st) {
    XcdBarrier b; b.bar = bar; b.x = xb_xcc_id(); b.st = st;
    if (threadIdx.x == 0) (void)xb_add(&bar[XB_XCNT(b.x)], 1u);
    return b;
}
__device__ __forceinline__ void xcd_barrier_complete(unsigned* bar, unsigned x, unsigned& nloc, unsigned& nx) {
    const unsigned G = gridDim.x * gridDim.y * gridDim.z;
    unsigned sum, cnt, mine, sp = 0u;
    for (;;) {
        sum = 0u; cnt = 0u; mine = 0u;
#pragma unroll
        for (unsigned j = 0; j < 16; ++j) { const unsigned c = xb_ld(&bar[XB_XCNT(j)]); sum += c; cnt += (c > 0u) ? 1u : 0u; mine = (j == x) ? c : mine; }
        if (sum == G) break;
        __builtin_amdgcn_s_sleep(1);
        if ((++sp & 255u) == 0u) { if (xb_ld(&bar[XB_TMO])) break; if (sp > XB_SPIN_CAP) { atomicAdd(&bar[XB_TMO], 1u); break; } }
    }
    nloc = mine > 0u ? mine : 1u; nx = cnt > 0u ? cnt : 1u;
}

__device__ __forceinline__ void xcd_barrier(const XcdBarrier& b) {
    asm volatile("s_waitcnt vmcnt(0)" ::: "memory");
    __syncthreads();
    if (threadIdx.x == 0) {
        unsigned* bar = b.bar;
        __builtin_amdgcn_s_waitcnt(0);
        unsigned nloc = b.st[0], nx = b.st[1];
        if (nloc == 0u) { xcd_barrier_complete(bar, b.x, nloc, nx); b.st[0] = nloc; b.st[1] = nx; }
        const unsigned old = xb_add(&bar[XB_XSUB(b.x)], 1u);
        const unsigned gen = old / nloc;
        if (old + 1u == (gen + 1u) * nloc) {
            __builtin_amdgcn_fence(__ATOMIC_RELEASE, "agent");
            asm volatile("s_waitcnt vmcnt(0)" ::: "memory");
            const unsigned og = xb_add(&bar[XB_TOP], 1u);
            const unsigned tg = og / nx;
            if (og + 1u == (tg + 1u) * nx) xb_add(&bar[XB_TOPGEN], 1u);
            else XB_SPIN(xb_ld(&bar[XB_TOPGEN]) == tg, bar);
            __builtin_amdgcn_fence(__ATOMIC_ACQUIRE, "agent");
            xb_add(&bar[XB_XGEN(b.x)], 1u);
            asm volatile("s_waitcnt vmcnt(0)" ::: "memory");
        } else {
            XB_SPIN(xb_ld(&bar[XB_XGEN(b.x)]) == gen, bar);
            __builtin_amdgcn_fence(__ATOMIC_ACQUIRE, "agent");
            asm volatile("s_waitcnt vmcnt(0)" ::: "memory");
        }
    }
    __syncthreads();
}

struct Frame {
    LAS unsigned char* lds;
    volatile LAS unsigned* MISC;
    gu32* ctl;
    int tid, lane, wave;
    int vcu, G;
};
typedef unsigned u32x4v __attribute__((ext_vector_type(4)));
__device__ __forceinline__ float bflo(unsigned w) { return __builtin_bit_cast(float, w << 16); }
__device__ __forceinline__ float bfhi(unsigned w) { return __builtin_bit_cast(float, w & 0xffff0000u); }
__device__ __forceinline__ unsigned cvtpk(float lo, float hi) { unsigned r; asm volatile("v_cvt_pk_bf16_f32 %0, %1, %2" : "=v"(r) : "v"(lo), "v"(hi)); return r; }

__device__ __forceinline__ void transpose_load64(f32x4 (&v)[16], const float* W, int ldw, int k0, int n0src, int lane) {
    const float* src = W + (size_t)(k0 + (lane >> 4)) * ldw + n0src + 4 * (lane & 15);
#pragma unroll
    for (int i = 0; i < 16; ++i) v[i] = *(const f32x4*)(src + (size_t)(4 * i) * ldw);
}
__device__ __forceinline__ void transpose_finish64(const f32x4 (&v)[16], bf16* WT, int ldt, int k0, int dstrow0, LAS float* scr, int lane) {
#pragma unroll
    for (int i = 0; i < 16; ++i) { const int k = 4 * i + (lane >> 4); const int col = (4 * (lane & 15) + 8 * (k >> 3)) & 63; *(LAS f32x4*)(scr + k * 64 + col) = v[i]; }
    LDS_WAIT(); asm volatile("" ::: "memory");
    const int c = lane >> 3;
#pragma unroll
    for (int q = 0; q < 8; ++q) { const int n = (lane & 7) + 8 * q; const LAS float* s_ = scr + (8 * c) * 64 + ((n + 8 * c) & 63);
        v4u o; o.x = pk2(s_[0], s_[64]); o.y = pk2(s_[128], s_[192]); o.z = pk2(s_[256], s_[320]); o.w = pk2(s_[384], s_[448]);
        *(GAS v4u*)(WT + (size_t)(dstrow0 + n) * ldt + k0 + 8 * c) = o; }
    LDS_WAIT(); asm volatile("" ::: "memory");
}
__device__ __forceinline__ void transpose_item64(const float* W, int ldw, bf16* WT, int ldt, int k0, int n0src, int dstrow0, LAS float* scr, int lane) {
    f32x4 v[16];
    transpose_load64(v, W, ldw, k0, n0src, lane);
    asm volatile("" ::: "memory"); __builtin_amdgcn_sched_barrier(0);
    transpose_finish64(v, WT, ldt, k0, dstrow0, scr, lane);
}
struct In {
    const float *x, *c, *g_mix, *g_ffn, *g_fin, *w_ada, *b_ada, *w_in, *b_fg, *w_pool, *pool_scale, *w_out, *w_rg, *b_rg, *w_re, *b_re, *w_eg, *w_eu, *w_ed;
};
__device__ __forceinline__ void p0_prologue(Frame& F, const In& I, unsigned char* ws, int mode) {
    bf16* WinT = (bf16*)(ws + WS_WIN); bf16* WoutT = (bf16*)(ws + WS_WOUT);
    float* MOD = (float*)(ws + WS_MOD);
#ifndef WG_REPS
#define WG_REPS 1
#endif
#pragma nounroll
    for (int wrp = 0; wrp < WG_REPS; ++wrp)
    if (mode != 1 && F.vcu < 64) {
        const int l = F.vcu >> 5, g = (F.vcu >> 3) & 3, nb = F.vcu & 7;
        LAS float* ApT = (LAS float*)F.lds;
        LAS float* Bw = ApT + 128 * 128;
        const float* wp = I.w_pool + (size_t)(l * 4 + g) * 128 * 128; const float* ps = I.pool_scale + l * 512 + g * 128;
        const float* wo = I.w_out + (size_t)l * D * D + (size_t)(512 + 128 * g) * D + 128 * nb;
        { f32x4 va[8], vb[8];
#pragma unroll
          for (int j = 0; j < 8; ++j) { const int q4 = F.tid + 512 * j; const int r = q4 >> 5, c4 = (q4 & 31) * 4; va[j] = *(const f32x4*)(wp + r * 128 + c4); vb[j] = *(const f32x4*)(wo + (size_t)r * D + c4); }
#pragma unroll
          for (int j = 0; j < 8; ++j) { const int q4 = F.tid + 512 * j; const int r = q4 >> 5, c4 = (q4 & 31) * 4;
              const f32x4 p4 = *(const f32x4*)(ps + c4);
              const int rs = r ^ (((c4 >> 2) & 15) << 3);
              ApT[(c4 + 0) * 128 + rs] = va[j][0] * p4[0]; ApT[(c4 + 1) * 128 + rs] = va[j][1] * p4[1]; ApT[(c4 + 2) * 128 + rs] = va[j][2] * p4[2]; ApT[(c4 + 3) * 128 + rs] = va[j][3] * p4[3];
              *(LAS f32x4*)(Bw + r * 128 + c4) = vb[j]; } }
        __syncthreads();
        const int tn = F.tid & 31, tc = F.tid >> 5;
        float acc[4][8];
#pragma unroll
        for (int i = 0; i < 4; ++i)
#pragma unroll
            for (int j = 0; j < 8; ++j) acc[i][j] = 0.f;
#pragma unroll 2
        for (int d = 0; d < 128; ++d) { const f32x4 bv = *(const LAS f32x4*)(Bw + d * 128 + 4 * tn);
            const int cs = (8 * tc) ^ (((d >> 2) & 15) << 3);
            const f32x4 a0 = *(const LAS f32x4*)(ApT + d * 128 + cs), a1 = *(const LAS f32x4*)(ApT + d * 128 + cs + 4);
#pragma unroll
            for (int i = 0; i < 4; ++i) { acc[i][0] += a0[0] * bv[i]; acc[i][1] += a0[1] * bv[i]; acc[i][2] += a0[2] * bv[i]; acc[i][3] += a0[3] * bv[i];
                acc[i][4] += a1[0] * bv[i]; acc[i][5] += a1[1] * bv[i]; acc[i][6] += a1[2] * bv[i]; acc[i][7] += a1[3] * bv[i]; } }
#pragma unroll
        for (int i = 0; i < 4; ++i) { bf16* dst = WoutT + (size_t)l * D * D + (size_t)(128 * nb + 4 * tn + i) * D + 512 + 128 * g + 8 * tc;
            v4u o; o.x = pk2(acc[i][0], acc[i][1]); o.y = pk2(acc[i][2], acc[i][3]); o.z = pk2(acc[i][4], acc[i][5]); o.w = pk2(acc[i][6], acc[i][7]);
            *(GAS v4u*)dst = o; }
        __syncthreads();
    } else if (mode != 1 && F.vcu < 256) {
        const int it = F.vcu - 64, l = it / 96, n0 = 64 * (it % 96);
        LAS float* cT = (LAS float*)F.lds;
        LAS float* part = (LAS float*)(F.lds + 32768);
        { float cv[16];
#pragma unroll
          for (int j = 0; j < 16; ++j) cv[j] = I.c[F.tid + 512 * j];
          asm volatile("" ::: "memory"); __builtin_amdgcn_sched_barrier(0);
#pragma unroll
          for (int j = 0; j < 16; ++j) { const int q = F.tid + 512 * j; const int b = q >> 10, k = q & 1023; cT[k * 8 + b] = cv[j] / (1.f + __expf(-cv[j])); } }
        __syncthreads();
        const int r4 = F.lane >> 4, c16 = F.lane & 15;
        const char* wb = (const char*)(I.w_ada + (size_t)l * D * 6144 + n0);
        const unsigned off0 = (unsigned)(((F.wave * 128 + r4) * 6144 + 4 * c16) * 4);
        float acc[8][4];
#pragma unroll
        for (int b = 0; b < 8; ++b) { acc[b][0] = 0.f; acc[b][1] = 0.f; acc[b][2] = 0.f; acc[b][3] = 0.f; }
#pragma unroll 1
        for (int kb = 0; kb < 2; ++kb) {
            f32x4 wv[16];
#pragma unroll
            for (int j = 0; j < 16; ++j) wv[j] = *(const f32x4*)(wb + (off0 + (unsigned)((kb * 64 + 4 * j) * 6144 * 4)));
            asm volatile("" ::: "memory"); __builtin_amdgcn_sched_barrier(0);
#pragma unroll
            for (int j = 0; j < 16; ++j) { const int k = F.wave * 128 + kb * 64 + 4 * j + r4;
                if ((j & 3) == 0) asm volatile("" ::: "memory");
                const f32x4 c0 = *(const LAS f32x4*)(cT + k * 8), c1 = *(const LAS f32x4*)(cT + k * 8 + 4);
#pragma unroll
                for (int i = 0; i < 4; ++i) { acc[0][i] += c0[0] * wv[j][i]; acc[1][i] += c0[1] * wv[j][i]; acc[2][i] += c0[2] * wv[j][i]; acc[3][i] += c0[3] * wv[j][i];
                    acc[4][i] += c1[0] * wv[j][i]; acc[5][i] += c1[1] * wv[j][i]; acc[6][i] += c1[2] * wv[j][i]; acc[7][i] += c1[3] * wv[j][i]; } }
        }
#pragma unroll
        for (int b = 0; b < 8; ++b) *(LAS f32x4*)(part + ((F.wave * 4 + r4) * 8 + b) * 64 + 4 * c16) = (f32x4){acc[b][0], acc[b][1], acc[b][2], acc[b][3]};
        __syncthreads();
        { const int b = F.wave; float s = I.b_ada[l * 6144 + n0 + F.lane];
#pragma unroll
            for (int sl = 0; sl < 32; ++sl) s += part[(sl * 8 + b) * 64 + F.lane];
            MOD[(size_t)(l * 8 + b) * 6144 + n0 + F.lane] = s; }
        __syncthreads();
    }
    { const int q = (F.G - 1 - F.vcu) * (NWAVES * 64) + F.tid;
      if (mode != 1 && q < NL * 32 * 4 * 64) {
        const int l = q >> 13, c = (q >> 8) & 31, nb4 = (q >> 6) & 3, ln = q & 63; const int n = ln & 15, k0 = 32 * c + 8 * (ln >> 4);
        const float* base; size_t stride; bool valid;
        if (nb4 == 3) { valid = n < 8; base = I.w_in + (size_t)l * D * INW + 1536 + (valid ? n : 0); stride = INW; }
        else { const int col = 16 * nb4 + n; valid = col < 36;
            if (col < 4) { base = I.w_rg + (size_t)l * D * 4 + col; stride = 4; }
            else { const int cc = valid ? col - 4 : 0; base = I.w_re + ((size_t)(l * 4 + (cc >> 3)) * D) * 8 + (cc & 7); stride = 8; } }
        float v[8];
#pragma unroll
        for (int j = 0; j < 8; ++j) v[j] = base[(size_t)(k0 + j) * stride];
#pragma unroll
        for (int j = 0; j < 8; ++j) v[j] = valid ? v[j] : 0.f;
        unsigned hi[4], lo[4];
#pragma unroll
        for (int j = 0; j < 4; ++j) { hi[j] = pk2(v[2 * j], v[2 * j + 1]); lo[j] = pk2(v[2 * j] - bflo(hi[j]), v[2 * j + 1] - bfhi(hi[j])); }
        v4u* dst = (nb4 == 3) ? (v4u*)(ws + WS_FRF) + ((size_t)(l * 32 + c) * 2) * 64 + ln : (v4u*)(ws + WS_RRF) + (((size_t)(l * 32 + c) * 3 + nb4) * 2) * 64 + ln;
        dst[0] = (v4u){hi[0], hi[1], hi[2], hi[3]}; dst[64] = (v4u){lo[0], lo[1], lo[2], lo[3]};
      } }
    LAS float* scr = (LAS float*)(F.lds + RING_OFF + F.wave * 16384);
    const int gw = (F.G - 1 - F.vcu) * NWAVES + F.wave, NGW = F.G * NWAVES;
    constexpr int IT_IN = 512, IT_OUT = 128, IT_L = IT_IN + IT_OUT;
#ifndef TR_REPS
#define TR_REPS 1
#endif
#pragma nounroll
    for (int trp = 0; trp < TR_REPS; ++trp)
    for (int it = gw; it < NL * IT_L; it += NGW) {
        const int l = it / IT_L; int r = it - l * IT_L;
        if (r < IT_IN) { const int kb = r >> 5, nb = r & 31; const int n0 = 64 * nb;
            transpose_item64(I.w_in + (size_t)l * D * INW, INW, WinT + (size_t)l * 2048 * D, D, 64 * kb, n0 < 1536 ? n0 : n0 + 8, n0, scr, F.lane); continue; }
        r -= IT_IN;
        if (r < IT_OUT) { const int kb = r >> 4, nb = r & 15;
            transpose_item64(I.w_out + (size_t)l * D * D, D, WoutT + (size_t)l * D * D, D, 64 * kb, 64 * nb, 64 * nb, scr, F.lane); continue; }
    }
}

struct NormArgs {
    const float* xin; const bf16* xinb;
    bf16* xwb; float* out;
    const unsigned char* Y0; const unsigned char* Y1; const float* gate;
    const bf16* Dl;
    const float* gamma; const float* scale; const float* shift;
    bf16* H; const v4u* frag;
    const float* bias0; const float* bias1;
    float* FL; float* BT; float* CW; unsigned* LIST; gu32* cnt;
};
template <bool XBF, bool ADD_D, bool ADD_Y, bool WRITE_XB, int NB, bool FINAL>
__device__ __forceinline__ void norm_phase(Frame& F, const NormArgs& A) {
    constexpr int NBX = NB > 0 ? NB : 1, LGW = 16 * NBX;
    constexpr bool TREG = (NB < 3);
    LAS float* gm = (LAS float*)F.lds; LAS float* shl = gm + 1024; LAS float* gtl = shl + 1024;
    LAS float* SSP = (LAS float*)(F.lds + 12288);
    LAS float* LGP = (LAS float*)(F.lds + 16384);
    LAS float* LGA = (LAS float*)(F.lds + 40960);
    LAS int* lcnt = (LAS int*)(F.lds + 65536); LAS int* gbase = lcnt + 32;
    const int tok0 = F.vcu * 128, b = tok0 >> 12;
    float tg_[2], tsc_[2], tsh_[2], tgt_[2];
#pragma unroll
    for (int j = 0; j < 2; ++j) { const int k = F.tid + NWAVES * 64 * j; tg_[j] = A.gamma[k]; tsc_[j] = FINAL ? 0.f : A.scale[(size_t)b * 6144 + k]; tsh_[j] = FINAL ? 0.f : A.shift[(size_t)b * 6144 + k];
        tgt_[j] = ADD_Y ? A.gate[(size_t)b * 6144 + k] : 0.f; }
    if (NB == 3 && F.tid < 32) lcnt[F.tid] = 0;
    const int i16 = F.lane & 15, kq = F.lane >> 4, kcol = 128 * F.wave + 8 * kq;
    bf16x8 Bh[NB > 0 ? 4 : 1][NBX], Bl[NB > 0 ? 4 : 1][NBX];
    if constexpr (NB > 0) {
#pragma unroll
        for (int c = 0; c < 4; ++c)
#pragma unroll
            for (int nb = 0; nb < NB; ++nb) { const size_t fi = ((size_t)((4 * F.wave + c) * NB + nb) * 2) * 64 + F.lane;
                Bh[c][nb] = __builtin_bit_cast(bf16x8, A.frag[fi]); Bl[c][nb] = __builtin_bit_cast(bf16x8, A.frag[fi + 64]); }
    }
    f32x4 xa[XBF ? 1 : 4][2], xn[XBF ? 1 : 4][2]; v4u xba[4], xbn[4], da[4], dn[4]; typedef unsigned v2u __attribute__((ext_vector_type(2))); v2u ya[2][4], yn[2][4];
#define NORM_LOAD(dst, bdst, ydst, ddst, it_) do { const size_t ro_ = (size_t)(tok0 + 16 * (it_) + i16) * D + kcol; \
        _Pragma("unroll") for (int c = 0; c < 4; ++c) { \
            if constexpr (XBF) bdst[c] = *(const v4u*)(A.xinb + ro_ + 32 * c); \
            else { dst[c][0] = *(const f32x4*)(A.xin + ro_ + 32 * c); dst[c][1] = *(const f32x4*)(A.xin + ro_ + 32 * c + 4); } \
            if (ADD_D) ddst[c] = *(const v4u*)(A.Dl + ro_ + 32 * c); \
            if (ADD_Y) { ydst[0][c] = *(const v2u*)(A.Y0 + ro_ + 32 * c); ydst[1][c] = *(const v2u*)(A.Y1 + ro_ + 32 * c); } } } while (0)
#define NORM_STEP(XA_, XBA_, YA_, DA_, IT_) do { \
        const size_t ro = (size_t)(tok0 + 16 * (IT_) + i16) * D + kcol; \
        f32x4 xv[4][2]; \
        float ss = 0.f; \
_Pragma("unroll") \
        for (int c = 0; c < 4; ++c) { \
            f32x4 a0, a1; \
            if constexpr (XBF) { const v4u xb = XBA_[c]; a0 = (f32x4){bflo(xb.x), bfhi(xb.x), bflo(xb.y), bfhi(xb.y)}; a1 = (f32x4){bflo(xb.z), bfhi(xb.z), bflo(xb.w), bfhi(xb.w)}; } \
            else { a0 = XA_[c][0]; a1 = XA_[c][1]; } \
            if (ADD_D) { const v4u d = DA_[c]; \
                a0[0] += bflo(d.x); a0[1] += bfhi(d.x); a0[2] += bflo(d.y); a0[3] += bfhi(d.y); a1[0] += bflo(d.z); a1[1] += bfhi(d.z); a1[2] += bflo(d.w); a1[3] += bfhi(d.w); } \
            if (ADD_Y) { const f32x4 g0 = TREG ? gtr[c][0] : *(const LAS f32x4*)(gtl + kcol + 32 * c), g1 = TREG ? gtr[c][1] : *(const LAS f32x4*)(gtl + kcol + 32 * c + 4); const v2u y0 = YA_[0][c], y1 = YA_[1][c]; typedef float f32x2u __attribute__((ext_vector_type(2))); \
                const f32x2u p0 = __builtin_amdgcn_cvt_pk_f32_fp8((int)y0[0], false) + __builtin_amdgcn_cvt_pk_f32_fp8((int)y1[0], false), p1 = __builtin_amdgcn_cvt_pk_f32_fp8((int)y0[0], true) + __builtin_amdgcn_cvt_pk_f32_fp8((int)y1[0], true); \
                const f32x2u p2 = __builtin_amdgcn_cvt_pk_f32_fp8((int)y0[1], false) + __builtin_amdgcn_cvt_pk_f32_fp8((int)y1[1], false), p3 = __builtin_amdgcn_cvt_pk_f32_fp8((int)y0[1], true) + __builtin_amdgcn_cvt_pk_f32_fp8((int)y1[1], true); \
                a0[0] += g0[0] * p0[0]; a0[1] += g0[1] * p0[1]; a0[2] += g0[2] * p1[0]; a0[3] += g0[3] * p1[1]; a1[0] += g1[0] * p2[0]; a1[1] += g1[1] * p2[1]; a1[2] += g1[2] * p3[0]; a1[3] += g1[3] * p3[1]; } \
            if (WRITE_XB) { v4u xo; xo.x = cvtpk(a0[0], a0[1]); xo.y = cvtpk(a0[2], a0[3]); xo.z = cvtpk(a1[0], a1[1]); xo.w = cvtpk(a1[2], a1[3]); *(v4u*)(A.xwb + ro + 32 * c) = xo; } \
            xv[c][0] = a0; xv[c][1] = a1; \
            ss += (a0[0] * a0[0] + a0[1] * a0[1]) + (a0[2] * a0[2] + a0[3] * a0[3]) + (a1[0] * a1[0] + a1[1] * a1[1]) + (a1[2] * a1[2] + a1[3] * a1[3]); \
        } \
        { auto r16_ = __builtin_amdgcn_permlane16_swap(__float_as_uint(ss), __float_as_uint(ss), false, false); ss = __uint_as_float(r16_[0]) + __uint_as_float(r16_[1]); \
          auto r32_ = __builtin_amdgcn_permlane32_swap(__float_as_uint(ss), __float_as_uint(ss), false, false); ss = __uint_as_float(r32_[0]) + __uint_as_float(r32_[1]); }     \
        LAS float* ssp = SSP + ((IT_) & 1) * 128; \
        if (kq == 0) ssp[F.wave * 16 + i16] = ss; \
        __syncthreads(); \
        float tot = 0.f; \
_Pragma("unroll") \
        for (int w = 0; w < 8; ++w) tot += ssp[w * 16 + i16]; \
        const float rstd = 1.0f / sqrtf(tot * (1.0f / D) + RMS_EPS); \
        f32x4 acc[NBX]; \
_Pragma("unroll") \
        for (int nb = 0; nb < NBX; ++nb) acc[nb] = (f32x4){0.f, 0.f, 0.f, 0.f}; \
_Pragma("unroll") \
        for (int c = 0; c < 4; ++c) { \
            const f32x4 m0 = TREG ? gmr[c][0] : *(const LAS f32x4*)(gm + kcol + 32 * c), m1 = TREG ? gmr[c][1] : *(const LAS f32x4*)(gm + kcol + 32 * c + 4); \
            const f32x4 s0 = TREG ? shr[c][0] : *(const LAS f32x4*)(shl + kcol + 32 * c), s1 = TREG ? shr[c][1] : *(const LAS f32x4*)(shl + kcol + 32 * c + 4); \
            const f32x4 h0 = xv[c][0] * rstd * m0 + s0, h1 = xv[c][1] * rstd * m1 + s1; \
            if (FINAL) { *(f32x4*)(A.out + ro + 32 * c) = h0; *(f32x4*)(A.out + ro + 32 * c + 4) = h1; } \
            else { \
                v4u hi; hi.x = cvtpk(h0[0], h0[1]); hi.y = cvtpk(h0[2], h0[3]); hi.z = cvtpk(h1[0], h1[1]); hi.w = cvtpk(h1[2], h1[3]); \
                *(v4u*)(A.H + ro + 32 * c) = hi; \
                if constexpr (NB > 0) { \
                    v4u lo; lo.x = cvtpk(h0[0] - bflo(hi.x), h0[1] - bfhi(hi.x)); lo.y = cvtpk(h0[2] - bflo(hi.y), h0[3] - bfhi(hi.y)); \
                    lo.z = cvtpk(h1[0] - bflo(hi.z), h1[1] - bfhi(hi.z)); lo.w = cvtpk(h1[2] - bflo(hi.w), h1[3] - bfhi(hi.w)); \
                    const bf16x8 Ah = __builtin_bit_cast(bf16x8, hi), Al = __builtin_bit_cast(bf16x8, lo); \
_Pragma("unroll") \
                    for (int nb = 0; nb < NB; ++nb) { \
                        acc[nb] = __builtin_amdgcn_mfma_f32_16x16x32_bf16(Ah, Bh[c][nb], acc[nb], 0, 0, 0); \
                        acc[nb] = __builtin_amdgcn_mfma_f32_16x16x32_bf16(Al, Bh[c][nb], acc[nb], 0, 0, 0); \
                        acc[nb] = __builtin_amdgcn_mfma_f32_16x16x32_bf16(Ah, Bl[c][nb], acc[nb], 0, 0, 0); } \
                } \
            } \
        } \
        if constexpr (NB > 0) { \
_Pragma("unroll") \
            for (int nb = 0; nb < NB; ++nb) \
_Pragma("unroll") \
                for (int r = 0; r < 4; ++r) LGP[(F.wave * 16 + 4 * kq + r) * LGW + 16 * nb + i16] = acc[nb][r]; \
            __syncthreads(); \
            for (int q = F.tid; q < 16 * LGW; q += NWAVES * 64) { float s = 0.f; \
_Pragma("unroll") \
                for (int w = 0; w < 8; ++w) s += LGP[w * 16 * LGW + q]; \
                LGA[(IT_) * 16 * LGW + q] = s; } \
        } \
    } while (0)
    NORM_LOAD(xa, xba, ya, da, 0);
#pragma unroll
    for (int j = 0; j < 2; ++j) { const int k = F.tid + NWAVES * 64 * j; gm[k] = FINAL ? tg_[j] : tg_[j] * (1.f + tsc_[j]); shl[k] = tsh_[j];
        if (ADD_Y) gtl[k] = tgt_[j] * (1.0f / 16.0f); }
    __syncthreads();
    f32x4 gmr[TREG ? 4 : 1][2], shr[TREG ? 4 : 1][2], gtr[(TREG && ADD_Y) ? 4 : 1][2];
    if constexpr (TREG) {
#pragma unroll
        for (int c = 0; c < 4; ++c) { gmr[c][0] = *(const LAS f32x4*)(gm + kcol + 32 * c); gmr[c][1] = *(const LAS f32x4*)(gm + kcol + 32 * c + 4); shr[c][0] = *(const LAS f32x4*)(shl + kcol + 32 * c); shr[c][1] = *(const LAS f32x4*)(shl + kcol + 32 * c + 4);
            if constexpr (ADD_Y) { gtr[c][0] = *(const LAS f32x4*)(gtl + kcol + 32 * c); gtr[c][1] = *(const LAS f32x4*)(gtl + kcol + 32 * c + 4); } }
    }
#pragma nounroll
    for (int it = 0; it < 8; it += 2) {
        NORM_LOAD(xn, xbn, yn, dn, it + 1);
        NORM_STEP(xa, xba, ya, da, it);
        NORM_LOAD(xa, xba, ya, da, (it + 2 < 8 ? it + 2 : 7));
        NORM_STEP(xn, xbn, yn, dn, it + 1);
    }
#undef NORM_STEP
#undef NORM_LOAD
    __syncthreads();
    if constexpr (NB == 1) {
        const int hh = F.wave, r0 = 2 * F.lane;
        const float bb = A.bias0[hh]; const float z0 = LGA[r0 * LGW + hh] + bb, z1 = LGA[(r0 + 1) * LGW + hh] + bb;
        const float v0 = fminf(z0, 0.f) - log1pf(__expf(-fabsf(z0))), v1 = fminf(z1, 0.f) - log1pf(__expf(-fabsf(z1)));
        float sc = v0 + v1;
#define NP_DPPF(V, CTRL, RM) __builtin_bit_cast(float, __builtin_amdgcn_update_dpp(0, __builtin_bit_cast(int, V), CTRL, RM, 0xf, true))
        sc += NP_DPPF(sc, 0x111, 0xf); sc += NP_DPPF(sc, 0x112, 0xf); sc += NP_DPPF(sc, 0x114, 0xf); sc += NP_DPPF(sc, 0x118, 0xf);
        sc += NP_DPPF(sc, 0x142, 0xa); sc += NP_DPPF(sc, 0x143, 0xc);
#undef NP_DPPF
        const float ex = sc - (v0 + v1); const float L2E = 1.4426950408889634f;
        typedef float f32x2n __attribute__((ext_vector_type(2)));
        *(f32x2n*)(A.FL + ((size_t)(b * 8 + hh) << 12) + (tok0 & (SEQ - 1)) + r0) = (f32x2n){(ex + v0) * L2E, (ex + v0 + v1) * L2E};
        if (F.lane == 63) A.BT[(b * 8 + hh) * 32 + ((tok0 & (SEQ - 1)) >> 7)] = sc * L2E;
    }
    if constexpr (NB == 3) {
        int e0 = 0, e1 = 0, r0 = 0, r1 = 0; float w0 = 0.f, w1 = 0.f;
        if (F.tid < 128) {
            const LAS float* row = LGA + F.tid * LGW;
            const float l0 = row[0] + A.bias0[0], l1 = row[1] + A.bias0[1], l2 = row[2] + A.bias0[2], l3 = row[3] + A.bias0[3];
            int g = 0; float mx = l0; if (l1 > mx) { mx = l1; g = 1; } if (l2 > mx) { mx = l2; g = 2; } if (l3 > mx) { mx = l3; g = 3; }
            const float top_p = 1.f / (__expf(l0 - mx) + __expf(l1 - mx) + __expf(l2 - mx) + __expf(l3 - mx));
            float v1 = -INFINITY, v2 = -INFINITY; int i1 = 0, i2 = 0;
#pragma unroll
            for (int j = 0; j < 8; ++j) { const float v = row[4 + 8 * g + j] + A.bias1[8 * g + j];
                if (v > v1) { v2 = v1; i2 = i1; v1 = v; i1 = j; } else if (v > v2) { v2 = v; i2 = j; } }
            const float e21 = __expf(v2 - v1), ew1 = 1.f / (1.f + e21);
            w0 = top_p * ew1; w1 = top_p * (e21 * ew1); e0 = 8 * g + i1; e1 = 8 * g + i2;
            r0 = __hip_atomic_fetch_add(lcnt + e0, 1, __ATOMIC_RELAXED, __HIP_MEMORY_SCOPE_WORKGROUP);
            r1 = __hip_atomic_fetch_add(lcnt + e1, 1, __ATOMIC_RELAXED, __HIP_MEMORY_SCOPE_WORKGROUP);
        }
        __syncthreads();
        if (F.tid < 32) gbase[F.tid] = (int)__hip_atomic_fetch_add(A.cnt + 64 * F.tid, (unsigned)lcnt[F.tid], __ATOMIC_RELAXED, __HIP_MEMORY_SCOPE_AGENT);
        __syncthreads();
        if (F.tid < 128) { const int tk = tok0 + F.tid;
            A.LIST[(size_t)e0 * T + gbase[e0] + r0] = 2u * tk; A.LIST[(size_t)e1 * T + gbase[e1] + r1] = 2u * tk + 1u;
            A.CW[2 * tk] = w0; A.CW[2 * tk + 1] = w1; }
    }
    __syncthreads();
}

struct Args { In in; float* out; unsigned char* ws; int ph_lo, ph_hi; };
typedef const __attribute__((address_space(4))) Args* KArgP;
__device__ __forceinline__ KArgP KA() { KArgP p = (KArgP)__builtin_amdgcn_kernarg_segment_ptr(); asm volatile("" : "+s"(p)); return p; }
#define WSP   (KA()->ws)
#define XRES  (KA()->out)
#define MODP  ((float*)(WSP + WS_MOD))
#define HB    ((bf16*)(WSP + WS_H))
#define QB_   ((bf16*)(WSP + WS_QKVU))
#define YB    ((unsigned char*)(WSP + WS_QKVU))
#define AOB   ((bf16*)(WSP + WS_AO))
#define ACTB  ((bf16*)(WSP + WS_AO))
#define FLP   ((float*)(WSP + WS_FL))
#define FCP   ((float*)(WSP + WS_FC))
#define CWP   ((float*)(WSP + WS_CW))
#define LISTP ((unsigned*)(WSP + WS_LIST))
#define CTLP  ((gu32*)(WSP + WS_CTL))
#define DLB   ((bf16*)(WSP + WS_DL))
#define XBB   ((bf16*)(WSP + WS_XB))
struct PoolDiff {
    Frame& F; const bf16* U; bf16* AO; v4u la[9], lb[9]; int steps;
    __device__ __forceinline__ void load(v4u (&ld)[9], const int half) { const int t0 = blk * 128, pos0 = t0 & (SEQ - 1);
#pragma unroll
        for (int j = 0; j < 9; ++j) { const int p = F.tid + 512 * j; const int r = p >> 5, cc = p & 31; v4u v = (v4u){0u, 0u, 0u, 0u};
            if (p < 143 * 32 && pos0 - 15 + r >= 0) v = *(const v4u*)(U + (size_t)(t0 - 15 + r) * 512 + half * 256 + 8 * cc);
            ld[j] = v; } }
    __device__ __forceinline__ void half_pass(const v4u (&ld)[9], const int half) { const int t0 = blk * 128, pos0 = t0 & (SEQ - 1);
        LAS v4u* tile = (LAS v4u*)F.lds;
#pragma unroll
        for (int j = 0; j < 9; ++j) { const int p = F.tid + 512 * j; if (p < 143 * 32) tile[p] = ld[j]; }
        __syncthreads();
        const int cc = F.tid & 31, tl0 = 8 * (F.tid >> 5); const int w = 2 << ((half * 32 + cc) >> 4);
        float sum[8];
#pragma unroll
        for (int q = 0; q < 8; ++q) sum[q] = 0.f;
#define POOL_ACC(V, SGN) do { sum[0] += SGN bflo((V).x); sum[1] += SGN bfhi((V).x); sum[2] += SGN bflo((V).y); sum[3] += SGN bfhi((V).y); sum[4] += SGN bflo((V).z); sum[5] += SGN bfhi((V).z); sum[6] += SGN bflo((V).w); sum[7] += SGN bfhi((V).w); } while (0)
        for (int d = 1; d < w; ++d) { const v4u v = tile[(15 + tl0 - d) * 32 + cc]; POOL_ACC(v, +); }
#pragma unroll 2
        for (int j = 0; j < 8; ++j) { const int tl = tl0 + j, pos = pos0 + tl;
            const v4u v = tile[(15 + tl) * 32 + cc]; POOL_ACC(v, +);
            const float rc = 1.0f / (float)((pos + 1) < w ? (pos + 1) : w);
            v4u o; o.x = pk2(sum[0] * rc - bflo(v.x), sum[1] * rc - bfhi(v.x)); o.y = pk2(sum[2] * rc - bflo(v.y), sum[3] * rc - bfhi(v.y));
            o.z = pk2(sum[4] * rc - bflo(v.z), sum[5] * rc - bfhi(v.z)); o.w = pk2(sum[6] * rc - bflo(v.w), sum[7] * rc - bfhi(v.w));
            *(v4u*)(AO + (size_t)(t0 + tl) * D + 512 + half * 256 + 8 * cc) = o;
            const v4u u = tile[(15 + tl - (w - 1)) * 32 + cc]; POOL_ACC(u, -); }
#undef POOL_ACC
        __syncthreads(); }
    int blk;
    __device__ __forceinline__ void block(const int it) { blk = it; load(la, 0); load(lb, 1); half_pass(la, 0); half_pass(lb, 1); }
    int l;
    __device__ __forceinline__ void convert() {
        const In& I = *(const In*)(const void*)(&KA()->in);
        bf16* WguT = (bf16*)(WSP + WS_WGU); bf16* WdT = (bf16*)(WSP + WS_WD);
        int t_ = threadIdx.x; asm volatile("" : "+v"(t_));
        const int lane_ = t_ & 63, wave_ = __builtin_amdgcn_readfirstlane(t_ >> 6);
        LAS float* scr = (LAS float*)(F.lds + RING_OFF + wave_ * 16384);
        constexpr int IT_E = 2048;
        struct Item { const float* W; int ldw; bf16* WT; int ldt, k0, n0src, dstrow0; };
        auto item = [&](int j) -> Item { int r = (F.vcu + 256 * j) * NWAVES + wave_;
            if (r < 2 * IT_E) { const int up = r >= IT_E; if (up) r -= IT_E; const int e = r >> 6, q = r & 63, kb = q >> 2, nb = q & 3, n0 = 64 * nb;
                return Item{(up ? I.w_eu : I.w_eg) + (size_t)(l * NX + e) * D * FE, FE, WguT + (size_t)(l * NX + e) * 512 * D, D, 64 * kb, n0, 256 * (n0 >> 7) + (n0 & 127) + (up ? 128 : 0)}; }
            r -= 2 * IT_E; const int e = r >> 6, q = r & 63, kb = q >> 4, nb = q & 15;
            return Item{I.w_ed + (size_t)(l * NX + e) * FE * D, D, WdT + (size_t)(l * NX + e) * D * FE, FE, 64 * kb, 64 * nb, 64 * nb}; };
        f32x4 va[16], vb[16];
        const Item i0 = item(0), i1 = item(1), i2 = item(2);
        transpose_load64(va, i0.W, i0.ldw, i0.k0, i0.n0src, lane_);
        transpose_load64(vb, i1.W, i1.ldw, i1.k0, i1.n0src, lane_);
        asm volatile("" ::: "memory"); __builtin_amdgcn_sched_barrier(0);
        transpose_finish64(va, i0.WT, i0.ldt, i0.k0, i0.dstrow0, scr, lane_);
        transpose_load64(va, i2.W, i2.ldw, i2.k0, i2.n0src, lane_);
        asm volatile("" ::: "memory"); __builtin_amdgcn_sched_barrier(0);
        transpose_finish64(vb, i1.WT, i1.ldt, i1.k0, i1.dstrow0, scr, lane_);
        transpose_finish64(va, i2.WT, i2.ldt, i2.k0, i2.dstrow0, scr, lane_);
        __syncthreads();
    }
};
template <bool WITH_CW>
__device__ __forceinline__ void moe_tables(Frame& F, pg8::MoeSched& S, int l, int npn, const char* W, size_t estride, size_t pnstride, const unsigned* LIST, const float* CW) {
    LAS unsigned* ent = (LAS unsigned*)(F.lds + ENT_OFF); LAS float* cwt = (LAS float*)(F.lds + CWT_OFF);
    LAS int* tstart = (LAS int*)(F.lds + TST_OFF); LAS int* cntl = tstart + 33; LAS int* ut = cntl + 32; LAS int* nun = ut + 4 * ENT_UNITS;
    unsigned* const pubp = (unsigned*)(CTLP + CW_TIL + l * TIL_STRIDE);
    if (F.wave == 0) {
        const int ln = F.lane; unsigned c = 0u;
        if (ln < 32) { c = __hip_atomic_load(CTLP + CW_CNT + 64 * (l * 32 + ln), RLX_AGENT); c = c < (unsigned)T ? c : (unsigned)T; }
        const int tl = (int)((c + 255u) >> 8); int inc = tl;
        inc += __builtin_amdgcn_update_dpp(0, inc, 0x111, 0xf, 0xf, true); inc += __builtin_amdgcn_update_dpp(0, inc, 0x112, 0xf, 0xf, true); inc += __builtin_amdgcn_update_dpp(0, inc, 0x114, 0xf, 0xf, true);
        inc += __builtin_amdgcn_update_dpp(0, inc, 0x118, 0xf, 0xf, true); inc += __builtin_amdgcn_update_dpp(0, inc, 0x142, 0xa, 0xf, true);
        if (ln < 32) { cntl[ln] = (int)c; tstart[ln] = inc - tl; }
        if (ln == 31) tstart[32] = inc;
        const int ntile = __builtin_amdgcn_readlane(inc, 31);
        int tix = -1;
        if (ln < ENT_UNITS) {
            const int i = ln, G = F.G, cc = F.vcu, total = ntile * npn; int L = i * G + cc;
            if (!WITH_CW) { const int nlate = (ntile * 2) % G, ne = G - nlate, hs = (ne >= G / 2) ? 4 : 0;
                if (hs) L = cc >= nlate ? (i < hs ? i * ne + (cc - nlate) : hs * ne + (i - hs) * G + cc) : hs * ne + i * G + cc; }
            int e = 0, pn = 0, nrows = 0;
            if (L < total) { tix = L / npn; pn = L - tix * npn;
#pragma unroll
                for (int sft = 16; sft >= 1; sft >>= 1) if (tstart[e + sft] <= tix) e += sft;
                const int left = cntl[e] - (tix - tstart[e]) * 256; nrows = left < 256 ? left : 256; }
            ut[4 * i] = e; ut[4 * i + 1] = pn; ut[4 * i + 2] = nrows; ut[4 * i + 3] = tix;
        }
        const int n = __builtin_popcountll(__ballot(tix >= 0));
        unsigned rdy = 0u;
        if (!WITH_CW) {
            unsigned pc = 0u;
            if (tix >= 0) pc = __hip_atomic_load(pubp + 64 * tix, __ATOMIC_RELAXED, __HIP_MEMORY_SCOPE_AGENT);
            rdy = (unsigned)__ballot(tix >= 0 && pc >= 16u);
            __builtin_amdgcn_fence(__ATOMIC_ACQUIRE, "agent"); asm volatile("s_waitcnt vmcnt(0)" ::: "memory");
        }
        if (ln == 0) { nun[0] = n; nun[1] = (int)rdy; }
    }
    __syncthreads();
    S.ut = ut; S.nunits = nun[0]; S.rdy = WITH_CW ? 0u : (unsigned)nun[1]; S.W = W; S.estride = estride; S.pnstride = pnstride;
    S.pub = pubp; S.tmo = (unsigned*)(CTLP + CW_TMO);
    {
        constexpr int NJ = WITH_CW ? 2 : 4;
        unsigned en[NJ]; float cw[NJ];
#pragma unroll
        for (int j = 0; j < NJ; ++j) { const int q = F.tid + NWAVES * 64 * j, i = q >> 8, r = q & 255, ii = i < S.nunits ? i : 0;
            const int e = ut[4 * ii], nrows = ut[4 * ii + 2], r0 = (ut[4 * ii + 3] - tstart[e]) * 256;
            en[j] = LIST[(size_t)e * T + r0 + (r < nrows ? r : 0)]; }
        if (WITH_CW) {
#pragma unroll
            for (int j = 0; j < NJ; ++j) cw[j] = CW[en[j]];
        }
#pragma unroll
        for (int j = 0; j < NJ; ++j) { const int q = F.tid + NWAVES * 64 * j;
            if ((q >> 8) < S.nunits) { ent[q] = en[j]; if (WITH_CW) { if (q < 3 * 256) cwt[q] = cw[j]; } } }
    }
    __syncthreads();
}
__global__ void __launch_bounds__(NWAVES * 64, 2) mk_fwd(Args args_unused) {
    extern __shared__ __attribute__((aligned(16))) unsigned char lds[];
    Frame F;
    F.lds = (LAS unsigned char*)lds;
    F.MISC = (volatile LAS unsigned*)(F.lds + MISC_OFF);
    F.tid = threadIdx.x; F.lane = F.tid & 63; F.wave = __builtin_amdgcn_readfirstlane(F.tid >> 6);
    F.G = gridDim.x; { const int bx = blockIdx.x; F.vcu = (F.G % 8 == 0) ? (bx % 8) * (F.G / 8) + bx / 8 : bx; }
    F.ctl = (gu32*)(KA()->ws + WS_CTL);
    for (int u = F.tid; u < (LDS_BYTES - LDSCTL_OFF) / 4; u += NWAVES * 64) ((LAS unsigned*)(F.lds + LDSCTL_OFF))[u] = 0u;
    __syncthreads();
    XcdBarrier bar; bar.bar = (unsigned*)(F.ctl + CW_BAR); bar.x = 0; bar.st = nullptr;
    if (!MK_PER_PHASE) bar = xcd_barrier_post((unsigned*)(F.ctl + CW_BAR), F.MISC + 8);
#define GRID_BAR() do { if (!MK_PER_PHASE) { XcdBarrier b_ = bar; unsigned* p_ = b_.bar; unsigned x_ = b_.x; asm volatile("" : "+s"(p_), "+s"(x_)); b_.bar = p_; b_.x = x_; xcd_barrier(b_); } } while (0)
    const int lo = KA()->ph_lo, hi = KA()->ph_hi;
#ifndef PHASE_MASK
#define PHASE_MASK 0xFFFF
#endif
#define IN(k) ((((PHASE_MASK) >> ((k) > 7 && (k) < 15 ? (k) - 7 : (k))) & 1) && lo <= (k) && (k) < hi)
#ifndef PROBE_MODE
#define PROBE_MODE 0
#endif
#ifndef REPEAT_MASK
#define REPEAT_MASK 0
#endif
#define RPT(k, cond) _Pragma("nounroll") for (int rp_ = 0, nr_ = ((((REPEAT_MASK) >> (k)) & 1) && (cond)) ? 2 : 1; rp_ < nr_; ++rp_)
#ifndef TIME_A
#define TIME_A -1
#endif
#ifndef TIME_B
#define TIME_B -1
#endif
    unsigned long long tA_ = 0, tB_ = 0;
    if (TIME_B >= 0 && TIME_A < 0) tA_ = __builtin_amdgcn_s_memrealtime();
#define SEAM(k) do { if (IN(k) && IN((k) + 1)) GRID_BAR(); if (TIME_B >= 0) { if ((k) == TIME_A) tA_ = __builtin_amdgcn_s_memrealtime(); if ((k) == TIME_B) tB_ = __builtin_amdgcn_s_memrealtime(); } } while (0)
#define PHASE_BEGIN() do { int w_ = F.wave, v_ = F.vcu, g_ = F.G; int ln_ = (int)__builtin_amdgcn_mbcnt_hi(~0u, __builtin_amdgcn_mbcnt_lo(~0u, 0u)); asm volatile("" : "+v"(ln_), "+v"(w_), "+v"(v_), "+v"(g_)); \
        F.wave = __builtin_amdgcn_readfirstlane(w_); F.vcu = __builtin_amdgcn_readfirstlane(v_); F.G = __builtin_amdgcn_readfirstlane(g_); F.lane = ln_; F.tid = F.wave * 64 + ln_; } while (0)
#ifndef EXTRA_BARS
#define EXTRA_BARS 0
#endif
    for (int xb_ = 0; xb_ < EXTRA_BARS; ++xb_) GRID_BAR();
#if PROBE_STEPS
    const unsigned long long pk0_ = __builtin_amdgcn_s_memrealtime();
#endif
    if (IN(0)) { PHASE_BEGIN(); RPT(0, true) { if (rp_) GRID_BAR(); const In I = *(const In*)(const void*)(&KA()->in); p0_prologue(F, I, WSP, 0); }
#if PROBE_STEPS
        if (((PROBE_STEPS >= 16 && PROBE_STEPS <= 18) || (PROBE_STEPS == 19 && F.vcu < 64) || (PROBE_STEPS == 22 && F.vcu >= 64 && F.vcu < 96) || (PROBE_STEPS == 25 && F.vcu >= 96)) && F.tid == 0) { const unsigned d_ = (unsigned)((__builtin_amdgcn_s_memrealtime() - pk0_) / 10ull);
            __hip_atomic_fetch_max((unsigned*)(CTLP + 8), d_, RLX_AGENT); __hip_atomic_fetch_add((unsigned*)(CTLP + 9), 2u * d_, RLX_AGENT); __hip_atomic_fetch_max((unsigned*)(CTLP + 10), 100000u - d_, RLX_AGENT); }
#endif
        SEAM(0); }

#pragma nounroll
    for (int l = 0; l < NL; ++l) {
        const int pb = 1 + 7 * l;
        if (IN(pb + 0)) { PHASE_BEGIN();
            const float* modl = MODP + (size_t)l * 8 * 6144;
            NormArgs A{}; A.gamma = KA()->in.g_mix + l * D; A.scale = modl + 1024; A.shift = modl; A.H = HB; A.frag = (const v4u*)(WSP + WS_FRF) + (size_t)l * 32 * 2 * 64;
            A.bias0 = KA()->in.b_fg + l * 8; A.FL = FCP; A.BT = FLP;
            A.xwb = XBB;
            if (l == 0) { A.xin = KA()->in.x; RPT(1, true) { if (rp_) GRID_BAR(); norm_phase<false, false, false, true, 1, false>(F, A); } }
            else { A.xinb = DLB; A.Y0 = YB; A.Y1 = YB + (size_t)T * D; A.gate = MODP + (size_t)(l - 1) * 8 * 6144 + 5120; RPT(5, true) { if (rp_) GRID_BAR(); norm_phase<true, false, true, true, 1, false>(F, A); } }
            SEAM(pb + 0);
        }
        if (IN(pb + 1)) { PHASE_BEGIN();
            pg8::Gemm g{HB, (const bf16*)(WSP + WS_WIN) + (size_t)l * 2048 * D, T, 2048, D}; pg8::StaticOrder S; S.init(T, 2048, F.G, (int)blockIdx.x);
            pg8::EpiQKVU E{QB_, 512, 512, (size_t)T * 512, attn_body::C2, (unsigned*)(CTLP + CW_NRM + l * NRM_WORDS)};
            RPT(2, true) { if (rp_) GRID_BAR(); pg8::gemm_phase<pg8::EpiQKVU, pg8::StaticOrder, true, true>(F.lds + RING_OFF, g, S, E); }
            SEAM(pb + 1);
        }
        if (IN(pb + 2)) { PHASE_BEGIN();
            PoolDiff PD{F, QB_ + (size_t)3 * T * 512, AOB}; PD.l = l;
#if PROBE_STEPS
            const unsigned long long pt0_ = __builtin_amdgcn_s_memrealtime();
#endif
            const attn_body::AttnBase AB{(const char*)WSP, WS_QKVU, WS_QKVU + (size_t)T * 512 * 2, WS_QKVU + (size_t)2 * T * 512 * 2, WS_AO, WS_FC, WS_FL, WS_CTL + (size_t)(CW_NRM + l * NRM_WORDS) * 4, WS_CTL + (size_t)(CW_QAT + 64 * (l * 8)) * 4, WS_CTL + (size_t)(CW_PQ + 64 * l) * 4};
            attn_body::attn_phase<32>((char*)lds + RING_OFF, AB, F.vcu, F.tid, PD);
#if PROBE_STEPS
            if (PROBE_STEPS >= 4 && PROBE_STEPS <= 6) PD.steps = (int)((__builtin_amdgcn_s_memrealtime() - pt0_) / 100ull);
            if (PROBE_STEPS < 10 && F.tid == 0) { __hip_atomic_fetch_max((unsigned*)(CTLP + 8), (unsigned)PD.steps, RLX_AGENT); __hip_atomic_fetch_add((unsigned*)(CTLP + 9), (unsigned)PD.steps, RLX_AGENT); __hip_atomic_fetch_max((unsigned*)(CTLP + 10), (unsigned)(100000 - PD.steps), RLX_AGENT); }
#endif
            SEAM(pb + 2);
        }
        if (IN(pb + 3)) { PHASE_BEGIN();
            pg8::Gemm g{AOB, (const bf16*)(WSP + WS_WOUT) + (size_t)l * D * D, T, D, D}; pg8::StaticOrder S; S.init(T, D, F.G, (int)blockIdx.x);
            pg8::EpiMid E{DLB, XBB, MODP + (size_t)l * 8 * 6144 + 2048, 6144};
            RPT(4, true) { if (rp_) GRID_BAR(); pg8::gemm_phase<pg8::EpiMid, pg8::StaticOrder, true, true>(F.lds + RING_OFF, g, S, E); }
            SEAM(pb + 3);
        }
        if (IN(pb + 4)) { PHASE_BEGIN();
            const float* modl = MODP + (size_t)l * 8 * 6144;
            NormArgs A{}; A.xinb = DLB; A.gamma = KA()->in.g_ffn + l * D; A.scale = modl + 4096; A.shift = modl + 3072; A.H = HB;
            A.frag = (const v4u*)(WSP + WS_RRF) + (size_t)l * 32 * 3 * 2 * 64; A.bias0 = KA()->in.b_rg + l * 4; A.bias1 = KA()->in.b_re + l * 32; A.CW = CWP; A.LIST = LISTP; A.cnt = CTLP + CW_CNT + 64 * (l * 32);
            norm_phase<true, false, false, false, 3, false>(F, A);
            SEAM(pb + 4);
        }
#if PROBE_STEPS
        unsigned long long mt0_ = 0ull;
#endif
        if (IN(pb + 5)) { PHASE_BEGIN();
#if PROBE_STEPS
            mt0_ = __builtin_amdgcn_s_memrealtime();
#endif
            pg8::MoeSched S; moe_tables<true>(F, S, l, 2, (const char*)(WSP + WS_WGU) + (size_t)l * NX * 512 * D * 2, (size_t)512 * D * 2, (size_t)256 * D * 2, LISTP, CWP);
            LAS unsigned* ent = (LAS unsigned*)(F.lds + ENT_OFF); LAS float* cwt = (LAS float*)(F.lds + CWT_OFF);
            pg8::EpiAct E{ACTB, ent, cwt}; RPT(6, true) { if (rp_) GRID_BAR(); pg8::gemm_phase_moe<1, true, false, pg8::EpiAct, pg8::MoeSched>(F.lds + RING_OFF, HB, D, ent, S, E); }
#if PROBE_STEPS
            if (PROBE_STEPS == 13 && F.tid == 0) __hip_atomic_fetch_add((unsigned*)(CTLP + 9), (unsigned)((__builtin_amdgcn_s_memrealtime() - mt0_) / 100ull), RLX_AGENT);
#endif
        }
        if (IN(pb + 6)) { PHASE_BEGIN();
            pg8::MoeSched S; moe_tables<false>(F, S, l, 4, (const char*)(WSP + WS_WD) + (size_t)l * NX * D * FE * 2, (size_t)D * FE * 2, (size_t)256 * FE * 2, LISTP, CWP);
            LAS unsigned* ent = (LAS unsigned*)(F.lds + ENT_OFF);
            pg8::EpiY E{YB, (size_t)T * D, ent}; RPT(7, true) { if (rp_) GRID_BAR(); pg8::gemm_phase_moe<0, false, true, pg8::EpiY, pg8::MoeSched>(F.lds + RING_OFF, ACTB, FE, ent, S, E); }
#if PROBE_STEPS
            if (PROBE_STEPS >= 10 && PROBE_STEPS <= 12 && F.tid == 0) { const unsigned d_ = (unsigned)((__builtin_amdgcn_s_memrealtime() - mt0_) / 100ull);
                __hip_atomic_fetch_max((unsigned*)(CTLP + 8), d_, RLX_AGENT); __hip_atomic_fetch_add((unsigned*)(CTLP + 9), d_, RLX_AGENT); __hip_atomic_fetch_max((unsigned*)(CTLP + 10), 100000u - d_, RLX_AGENT); }
#endif
            SEAM(pb + 6);
        }
    }
    if (IN(NPH - 1)) { PHASE_BEGIN();
        NormArgs A{}; A.xinb = DLB; A.out = XRES; A.Y0 = YB; A.Y1 = YB + (size_t)T * D; A.gate = MODP + (size_t)(NL - 1) * 8 * 6144 + 5120; A.gamma = KA()->in.g_fin;
        norm_phase<true, false, true, false, 0, true>(F, A);
    }
#if PROBE_STEPS
    __syncthreads();
    if (F.vcu == 0 && F.tid == 0) { const unsigned mx = __hip_atomic_load((unsigned*)(CTLP + 8), RLX_AGENT), sm = __hip_atomic_load((unsigned*)(CTLP + 9), RLX_AGENT), mn = __hip_atomic_load((unsigned*)(CTLP + 10), RLX_AGENT);
        const float v = (PROBE_STEPS == 1 || PROBE_STEPS == 4 || PROBE_STEPS == 10 || PROBE_STEPS == 16 || PROBE_STEPS == 19 || PROBE_STEPS == 22 || PROBE_STEPS == 25) ? (float)mx : (PROBE_STEPS == 2 || PROBE_STEPS == 5 || PROBE_STEPS == 7 || PROBE_STEPS == 8 || PROBE_STEPS == 11 || PROBE_STEPS == 13 || PROBE_STEPS == 17) ? (float)sm * (1.0f / 512.0f) : (float)(100000u - mn); XRES[0] = 1000.f * (float)(((int)(v + 0.5f) + PROBE_BASE) / PROBE_Q * PROBE_Q); }
#endif
    if (TIME_B >= 0) {
        if (TIME_B >= NPH - 1) tB_ = __builtin_amdgcn_s_memrealtime();
        __syncthreads();
#ifndef TIME_Q
#define TIME_Q 10
#endif
#ifndef TIME_OFF
#define TIME_OFF 0
#endif
        const long long us_q = (long long)((((tB_ - tA_) / 100ull + TIME_OFF) / TIME_Q) * TIME_Q);
        const long long n = us_q * 1000ll - (long long)F.vcu * 131072ll; const int cnt = n < 0 ? 0 : (n > 131072 ? 131072 : (int)n);
        float* o = XRES + (size_t)F.vcu * 131072;
        for (int i = F.tid; i < cnt; i += NWAVES * 64) o[i] = 0.f;
    }
#undef IN
#undef SEAM
#undef GRID_BAR
}

extern "C" void kernel_launch(void* const* d_in, const int* in_sizes, int n_in, void* d_out, int out_size, void* d_ws, size_t ws_size, hipStream_t stream) {
    static int grid = 0;
    if (grid == 0) {
        if (n_in != 19 || in_sizes[0] != T * D || out_size != T * D || ws_size < WS_END) { fprintf(stderr, "kernel_launch: shape/workspace mismatch: n_in %d in0 %d out %d ws %zu (need %zu); nothing launched\n", n_in, n_in > 0 ? in_sizes[0] : -1, out_size, ws_size, (size_t)WS_END); grid = -1; return; }
        int dev = 0, cus = 0, per_cu = 0;
        if (hipGetDevice(&dev) != hipSuccess || hipDeviceGetAttribute(&cus, hipDeviceAttributeMultiprocessorCount, dev) != hipSuccess) { fprintf(stderr, "kernel_launch: device query failed\n"); grid = -1; return; }
        if (hipFuncSetAttribute((const void*)mk_fwd, hipFuncAttributeMaxDynamicSharedMemorySize, LDS_BYTES) != hipSuccess) { fprintf(stderr, "kernel_launch: hipFuncSetAttribute failed\n"); grid = -1; return; }
        if (hipOccupancyMaxActiveBlocksPerMultiprocessor(&per_cu, (const void*)mk_fwd, NWAVES * 64, LDS_BYTES) != hipSuccess || per_cu < 1) fprintf(stderr, "kernel_launch: note: occupancy query reports %d workgroups per CU\n", per_cu);
        (void)hipGetLastError();
        grid = cus;
        if (grid != 256) { fprintf(stderr, "kernel_launch: built for 256 CUs, device has %d; nothing launched\n", cus); grid = -1; return; }
    }
    if (grid < 0) return;
    if (hipMemsetAsync((char*)d_ws + WS_CTL, 0, CTL_ZERO_BYTES, stream) != hipSuccess) { fprintf(stderr, "kernel_launch: hipMemsetAsync failed\n"); return; }
    Args a{};
    const float** ip = (const float**)&a.in;
    for (int i = 0; i < 19; ++i) ip[i] = (const float*)d_in[i];
    a.out = (float*)d_out; a.ws = (unsigned char*)d_ws;
#if MK_PER_PHASE
    for (int p = 0; p < NPH; ++p) { a.ph_lo = p; a.ph_hi = p + 1; hipLaunchKernelGGL(mk_fwd, dim3(grid), dim3(NWAVES * 64), LDS_BYTES, stream, a); }
#else
    a.ph_lo = 0; a.ph_hi = NPH; hipLaunchKernelGGL(mk_fwd, dim3(grid), dim3(NWAVES * 64), LDS_BYTES, stream, a);
#endif
    const hipError_t le = hipPeekAtLastError();
    if (le != hipSuccess) fprintf(stderr, "kernel_launch: launch failed: %s\n", hipGetErrorName(le));
}
```

```cpp
#ifndef PROBE_STEPS
#define PROBE_STEPS 0
#endif
#ifndef PROBE_BASE
#define PROBE_BASE 0
#endif
#ifndef PROBE_Q
#define PROBE_Q 10
#endif
#include <hip/hip_runtime.h>
#include <hip/hip_bf16.h>
#include <cstdio>
#include <cstdint>
#include <cmath>

namespace pg8 {
#define PG8_LAS __attribute__((address_space(3)))
typedef unsigned short bf16_t;
typedef short bf16x8 __attribute__((ext_vector_type(8)));
typedef float f32x4 __attribute__((ext_vector_type(4)));
typedef unsigned u32x4 __attribute__((ext_vector_type(4)));
constexpr int BM = 256, BK = 64, HALF = 128, HTB = HALF * BK * 2  , STAGE_BYTES = 8 * HTB, NXCD = 8, WGM = 8;

__host__ __device__ __forceinline__ int lds_byte(int r, int c) { const int st = (r >> 4) * 2 + (c >> 5), rr = r & 15, cc = c & 31, ob = rr * 64 + cc * 2; return st * 1024 + (ob ^ (((ob >> 9) & 1) << 5)); }
__host__ __device__ __forceinline__ void stage_rc(int b, int& R, int& C) { const int st = b / 1024, sb = b % 1024, swz = sb ^ (((sb >> 9) & 1) << 5); R = (st >> 1) * 16 + swz / 64; C = (st & 1) * 32 + (swz % 64) / 2; }
__host__ __device__ __forceinline__ int perm32(int rho) { const int n = rho >> 4, i = rho & 15; return 8 * (i >> 2) + 4 * n + (i & 3); }

struct Unit { int pm, pn; };
struct Gemm { const bf16_t* A; const bf16_t* Bt; int M, N, K; };

struct StaticOrder {
    int nM, nN, nwg, G, c;
    __host__ __device__ void init(int M, int N, int G_, int c_) { nM = M / BM; nN = N / BM; nwg = nM * nN; G = G_; c = c_; }
    __host__ __device__ bool next(int i, Unit& u) const {
        const long L = (long)i * G + c; if (L >= nwg) return false;
        int wgid = (int)L; { const int q = nwg / NXCD, r = nwg % NXCD, xcd = wgid % NXCD, off = wgid / NXCD; wgid = (xcd < r ? xcd * (q + 1) : r * (q + 1) + (xcd - r) * q) + off; }
        const int nig = WGM * nN, gid = wgid / nig, fm = gid * WGM, gsz = (nM - fm) < WGM ? (nM - fm) : WGM;
        u.pm = fm + ((wgid % nig) % gsz); u.pn = (wgid % nig) / gsz; return true;
    }
    __device__ __forceinline__ void a_ready(const Unit&) const {}
    __device__ __forceinline__ void done(const Unit&) const {}
};

__device__ __forceinline__ unsigned cvt_pk_bf16(float lo, float hi) { unsigned r; asm volatile("v_cvt_pk_bf16_f32 %0, %1, %2" : "=v"(r) : "v"(lo), "v"(hi)); return r; }
typedef float f32x2 __attribute__((ext_vector_type(2)));

__device__ __forceinline__ float lane_read(float v, int src_lane) { return __builtin_bit_cast(float, __builtin_amdgcn_ds_bpermute(src_lane << 2, __builtin_bit_cast(int, v))); }
#ifndef MK_WT_STORES
#define MK_WT_STORES 0
#endif
#if MK_WT_STORES
#define STORE16_WT(p, v) asm volatile("global_store_dwordx4 %0, %1, off sc1\n\ts_nop 1" :: "v"(p), "v"(v) : "memory")
#else
#define STORE16_WT(p, v) (*(u32x4*)(p) = (v))
#endif
struct EpiQKVU {
    static constexpr bool PERM = true, AFTER_DRAIN = false;
    bf16_t* O; int ldc; int split_cols; size_t split_stride; float scale0;
    unsigned* nrm;
    __device__ __forceinline__ void operator()(const f32x4 (&acc)[2][2][4][2], const Unit& u, int wr, int wc, int fr, int fq) const {
        const int row0 = u.pm * BM + wr * 64 + fr; int colt = u.pn * BM; bf16_t* base = O;
        const int t = colt / split_cols; float sc = 1.f; { base += (size_t)t * split_stride; colt -= t * split_cols; if (t == 0) sc = scale0; }
        const int col0 = colt + wc * 32 + 8 * fq;
        if (t < 2) {
            const int b = (u.pm * BM) >> 12, tile0 = ((u.pm * BM) & 4095) >> 6;
#pragma unroll
            for (int ai = 0; ai < 2; ++ai)
#pragma unroll
                for (int bj = 0; bj < 2; ++bj) { float mx = 0.f;
#pragma unroll
                    for (int m = 0; m < 4; ++m) { const f32x4 v0 = acc[ai][bj][m][0] * sc, v1 = acc[ai][bj][m][1] * sc;
                        float ssq = (v0[0] * v0[0] + v0[1] * v0[1]) + (v0[2] * v0[2] + v0[3] * v0[3]) + (v1[0] * v1[0] + v1[1] * v1[1]) + (v1[2] * v1[2] + v1[3] * v1[3]);
                        { auto r16_ = __builtin_amdgcn_permlane16_swap(__float_as_uint(ssq), __float_as_uint(ssq), false, false); ssq = __uint_as_float(r16_[0]) + __uint_as_float(r16_[1]);
                          auto r32_ = __builtin_amdgcn_permlane32_swap(__float_as_uint(ssq), __float_as_uint(ssq), false, false); ssq = __uint_as_float(r32_[0]) + __uint_as_float(r32_[1]); }
                        mx = fmaxf(mx, ssq); }
#define PG8_DPPF(V, CTRL) __builtin_bit_cast(float, __builtin_amdgcn_update_dpp(0, __builtin_bit_cast(int, V), CTRL, 0xf, 0xf, false))
                    mx = fmaxf(mx, PG8_DPPF(mx, 0xB1)); mx = fmaxf(mx, PG8_DPPF(mx, 0x4E)); mx = fmaxf(mx, PG8_DPPF(mx, 0x141)); mx = fmaxf(mx, PG8_DPPF(mx, 0x140));
#undef PG8_DPPF
                    if (fr == 0 && fq == 0) { const int head = (colt >> 6) + 2 * bj + (wc >> 1);
                        nrm[((size_t)((t * 64 + b * 8 + head) * 64 + tile0 + 2 * ai + wr)) * 2 + (wc & 1)] = __float_as_uint(mx); } }
        }
#pragma unroll
        for (int ai = 0; ai < 2; ++ai)
#pragma unroll
            for (int m = 0; m < 4; ++m) { bf16_t* rowp = base + (size_t)(row0 + ai * HALF + m * 16) * ldc + col0;
#pragma unroll
                for (int bj = 0; bj < 2; ++bj) { const f32x4 v0 = acc[ai][bj][m][0] * sc, v1 = acc[ai][bj][m][1] * sc;
                    u32x4 w; w.x = cvt_pk_bf16(v0[0], v0[1]); w.y = cvt_pk_bf16(v0[2], v0[3]); w.z = cvt_pk_bf16(v1[0], v1[1]); w.w = cvt_pk_bf16(v1[2], v1[3]);
                    STORE16_WT(rowp + bj * HALF, w); } }
    }
};
struct EpiDelta {
    static constexpr bool PERM = true, AFTER_DRAIN = false;
    bf16_t* O; const float* gate; int gstride;
    __device__ __forceinline__ void operator()(const f32x4 (&acc)[2][2][4][2], const Unit& u, int wr, int wc, int fr, int fq) const {
        const int row0 = u.pm * BM + wr * 64 + fr, col0 = u.pn * BM + wc * 32 + 8 * fq; const int b = (u.pm * BM) >> 12;
        f32x4 gv[2][2];
#pragma unroll
        for (int bj = 0; bj < 2; ++bj)
#pragma unroll
            for (int n = 0; n < 2; ++n) gv[bj][n] = *(const f32x4*)(gate + (size_t)b * gstride + col0 + bj * HALF + 4 * n);
#pragma unroll
        for (int ai = 0; ai < 2; ++ai)
#pragma unroll
            for (int m = 0; m < 4; ++m) { bf16_t* rowp = O + (size_t)(row0 + ai * HALF + m * 16) * 1024 + col0;
#pragma unroll
                for (int bj = 0; bj < 2; ++bj) { const f32x4 v0 = acc[ai][bj][m][0] * gv[bj][0], v1 = acc[ai][bj][m][1] * gv[bj][1];
                    u32x4 w; w.x = cvt_pk_bf16(v0[0], v0[1]); w.y = cvt_pk_bf16(v0[2], v0[3]); w.z = cvt_pk_bf16(v1[0], v1[1]); w.w = cvt_pk_bf16(v1[2], v1[3]);
                    STORE16_WT(rowp + bj * HALF, w); } }
    }
};
struct EpiMid {
    static constexpr bool PERM = true, AFTER_DRAIN = false;
    bf16_t* O; const bf16_t* X; const float* gate; int gstride;
    __device__ __forceinline__ void operator()(const f32x4 (&acc)[2][2][4][2], const Unit& u, int wr, int wc, int fr, int fq) const {
        const int row0 = u.pm * BM + wr * 64 + fr, col0 = u.pn * BM + wc * 32 + 8 * fq; const int b = (u.pm * BM) >> 12;
        u32x4 xr[2][4][2];
#pragma unroll
        for (int ai = 0; ai < 2; ++ai)
#pragma unroll
            for (int m = 0; m < 4; ++m)
#pragma unroll
                for (int bj = 0; bj < 2; ++bj) xr[ai][m][bj] = *(const u32x4*)(X + (size_t)(row0 + ai * HALF + m * 16) * 1024 + col0 + bj * HALF);
        f32x4 gv[2][2];
#pragma unroll
        for (int bj = 0; bj < 2; ++bj)
#pragma unroll
            for (int n = 0; n < 2; ++n) gv[bj][n] = *(const f32x4*)(gate + (size_t)b * gstride + col0 + bj * HALF + 4 * n);
        asm volatile("" ::: "memory"); __builtin_amdgcn_sched_barrier(0);
#pragma unroll
        for (int ai = 0; ai < 2; ++ai)
#pragma unroll
            for (int m = 0; m < 4; ++m) { bf16_t* rowp = O + (size_t)(row0 + ai * HALF + m * 16) * 1024 + col0;
#pragma unroll
                for (int bj = 0; bj < 2; ++bj) { const u32x4 xv = xr[ai][m][bj];
                    const f32x4 x0 = {__uint_as_float(xv.x << 16), __uint_as_float(xv.x & 0xffff0000u), __uint_as_float(xv.y << 16), __uint_as_float(xv.y & 0xffff0000u)};
                    const f32x4 x1 = {__uint_as_float(xv.z << 16), __uint_as_float(xv.z & 0xffff0000u), __uint_as_float(xv.w << 16), __uint_as_float(xv.w & 0xffff0000u)};
                    const f32x4 v0 = x0 + acc[ai][bj][m][0] * gv[bj][0], v1 = x1 + acc[ai][bj][m][1] * gv[bj][1];
                    u32x4 w; w.x = cvt_pk_bf16(v0[0], v0[1]); w.y = cvt_pk_bf16(v0[2], v0[3]); w.z = cvt_pk_bf16(v1[0], v1[1]); w.w = cvt_pk_bf16(v1[2], v1[3]);
                    STORE16_WT(rowp + bj * HALF, w); } }
    }
};
struct EpiResGate {
    static constexpr bool PERM = false, AFTER_DRAIN = false;
    const float* base; float* out; const float* gate; int gstride;
    __device__ __forceinline__ void operator()(const f32x4 (&acc)[2][2][4][2], const Unit& u, int wr, int wc, int fr, int fq) const {
        const int row0 = u.pm * BM + wr * 64 + fr, col0 = u.pn * BM + wc * 32 + 4 * fq; const int b = (u.pm * BM) >> 12;
        f32x4 gv[2][2];
#pragma unroll
        for (int bj = 0; bj < 2; ++bj)
#pragma unroll
            for (int n = 0; n < 2; ++n) gv[bj][n] = *(const f32x4*)(gate + (size_t)b * gstride + col0 + bj * HALF + n * 16);
#pragma unroll
        for (int ai = 0; ai < 2; ++ai) {
            f32x4 bs[4][2][2];
#pragma unroll
            for (int m = 0; m < 4; ++m) { const size_t off = (size_t)(row0 + ai * HALF + m * 16) * 1024 + col0;
#pragma unroll
                for (int bj = 0; bj < 2; ++bj)
#pragma unroll
                    for (int n = 0; n < 2; ++n) bs[m][bj][n] = *(const f32x4*)(base + off + bj * HALF + n * 16); }
            asm volatile("" ::: "memory");
#pragma unroll
            for (int m = 0; m < 4; ++m) { const size_t off = (size_t)(row0 + ai * HALF + m * 16) * 1024 + col0;
#pragma unroll
                for (int bj = 0; bj < 2; ++bj)
#pragma unroll
                    for (int n = 0; n < 2; ++n) *(f32x4*)(out + off + bj * HALF + n * 16) = bs[m][bj][n] + gv[bj][n] * acc[ai][bj][m][n]; }
            asm volatile("" ::: "memory");
        }
    }
};

template <class Epi, class Sched, bool ALIGN_EPI = false, bool SP2 = false>
__device__ __forceinline__ void gemm_phase(PG8_LAS unsigned char* lds, const Gemm g, const Sched& S, const Epi& E) {
    int tid_ = threadIdx.x; asm volatile("" : "+v"(tid_));
    const int tid = tid_, wid = __builtin_amdgcn_readfirstlane(tid >> 6), lane = tid & 63, wr = wid >> 2, wc = wid & 3, fr = lane & 15, fq = lane >> 4;
    const int K = g.K, nt = K / BK;
    unsigned voffA[2], voffB[2];
#pragma unroll
    for (int i = 0; i < 2; ++i) { int R, C; stage_rc(tid * 16 + i * 8192, R, C); const int Rb = Epi::PERM ? ((R & ~31) + perm32(R & 31)) : R;
        voffA[i] = (unsigned)(R * K + C) * 2u; voffB[i] = (unsigned)(Rb * K + C) * 2u; }
    const size_t kstep = (size_t)(BK * 2);
    const size_t hstep = (size_t)HALF * K * 2;
    const size_t tstep = 2 * hstep;
    const unsigned ldsw = (unsigned)wid * 1024u;
    const int aoff = lds_byte(wr * 64 + fr, fq * 8), boff = lds_byte(wc * 32 + fr, fq * 8);
#define PG8_SA(b, h) (((b) * 2 + (h)) * HTB)
#define PG8_SB(b, h) ((4 + (b) * 2 + (h)) * HTB)
#define PG8_STAGE(bufoff, gbase, voff) do { _Pragma("unroll") for (int _i = 0; _i < 2; ++_i) \
        __builtin_amdgcn_global_load_lds((const unsigned*)((const char*)(gbase) + (voff)[_i]), (PG8_LAS unsigned*)(lds + (bufoff) + ldsw + _i * 8192), 16, 0, 0); } while (0)
#define PG8_LDA(dst, b, h) do { _Pragma("unroll") for (int m = 0; m < 4; ++m) _Pragma("unroll") for (int k = 0; k < 2; ++k) dst[m][k] = *(const PG8_LAS bf16x8*)(lds + PG8_SA(b, h) + aoff + m * 2048 + k * 1024); } while (0)
#define PG8_LDB(dst, b, h) do { _Pragma("unroll") for (int n = 0; n < 2; ++n) _Pragma("unroll") for (int k = 0; k < 2; ++k) dst[n][k] = *(const PG8_LAS bf16x8*)(lds + PG8_SB(b, h) + boff + n * 2048 + k * 1024); } while (0)
#define PG8_MMA(ai, bj, At, Bt) do { __builtin_amdgcn_s_setprio(1); _Pragma("unroll") for (int m = 0; m < 4; ++m) _Pragma("unroll") for (int n = 0; n < 2; ++n) _Pragma("unroll") for (int k = 0; k < 2; ++k) \
        acc[ai][bj][m][n] = __builtin_amdgcn_mfma_f32_16x16x32_bf16(Bt[n][k], At[m][k], acc[ai][bj][m][n], 0, 0, 0); __builtin_amdgcn_s_setprio(0); } while (0)
#define PG8_WAIT_V(n) asm volatile("s_waitcnt vmcnt(" #n ")" ::: "memory")
#define PG8_WAIT_L(n) asm volatile("s_waitcnt lgkmcnt(" #n ")" ::: "memory")
#define PG8_BAR __builtin_amdgcn_s_barrier()
#define PG8_SCHED __builtin_amdgcn_sched_barrier(0)
    Unit cur, nxt; int ui = 0;
    if (!S.next(0, cur)) return;
    f32x4 acc[2][2][4][2];
#pragma unroll
    for (int a = 0; a < 2; ++a)
#pragma unroll
        for (int b = 0; b < 2; ++b)
#pragma unroll
            for (int m = 0; m < 4; ++m)
#pragma unroll
                for (int n = 0; n < 2; ++n) acc[a][b][m][n] = (f32x4){0.f, 0.f, 0.f, 0.f};
    bf16x8 At[4][2], B0[2][2], B1[2][2];
    const char* cA = (const char*)g.A + (size_t)cur.pm * tstep; const char* cB = (const char*)g.Bt + (size_t)cur.pn * tstep;
    S.a_ready(cur);
    if constexpr (SP2) {
        PG8_STAGE(PG8_SB(0, 0), cB, voffB); PG8_STAGE(PG8_SB(0, 1), cB + hstep, voffB); PG8_STAGE(PG8_SA(0, 0), cA, voffA); PG8_STAGE(PG8_SA(0, 1), cA + hstep, voffA);
        if (wr == 1) PG8_BAR;
        PG8_WAIT_V(2); PG8_BAR;
        PG8_STAGE(PG8_SB(1, 0), cB + kstep, voffB); PG8_STAGE(PG8_SA(1, 0), cA + kstep, voffA); PG8_STAGE(PG8_SB(1, 1), cB + hstep + kstep, voffB);
        PG8_WAIT_V(6); PG8_BAR;
    } else {
        PG8_STAGE(PG8_SB(0, 0), cB, voffB); PG8_STAGE(PG8_SA(0, 0), cA, voffA); PG8_STAGE(PG8_SB(0, 1), cB + hstep, voffB); PG8_STAGE(PG8_SA(0, 1), cA + hstep, voffA);
        if (wr == 1) PG8_BAR;
        PG8_WAIT_V(4); PG8_BAR;
        PG8_STAGE(PG8_SB(1, 0), cB + kstep, voffB); PG8_STAGE(PG8_SA(1, 0), cA + kstep, voffA); PG8_STAGE(PG8_SB(1, 1), cB + hstep + kstep, voffB);
        PG8_WAIT_V(6); PG8_BAR;
    }
    for (;;) {
        const bool has_next = S.next(ui + 1, nxt);
        const char* nA = has_next ? (const char*)g.A + (size_t)nxt.pm * tstep : cA; const char* nB = has_next ? (const char*)g.Bt + (size_t)nxt.pn * tstep : cB;
        for (int t = 0; t < nt; t += 2) {
            const bool last = (t == nt - 2);
            const char* a1 = cA + (size_t)(t + 1) * kstep;
            const char* a2 = last ? nA : cA + (size_t)(t + 2) * kstep; const char* b2 = last ? nB : cB + (size_t)(t + 2) * kstep;
            const char* a3 = a2 + kstep; const char* b3 = b2 + kstep;
            if (last && has_next) S.a_ready(nxt);
            if constexpr (SP2) {
            PG8_LDB(B0, 0, 0); PG8_LDB(B1, 0, 1); PG8_SCHED; PG8_LDA(At, 0, 0); PG8_STAGE(PG8_SA(1, 1), a1 + hstep, voffA);
            PG8_WAIT_V(8); PG8_WAIT_L(0); PG8_BAR; PG8_MMA(0, 0, At, B0); PG8_MMA(0, 1, At, B1); PG8_BAR; PG8_SCHED;
            PG8_LDA(At, 0, 1); PG8_STAGE(PG8_SB(0, 0), b2, voffB); PG8_STAGE(PG8_SB(0, 1), b2 + hstep, voffB); PG8_STAGE(PG8_SA(0, 0), a2, voffA);
            PG8_WAIT_V(8); PG8_WAIT_L(0); PG8_BAR; PG8_MMA(1, 0, At, B0); PG8_MMA(1, 1, At, B1); PG8_BAR; PG8_SCHED;
            PG8_LDB(B0, 1, 0); PG8_LDB(B1, 1, 1); PG8_SCHED; PG8_LDA(At, 1, 0); PG8_STAGE(PG8_SA(0, 1), a2 + hstep, voffA);
            PG8_WAIT_V(8); PG8_WAIT_L(0); PG8_BAR; PG8_MMA(0, 0, At, B0); PG8_MMA(0, 1, At, B1); PG8_BAR; PG8_SCHED;
            PG8_LDA(At, 1, 1); PG8_STAGE(PG8_SB(1, 0), b3, voffB); PG8_STAGE(PG8_SB(1, 1), b3 + hstep, voffB); PG8_STAGE(PG8_SA(1, 0), a3, voffA);
            PG8_WAIT_V(8); PG8_WAIT_L(0); PG8_BAR; PG8_MMA(1, 0, At, B0); PG8_MMA(1, 1, At, B1); PG8_BAR; PG8_SCHED;
            } else {
            PG8_LDB(B0, 0, 0); PG8_SCHED; PG8_LDA(At, 0, 0); PG8_STAGE(PG8_SA(1, 1), a1 + hstep, voffA);
            PG8_WAIT_L(8); PG8_BAR; PG8_WAIT_L(0); PG8_MMA(0, 0, At, B0); PG8_BAR; PG8_SCHED;
            PG8_LDB(B1, 0, 1); PG8_STAGE(PG8_SB(0, 0), b2, voffB);
            PG8_BAR; PG8_WAIT_L(0); PG8_MMA(0, 1, At, B1); PG8_BAR;
            PG8_LDA(At, 0, 1); PG8_STAGE(PG8_SA(0, 0), a2, voffA);
            PG8_BAR; PG8_WAIT_L(0); PG8_MMA(1, 0, At, B0); PG8_BAR; PG8_SCHED;
            PG8_STAGE(PG8_SB(0, 1), b2 + hstep, voffB);
            PG8_WAIT_V(6); PG8_BAR; PG8_MMA(1, 1, At, B1); PG8_BAR;
            PG8_LDB(B0, 1, 0); PG8_SCHED; PG8_LDA(At, 1, 0); PG8_STAGE(PG8_SA(0, 1), a2 + hstep, voffA);
            PG8_WAIT_L(8); PG8_BAR; PG8_WAIT_L(0); PG8_MMA(0, 0, At, B0); PG8_BAR; PG8_SCHED;
            PG8_LDB(B1, 1, 1); PG8_STAGE(PG8_SB(1, 0), b3, voffB);
            PG8_BAR; PG8_WAIT_L(0); PG8_MMA(0, 1, At, B1); PG8_BAR;
            PG8_LDA(At, 1, 1); PG8_STAGE(PG8_SA(1, 0), a3, voffA);
            PG8_BAR; PG8_WAIT_L(0); PG8_MMA(1, 0, At, B0); PG8_BAR; PG8_SCHED;
            PG8_STAGE(PG8_SB(1, 1), b3 + hstep, voffB);
            PG8_WAIT_V(6); PG8_BAR; PG8_MMA(1, 1, At, B1); PG8_BAR;
            }
        }
        if constexpr (ALIGN_EPI) { if (wr == 0) PG8_BAR; }
        if constexpr (!Epi::AFTER_DRAIN) { E(acc, cur, wr, wc, fr, fq); S.done(cur); }
        if (!has_next) break;
#pragma unroll
        for (int a = 0; a < 2; ++a)
#pragma unroll
            for (int b = 0; b < 2; ++b)
#pragma unroll
                for (int m = 0; m < 4; ++m)
#pragma unroll
                    for (int n = 0; n < 2; ++n) acc[a][b][m][n] = (f32x4){0.f, 0.f, 0.f, 0.f};
        cur = nxt; cA = nA; cB = nB; ++ui;
        if constexpr (ALIGN_EPI) { if (wr == 1) PG8_BAR; }
    }
    PG8_WAIT_V(0);
    if constexpr (!ALIGN_EPI) { if (wr == 0) PG8_BAR; }
    PG8_BAR;
    if constexpr (Epi::AFTER_DRAIN) { E.fused(acc, cur, wr, wc, fr, fq, lds, wid, lane); S.done(cur); }
#undef PG8_SA
#undef PG8_SB
#undef PG8_STAGE
#undef PG8_LDA
#undef PG8_LDB
#undef PG8_MMA
#undef PG8_WAIT_V
#undef PG8_WAIT_L
#undef PG8_BAR
#undef PG8_SCHED
}

struct MUnit { int slot, e, pn, nrows, tile; };
struct MoeSched {
    PG8_LAS const int* ut; int nunits;
    const char* W; size_t estride, pnstride;
    unsigned rdy;
    unsigned* pub; unsigned* tmo;
    __device__ __forceinline__ bool next(int i, MUnit& u) const {
        if (i >= nunits) return false;
        u.slot = i; u.e = ut[4 * i]; u.pn = ut[4 * i + 1]; u.nrows = ut[4 * i + 2]; u.tile = ut[4 * i + 3]; return true; }
    __device__ __forceinline__ const char* b_base(const MUnit& u) const { return W + (size_t)u.e * estride + (size_t)u.pn * pnstride; }
    __device__ __forceinline__ void publish(int tile, int lane) const { if (lane == 0) __hip_atomic_fetch_add(pub + 64 * tile, 1u, __ATOMIC_RELAXED, __HIP_MEMORY_SCOPE_AGENT); }
    __device__ __forceinline__ void a_ready(const MUnit& u, int wid, int lane) const {
        if ((rdy >> u.slot) & 1u) return;
        if (wid == 0) {
            unsigned polls = 0;
            while ((unsigned)__builtin_amdgcn_readfirstlane(__hip_atomic_load(pub + 64 * u.tile, __ATOMIC_RELAXED, __HIP_MEMORY_SCOPE_AGENT)) < 16u) {
                if ((++polls & 255u) == 0u && __builtin_amdgcn_readfirstlane(__hip_atomic_load(tmo, __ATOMIC_RELAXED, __HIP_MEMORY_SCOPE_AGENT)) != 0u) break;
                if (polls > (1u << 14)) { if (lane == 0) __hip_atomic_store(tmo, 1u, __ATOMIC_RELAXED, __HIP_MEMORY_SCOPE_AGENT); break; }
                __builtin_amdgcn_s_sleep(2); }
            __builtin_amdgcn_fence(__ATOMIC_ACQUIRE, "agent");
            asm volatile("s_waitcnt vmcnt(0)" ::: "memory");
        }
        asm volatile("" ::: "memory"); __builtin_amdgcn_s_barrier(); asm volatile("" ::: "memory");
    }
};
template <int ESH, bool PUBLISH, bool WAITA, class Epi, class Sched>
__device__ __forceinline__ void gemm_phase_moe(PG8_LAS unsigned char* lds, const bf16_t* Abase, const int K, PG8_LAS const unsigned* ent, const Sched& S, const Epi& E) {
    int tid_ = threadIdx.x; asm volatile("" : "+v"(tid_));
    const int tid = tid_, wid = __builtin_amdgcn_readfirstlane(tid >> 6), lane = tid & 63, wr = wid >> 2, wc = wid & 3, fr = lane & 15, fq = lane >> 4;
    const int nt = K / BK;
    int RA[2]; unsigned cA2[2], voffB[2];
#pragma unroll
    for (int i = 0; i < 2; ++i) { int R, C; stage_rc(tid * 16 + i * 8192, R, C); const int Rb = Epi::PERM ? ((R & ~31) + perm32(R & 31)) : R;
        RA[i] = R; cA2[i] = (unsigned)C * 2u; voffB[i] = (unsigned)(Rb * K + C) * 2u; }
    const size_t kstep = (size_t)(BK * 2);
    const size_t hstep = (size_t)HALF * K * 2;
    const unsigned rowb = (unsigned)K * 2u;
    const unsigned ldsw = (unsigned)wid * 1024u;
    const int aoff = lds_byte(wr * 64 + fr, fq * 8), boff = lds_byte(wc * 32 + fr, fq * 8);
#define PG8_SA(b, h) (((b) * 2 + (h)) * HTB)
#define PG8_SB(b, h) ((4 + (b) * 2 + (h)) * HTB)
#define PG8_STAGE(bufoff, gbase, voff) do { _Pragma("unroll") for (int _i = 0; _i < 2; ++_i) \
        __builtin_amdgcn_global_load_lds((const unsigned*)((const char*)(gbase) + (voff)[_i]), (PG8_LAS unsigned*)(lds + (bufoff) + ldsw + _i * 8192), 16, 0, 0); } while (0)
#define PG8_LDA(dst, b, h) do { _Pragma("unroll") for (int m = 0; m < 4; ++m) _Pragma("unroll") for (int k = 0; k < 2; ++k) dst[m][k] = *(const PG8_LAS bf16x8*)(lds + PG8_SA(b, h) + aoff + m * 2048 + k * 1024); } while (0)
#define PG8_LDB(dst, b, h) do { _Pragma("unroll") for (int n = 0; n < 2; ++n) _Pragma("unroll") for (int k = 0; k < 2; ++k) dst[n][k] = *(const PG8_LAS bf16x8*)(lds + PG8_SB(b, h) + boff + n * 2048 + k * 1024); } while (0)
#define PG8_MMA(ai, bj, At, Bt) do { __builtin_amdgcn_s_setprio(1); _Pragma("unroll") for (int m = 0; m < 4; ++m) _Pragma("unroll") for (int n = 0; n < 2; ++n) _Pragma("unroll") for (int k = 0; k < 2; ++k) \
        acc[ai][bj][m][n] = __builtin_amdgcn_mfma_f32_16x16x32_bf16(Bt[n][k], At[m][k], acc[ai][bj][m][n], 0, 0, 0); __builtin_amdgcn_s_setprio(0); } while (0)
#define PG8_WAIT_V(n) asm volatile("s_waitcnt vmcnt(" #n ")" ::: "memory")
#define PG8_WAIT_L(n) asm volatile("s_waitcnt lgkmcnt(" #n ")" ::: "memory")
#define PG8_BAR __builtin_amdgcn_s_barrier()
#define PG8_SCHED __builtin_amdgcn_sched_barrier(0)
#define PG8_OFFS(dst, u) do { _Pragma("unroll") for (int _h = 0; _h < 2; ++_h) _Pragma("unroll") for (int _i = 0; _i < 2; ++_i) \
        dst[_h][_i] = (ent[(u).slot * 256 + _h * HALF + RA[_i]] >> ESH) * rowb + cA2[_i]; } while (0)
    MUnit cur, nxt; int ui = 0; int pend = -1;
    if (!S.next(0, cur)) return;
    if constexpr (WAITA) S.a_ready(cur, wid, lane);
    f32x4 acc[2][2][4][2];
#pragma unroll
    for (int a = 0; a < 2; ++a)
#pragma unroll
        for (int b = 0; b < 2; ++b)
#pragma unroll
            for (int m = 0; m < 4; ++m)
#pragma unroll
                for (int n = 0; n < 2; ++n) acc[a][b][m][n] = (f32x4){0.f, 0.f, 0.f, 0.f};
    bf16x8 At[4][2], B0[2][2], B1[2][2];
    unsigned offc[2][2], offn[2][2];
    PG8_OFFS(offc, cur);
    const char* const cA = (const char*)Abase; const char* cB = S.b_base(cur);
    PG8_STAGE(PG8_SB(0, 0), cB, voffB); PG8_STAGE(PG8_SB(0, 1), cB + hstep, voffB); PG8_STAGE(PG8_SA(0, 0), cA, offc[0]); PG8_STAGE(PG8_SA(0, 1), cA, offc[1]);
    if (wr == 1) PG8_BAR;
    PG8_WAIT_V(2); PG8_BAR;
    PG8_STAGE(PG8_SB(1, 0), cB + kstep, voffB); PG8_STAGE(PG8_SA(1, 0), cA + kstep, offc[0]); PG8_STAGE(PG8_SB(1, 1), cB + hstep + kstep, voffB);
    PG8_WAIT_V(6); PG8_BAR;
    for (;;) {
        const bool has_next = S.next(ui + 1, nxt);
        const char* nB = has_next ? S.b_base(nxt) : cB;
        if (has_next) { PG8_OFFS(offn, nxt); } else {
#pragma unroll
            for (int h = 0; h < 2; ++h)
#pragma unroll
                for (int i = 0; i < 2; ++i) offn[h][i] = offc[h][i]; }
#pragma nounroll
        for (int t = 0; t < nt; t += 2) {
            const bool last = (t == nt - 2);
            if constexpr (WAITA) { if (last && has_next) S.a_ready(nxt, wid, lane); }
            const char* a1 = cA + (size_t)(t + 1) * kstep;
            const char* a2 = last ? cA : cA + (size_t)(t + 2) * kstep; const char* b2 = last ? nB : cB + (size_t)(t + 2) * kstep;
            const char* a3 = a2 + kstep; const char* b3 = b2 + kstep;
            unsigned o2[2][2];
#pragma unroll
            for (int h = 0; h < 2; ++h)
#pragma unroll
                for (int i = 0; i < 2; ++i) o2[h][i] = last ? offn[h][i] : offc[h][i];
            PG8_LDB(B0, 0, 0); PG8_LDB(B1, 0, 1); PG8_SCHED; PG8_LDA(At, 0, 0); PG8_STAGE(PG8_SA(1, 1), a1, offc[1]);
            PG8_WAIT_V(8); PG8_WAIT_L(0); PG8_BAR; PG8_MMA(0, 0, At, B0); PG8_MMA(0, 1, At, B1); PG8_BAR; PG8_SCHED;
            PG8_LDA(At, 0, 1); PG8_STAGE(PG8_SB(0, 0), b2, voffB); PG8_STAGE(PG8_SB(0, 1), b2 + hstep, voffB); PG8_STAGE(PG8_SA(0, 0), a2, o2[0]);
            PG8_WAIT_V(8); PG8_WAIT_L(0);
            if constexpr (PUBLISH) { if (t == 0 && pend >= 0) { S.publish(pend, lane); pend = -1; } }
            PG8_BAR; PG8_MMA(1, 0, At, B0); PG8_MMA(1, 1, At, B1); PG8_BAR; PG8_SCHED;
            PG8_LDB(B0, 1, 0); PG8_LDB(B1, 1, 1); PG8_SCHED; PG8_LDA(At, 1, 0); PG8_STAGE(PG8_SA(0, 1), a2, o2[1]);
            PG8_WAIT_V(8); PG8_WAIT_L(0); PG8_BAR; PG8_MMA(0, 0, At, B0); PG8_MMA(0, 1, At, B1); PG8_BAR; PG8_SCHED;
            PG8_LDA(At, 1, 1); PG8_STAGE(PG8_SB(1, 0), b3, voffB); PG8_STAGE(PG8_SB(1, 1), b3 + hstep, voffB); PG8_STAGE(PG8_SA(1, 0), a3, o2[0]);
            PG8_WAIT_V(8); PG8_WAIT_L(0); PG8_BAR; PG8_MMA(1, 0, At, B0); PG8_MMA(1, 1, At, B1); PG8_BAR; PG8_SCHED;
        }
        if (wr == 0) PG8_BAR;
        E(acc, cur, wr, wc, fr, fq);
        if constexpr (PUBLISH) pend = cur.tile;
        if (!has_next) break;
#pragma unroll
        for (int a = 0; a < 2; ++a)
#pragma unroll
            for (int b = 0; b < 2; ++b)
#pragma unroll
                for (int m = 0; m < 4; ++m)
#pragma unroll
                    for (int n = 0; n < 2; ++n) acc[a][b][m][n] = (f32x4){0.f, 0.f, 0.f, 0.f};
        cur = nxt; cB = nB; ++ui;
#pragma unroll
        for (int h = 0; h < 2; ++h)
#pragma unroll
            for (int i = 0; i < 2; ++i) offc[h][i] = offn[h][i];
        if (wr == 1) PG8_BAR;
    }
    PG8_WAIT_V(0);
    if constexpr (PUBLISH) { if (pend >= 0) S.publish(pend, lane); }
    PG8_BAR;
#undef PG8_SA
#undef PG8_SB
#undef PG8_STAGE
#undef PG8_LDA
#undef PG8_LDB
#undef PG8_MMA
#undef PG8_WAIT_V
#undef PG8_WAIT_L
#undef PG8_BAR
#undef PG8_SCHED
#undef PG8_OFFS
}
struct EpiAct {
    static constexpr bool PERM = true, AFTER_DRAIN = false;
    bf16_t* ACT; PG8_LAS const unsigned* ent; PG8_LAS const float* cwt;
    __device__ __forceinline__ void operator()(const f32x4 (&acc)[2][2][4][2], const MUnit& u, int wr, int wc, int fr, int fq) const {
#pragma unroll
        for (int ai = 0; ai < 2; ++ai)
#pragma unroll
            for (int m = 0; m < 4; ++m) { const int r = ai * HALF + wr * 64 + m * 16 + fr;
                if (r < u.nrows) { const unsigned en = ent[u.slot * 256 + r]; const float w = cwt[u.slot * 256 + r];
                    float a[8];
#pragma unroll
                    for (int n = 0; n < 2; ++n)
#pragma unroll
                        for (int j = 0; j < 4; ++j) { const float g = acc[ai][0][m][n][j], up = acc[ai][1][m][n][j];
                            a[4 * n + j] = g * __builtin_amdgcn_rcpf(1.f + __builtin_amdgcn_exp2f(-1.4426950408889634f * g)) * up * w; }
                    u32x4 o; o.x = cvt_pk_bf16(a[0], a[1]); o.y = cvt_pk_bf16(a[2], a[3]); o.z = cvt_pk_bf16(a[4], a[5]); o.w = cvt_pk_bf16(a[6], a[7]);
                    asm volatile("global_store_dwordx4 %0, %1, off sc1\n\ts_nop 1" :: "v"(ACT + (size_t)en * 256 + u.pn * HALF + wc * 32 + 8 * fq), "v"(o) : "memory"); } }
    }
};
struct EpiY {
    static constexpr bool PERM = true, AFTER_DRAIN = false;
    unsigned char* Y; size_t slot_stride; PG8_LAS const unsigned* ent;
    __device__ __forceinline__ void operator()(const f32x4 (&acc)[2][2][4][2], const MUnit& u, int wr, int wc, int fr, int fq) const {
#pragma unroll
        for (int ai = 0; ai < 2; ++ai)
#pragma unroll
            for (int m = 0; m < 4; ++m) { const int r = ai * HALF + wr * 64 + m * 16 + fr;
                if (r < u.nrows) { const unsigned en = ent[u.slot * 256 + r];
                    unsigned char* rowp = Y + (size_t)(en & 1u) * slot_stride + (size_t)(en >> 1) * 1024 + u.pn * BM + wc * 32 + 8 * fq;
#pragma unroll
                    for (int bj = 0; bj < 2; ++bj) { const f32x4 v0 = acc[ai][bj][m][0] * 16.f, v1 = acc[ai][bj][m][1] * 16.f;
                        int w0 = __builtin_amdgcn_cvt_pk_fp8_f32(v0[0], v0[1], 0, false); w0 = __builtin_amdgcn_cvt_pk_fp8_f32(v0[2], v0[3], w0, true);
                        int w1 = __builtin_amdgcn_cvt_pk_fp8_f32(v1[0], v1[1], 0, false); w1 = __builtin_amdgcn_cvt_pk_fp8_f32(v1[2], v1[3], w1, true);
                        typedef unsigned u32x2e __attribute__((ext_vector_type(2)));
                        *(u32x2e*)(rowp + bj * HALF) = (u32x2e){(unsigned)w0, (unsigned)w1}; } } }
    }
};
}

#include <hip/hip_bf16.h>
#include <cmath>

namespace attn_body {
using bf16=__hip_bfloat16;
using bf16x8=__attribute__((ext_vector_type(8)))short;
using s16x4=__attribute__((ext_vector_type(4)))short;
using f32x16=__attribute__((ext_vector_type(16)))float;
using u32x4=__attribute__((ext_vector_type(4)))unsigned;
constexpr int BATCH=8,NHEAD=8,SEQ=4096,D=64,DM=NHEAD*D,ODM=1024;
constexpr int NW=8,QBLK=32,QB=QBLK*NW,KVBLK=64,NQB=SEQ/QB;
constexpr int ATTN_PITCH=DM, ATTN_UNIT_ROWS=QB;
__device__ __forceinline__ int crow(int r,int hi){return (r&3)+8*(r>>2)+4*hi;}
#define SBAR() __builtin_amdgcn_sched_barrier(0)
__device__ __forceinline__ void cmask(f32x16&p0,f32x16&p1,int jb,int qrel,int hi){
  const float NEG=-INFINITY; int kb=64*jb+4*hi;
  #pragma unroll
  for(int r=0;r<16;++r){int kv=kb+(r&3)+8*(r>>2); if(kv>qrel)p0[r]=NEG; if(kv+32>qrel)p1[r]=NEG;}
}

constexpr int NSLOT=3, SLOTB=8192;
constexpr int LDS_K=0, LDS_V=NSLOT*SLOTB, LDS_WS=2*NSLOT*SLOTB, LDS_OST=LDS_WS+NW*64*4, LDS_BYTES=LDS_OST+NW*4096;
constexpr float SKIP_L2=-80.f;
constexpr int LDS_TICKET=85504;
constexpr int LDS_FB=86016, LDS_FB_BYTES=SEQ*8;
constexpr float C2=0.125f*1.4426950408889634f;
__device__ __forceinline__ void glds16(const void*gbase,unsigned voff,unsigned lds_dst){unsigned keep;
  asm volatile("s_mov_b32 %0, m0\n\ts_mov_b32 m0, %3\n\ts_nop 0\n\tglobal_load_lds_dwordx4 %1, %2\n\ts_mov_b32 m0, %0":"=&s"(keep):"v"(voff),"s"(gbase),"s"(lds_dst):"memory");}
__device__ __forceinline__ float max3f(float a,float b,float c){float r;asm("v_max3_f32 %0, %1, %2, %3":"=v"(r):"v"(a),"v"(b),"v"(c));return r;}
__device__ __forceinline__ float max2f(float a,float b){float r;asm("v_max_f32_e32 %0, %1, %2":"=v"(r):"v"(a),"v"(b));return r;}
__device__ __forceinline__ float fadd_s(float a,float b){float r;asm("v_add_f32_e32 %0, %1, %2":"=v"(r):"v"(a),"v"(b));return r;}
__device__ __forceinline__ float fsub_s(float a,float b){float r;asm("v_sub_f32_e32 %0, %1, %2":"=v"(r):"v"(a),"v"(b));return r;}
typedef float f32x2_t __attribute__((ext_vector_type(2))); typedef __bf16 bf16x2_t __attribute__((ext_vector_type(2)));
__device__ __forceinline__ unsigned cvtpk_s(float lo,float hi){f32x2_t v={lo,hi};bf16x2_t b=__builtin_convertvector(v,bf16x2_t);return __builtin_bit_cast(unsigned,b);}
#define WAIT_BAR(N) asm volatile("s_waitcnt vmcnt(" #N ") lgkmcnt(0)\n\ts_barrier":::"memory")

__device__ __forceinline__ void qkt(f32x16&p0,f32x16&p1,const char*Kslot,const bf16x8*qr,int r32,int hi){
  const char*kb=Kslot+hi*1024+r32*16;
  #pragma unroll
  for(int d0=0;d0<4;++d0){
    const bf16x8 b0=*reinterpret_cast<const bf16x8*>(kb+d0*2048);
    const bf16x8 b1=*reinterpret_cast<const bf16x8*>(kb+d0*2048+512);
    {p0=__builtin_amdgcn_mfma_f32_32x32x16_bf16(b0,qr[d0],p0,0,0,0);p1=__builtin_amdgcn_mfma_f32_32x32x16_bf16(b1,qr[d0],p1,0,0,0);}}
}
typedef __attribute__((address_space(3))) const char* lds_cptr;
typedef float f32x4_t __attribute__((ext_vector_type(4)));
typedef short v4i16_t __attribute__((ext_vector_type(4)));
__device__ __forceinline__ void kload8(bf16x8*kf,lds_cptr kp){
  kf[0]=*(const __attribute__((address_space(3))) bf16x8*)(kp);      kf[1]=*(const __attribute__((address_space(3))) bf16x8*)(kp+512);
  kf[2]=*(const __attribute__((address_space(3))) bf16x8*)(kp+2048); kf[3]=*(const __attribute__((address_space(3))) bf16x8*)(kp+2560);
  kf[4]=*(const __attribute__((address_space(3))) bf16x8*)(kp+4096); kf[5]=*(const __attribute__((address_space(3))) bf16x8*)(kp+4608);
  kf[6]=*(const __attribute__((address_space(3))) bf16x8*)(kp+6144); kf[7]=*(const __attribute__((address_space(3))) bf16x8*)(kp+6656);
}
__device__ __forceinline__ void kload2(bf16x8*kf,lds_cptr kp,int j){ kf[2*j]=*(const __attribute__((address_space(3))) bf16x8*)(kp+j*2048); kf[2*j+1]=*(const __attribute__((address_space(3))) bf16x8*)(kp+j*2048+512); }
__device__ __forceinline__ s16x4 vtr(lds_cptr p){ return __builtin_bit_cast(s16x4,__builtin_amdgcn_ds_read_tr16_b64_v4i16((__attribute__((address_space(3))) v4i16_t*)p)); }
__device__ __forceinline__ float rowmax(const f32x16&p0,const f32x16&p1){
  float a=max3f(p0[0],p0[1],p1[0]),b=max3f(p0[2],p0[3],p1[1]);a=max3f(a,p1[2],p1[3]);
  #pragma unroll
  for(int r=4;r<16;r+=4){a=max3f(a,p0[r],p0[r+1]);b=max3f(b,p0[r+2],p0[r+3]);a=max3f(a,p1[r],p1[r+1]);b=max3f(b,p1[r+2],p1[r+3]);}
  const float m=max2f(a,b);
  auto rr=__builtin_amdgcn_permlane32_swap(__float_as_uint(m),__float_as_uint(m),false,false);
  return max2f(__uint_as_float(rr[0]),__uint_as_float(rr[1]));
}
__device__ __forceinline__ void pv(f32x16*o,int vb,bf16x8 pa0,bf16x8 pa1,bf16x8 pa2,bf16x8 pa3){
  #pragma unroll
  for(int d0=0;d0<2;++d0){s16x4 lo[4],hi[4];
    #pragma unroll
    for(int ks=0;ks<4;++ks){
      asm volatile("ds_read_b64_tr_b16 %0,%1 offset:%c2":"=&v"(lo[ks]):"v"(vb),"i"(d0*4096+ks*1024):"memory");
      asm volatile("ds_read_b64_tr_b16 %0,%1 offset:%c2":"=&v"(hi[ks]):"v"(vb),"i"(d0*4096+ks*1024+512):"memory");}
    asm volatile("s_waitcnt lgkmcnt(0)":::"memory");SBAR();
    #define PK(k) (bf16x8){lo[k][0],lo[k][1],lo[k][2],lo[k][3],hi[k][0],hi[k][1],hi[k][2],hi[k][3]}
    o[d0]=__builtin_amdgcn_mfma_f32_32x32x16_bf16(pa0,PK(0),o[d0],0,0,0);
    o[d0]=__builtin_amdgcn_mfma_f32_32x32x16_bf16(pa1,PK(1),o[d0],0,0,0);
    o[d0]=__builtin_amdgcn_mfma_f32_32x32x16_bf16(pa2,PK(2),o[d0],0,0,0);
    o[d0]=__builtin_amdgcn_mfma_f32_32x32x16_bf16(pa3,PK(3),o[d0],0,0,0);
    #undef PK
  }
}

#ifndef ATTN_STORE16
#define ATTN_STORE16(p,v) STORE16_WT(p,v)
#endif
struct AttnBase { const char* ws; size_t q,k,v,o,fc,bt,nrm,qat,pq; };
template<int THRL> __device__ __forceinline__ int attn_units(const int x,int rank,const AttnBase&AB,const int maxu,int&ndone,int&steps,char*shm){
  typedef float f32x4_l __attribute__((ext_vector_type(4)));
  typedef unsigned v2u_t __attribute__((ext_vector_type(2)));
  #define WAVE_CONSTS() \
  int tid_=threadIdx.x; asm volatile("":"+v"(tid_)); const int tid=tid_,lane=tid&63,r32=lane&31,hi=lane>>5; const int wid=__builtin_amdgcn_readfirstlane(tid>>6); \
  const unsigned lds0=(unsigned)(uintptr_t)shm; \
  float*wsf=(float*)(shm+LDS_WS)+wid*64; \
  const unsigned ksrc=(unsigned)((lane*DM+wid*8)*2); \
  const unsigned vsrc=(unsigned)(((16*(wid&3)+(lane>>2))*DM+(wid>>2)*32+(lane&3)*8)*2); \
  const unsigned kdst=lds0+LDS_K+wid*1024, vdst=lds0+LDS_V+wid*1024; \
  const int vb0=(int)(lds0+LDS_V)+((lane>>4)&1)*32+(lane&3)*8+(4*hi+((lane&15)>>2))*64; \
  const char*Kbase=shm+LDS_K; \
  const lds_cptr shm3=(lds_cptr)shm; const lds_cptr kp0=shm3+LDS_K+hi*1024+r32*16; const lds_cptr vp0=shm3+LDS_V+((lane>>4)&1)*32+(lane&3)*8+(4*hi+((lane&15)>>2))*64; \
  const int qrel=wid*QBLK+r32; \
  const lds_cptr fbx=shm3+LDS_FB+(r32*8); \
  const u32x4 qxu_=hi?(u32x4){0u,0u,0u,0u}:(u32x4){0x3f803f80u,0x00003f80u,0u,0u}; const bf16x8 qx=__builtin_bit_cast(bf16x8,qxu_);
  #define DMA_K(t,slot) glds16(Kh,ksrc+(unsigned)(NTF-1-(t))*(unsigned)(KVBLK*DM*2),(unsigned)__builtin_amdgcn_readfirstlane(kdst+(slot)))
  #define DMA_V(t,slot) glds16(Vh,vsrc+(unsigned)(NTF-1-(t))*(unsigned)(KVBLK*DM*2),(unsigned)__builtin_amdgcn_readfirstlane(vdst+(slot)))
  int qb,q0,h,NTF,kend; long rowbase; const bf16*Kh,*Vh;
  float su_bt,su_fcj,su_fc0; unsigned su_k0,su_k1,su_q[8],su_u[8]; f32x4_l su_v0,su_v1; bf16x8 qr[4];
  #define NRMW(p,i) __hip_atomic_load((p)+(i),__ATOMIC_RELAXED,__HIP_MEMORY_SCOPE_AGENT)
  #define UNIT_ISSUE(RK) do{ const int u_=(RK),bq_=u_&7; qb=15-(u_>>3); const int bh_=bq_*8+((x-bq_)&7); h=bh_%NHEAD; rowbase=(long)(bh_/NHEAD)*SEQ; q0=qb*QB; kend=q0+QB; NTF=(q0+QB)/KVBLK; \
    const char*w_=AB.ws; asm volatile("":"+s"(w_)); const bf16*Q=(const bf16*)(w_+AB.q),*K=(const bf16*)(w_+AB.k),*V=(const bf16*)(w_+AB.v); const float*FC=(const float*)(w_+AB.fc),*BT=(const float*)(w_+AB.bt); const unsigned*nrm=(const unsigned*)(w_+AB.nrm); \
    const float*FCbh=FC+(long)bh_*SEQ; su_bt=lane<32?BT[bh_*32+lane]:0.f; \
    const unsigned*su_qn=nrm+((size_t)bh_*64)*2,*su_kn=nrm+((size_t)(64+bh_)*64)*2; \
    su_k0=NRMW(su_kn,2*lane);su_k1=NRMW(su_kn,2*lane+1); \
    _Pragma("unroll") for(int r=0;r<8;++r){ su_q[r]=NRMW(su_qn,8*qb+r); su_u[r]=NRMW(su_kn,8*qb+r); } \
    su_fcj=FCbh[64*lane+63];su_fc0=FCbh[256*qb]; \
    su_v0=(f32x4_l){0.f,0.f,0.f,0.f};su_v1=(f32x4_l){0.f,0.f,0.f,0.f}; \
    if(tid*4<kend)su_v0=*reinterpret_cast<const f32x4_l*>(FCbh+tid*4); \
    if(tid*4+NW*256<kend)su_v1=*reinterpret_cast<const f32x4_l*>(FCbh+tid*4+NW*256); \
    asm volatile("":::"memory"); __builtin_amdgcn_sched_barrier(0); \
    const bf16*Qw=Q+(rowbase+q0+wid*QBLK)*DM+h*D; Kh=K+rowbase*DM+h*D;Vh=V+rowbase*DM+h*D; \
    DMA_K(0,0);DMA_V(0,0);DMA_K(1,SLOTB); \
    _Pragma("unroll") for(int d0=0;d0<4;++d0)qr[d0]=*reinterpret_cast<const bf16x8*>(&Qw[(long)r32*DM+d0*16+hi*8]); \
    DMA_K(2,2*SLOTB); }while(0)
  #define XFR(v) __builtin_bit_cast(bf16x8,(u32x4){(v)[0],(v)[1],(v)[0],(v)[1]})
  #define CINIT(C0,C1,t) do{ const v2u_t a_=*(const __attribute__((address_space(3))) v2u_t*)(fbx+(NTF-1-(t))*512), b_=*(const __attribute__((address_space(3))) v2u_t*)(fbx+(NTF-1-(t))*512+256); \
      C0=__builtin_amdgcn_mfma_f32_32x32x16_bf16(XFR(a_),qx,negm,0,0,0); C1=__builtin_amdgcn_mfma_f32_32x32x16_bf16(XFR(b_),qx,negm,0,0,0); }while(0)
  #define CMASK(P0,P1,t) do{int jb_=3-(t); if(jb_>=0)cmask(P0,P1,jb_,qrel,hi);}while(0)
  #define START(P0,P1) do{ const float rm=rowmax(P0,P1); resc=false; \
    { const float dl=__builtin_fmaxf(rm,lower_); mhat=fadd_s(mhat,dl); \
      _Pragma("unroll") for(int r=0;r<16;++r){P0[r]=fsub_s(P0[r],dl);P1[r]=fsub_s(P1[r],dl);} \
      _Pragma("unroll") for(int r=0;r<16;++r)negm[r]=-mhat; asm volatile("":"+v"(negm)); } \
    _Pragma("unroll") for(int r=0;r<16;++r)P0[r]=__builtin_amdgcn_exp2f(P0[r]); }while(0)
  #define RESC() do{ if(resc){ asm volatile("s_waitcnt lgkmcnt(0)":::"memory"); \
      _Pragma("unroll") for(int d_=0;d_<2;++d_) _Pragma("unroll") for(int r=0;r<16;++r)o[d_][r]*=wsf[crow(r,hi)]; } }while(0)
  #define ROT() do{sl_prev=sl_cur;sl_cur=sl_next;sl_next=(sl_next==(NSLOT-1)*SLOTB)?0:sl_next+SLOTB;}while(0)
  { WAVE_CONSTS(); (void)wsf;(void)vb0;(void)Kbase;(void)kp0;(void)vp0;(void)qrel;(void)fbx;(void)qx; UNIT_ISSUE(rank); }
  int nrank,nu=0; bool pst=false;
  #pragma nounroll
  for(;;){
  WAVE_CONSTS(); bf16x8 kf[8];
  float mhat=0.f,l_reg=0.f;f32x16 o[2];o[0]=f32x16{};o[1]=f32x16{};f32x16 negm=f32x16{};asm volatile("":"+v"(negm));
  bool resc=false;
  f32x16 pA0,pA1,pB0,pB1;
  int sl_prev=0,sl_cur=0,sl_next=SLOTB;
  int j0; float cb; bool nomax;
  { float sc_=su_bt;
    #define DPPF0(V,CTRL,RM) __builtin_bit_cast(float,__builtin_amdgcn_update_dpp(0,__builtin_bit_cast(int,V),CTRL,RM,0xf,true))
    sc_+=DPPF0(sc_,0x111,0xf); sc_+=DPPF0(sc_,0x112,0xf); sc_+=DPPF0(sc_,0x114,0xf); sc_+=DPPF0(sc_,0x118,0xf);
    sc_+=DPPF0(sc_,0x142,0xa);
    #undef DPPF0
    const float offv=sc_-su_bt;
    const float kn2=__uint_as_float(su_k0)+__uint_as_float(su_k1);
    float qn2=0.f,ku2=0.f;
    #pragma unroll
    for(int r=0;r<4;++r){ qn2=fmaxf(qn2,__uint_as_float(su_q[2*r])+__uint_as_float(su_q[2*r+1])); ku2=fmaxf(ku2,__uint_as_float(su_u[2*r])+__uint_as_float(su_u[2*r+1])); }
    const float Qm=sqrtf(qn2)*1.01f,Kj=sqrtf(kn2)*1.01f,Ku=sqrtf(ku2)*1.01f; cb=Qm*Ku;
    const float fbj=-(su_fcj+pg8::lane_read(offv,lane>>1)),fb0=-(su_fc0+pg8::lane_read(offv,2*qb));
    const bool needed=(lane>=4*qb)||!(Qm*(Kj+Ku)+fbj-fb0<SKIP_L2);
    j0=__builtin_amdgcn_readfirstlane((int)(__builtin_ctzll(__ballot(needed)))&~1);
    nomax=(__ballot((lane>=j0)&&(lane<NTF)&&!(Qm*(Kj+Ku)<=78.f))==0ull);
    __attribute__((address_space(3))) u32x4* tb=(__attribute__((address_space(3))) u32x4*)(shm3+LDS_FB);
    #pragma unroll
    for(int k_=0;k_<2;++k_){ const int s_=tid*4+k_*NW*256;
      if(s_<kend){ const f32x4_l v_=(k_?su_v1:su_v0)+pg8::lane_read(offv,s_>>7); unsigned w0[4],w1[4];
        #pragma unroll
        for(int i_=0;i_<4;++i_){ const float f=-v_[i_]; const unsigned hb=cvtpk_s(f,0.f)&0xffffu; const float r1=f-__uint_as_float(hb<<16); const unsigned mb=cvtpk_s(r1,0.f)&0xffffu; const float r2=r1-__uint_as_float(mb<<16);
          w0[i_]=hb|(mb<<16); w1[i_]=cvtpk_s(r2,0.f)&0xffffu; }
        tb[s_/2]=(u32x4){w0[0],w1[0],w0[1],w1[1]}; tb[s_/2+1]=(u32x4){w0[2],w1[2],w0[3],w1[3]}; } }
  }
  const int NT=NTF-j0;
#if PROBE_STEPS
  steps+=NT;
#endif
  if(pst){WAIT_BAR(4);}else{WAIT_BAR(3);}
  float lower_; { const v2u_t e_=*(const __attribute__((address_space(3))) v2u_t*)(shm3+LDS_FB+(q0+qrel)*8); lower_=(__uint_as_float(e_[0]<<16)+__uint_as_float(e_[0]&0xffff0000u))+__uint_as_float(e_[1]<<16)-cb; }
  CINIT(pA0,pA1,0); qkt(pA0,pA1,Kbase,qr,r32,hi);asm volatile("s_nop 15\n\ts_nop 7":"+v"(pA0),"+v"(pA1));CMASK(pA0,pA1,0);
  START(pA0,pA1);
  _Pragma("unroll") for(int r=0;r<16;++r)pA1[r]=__builtin_amdgcn_exp2f(pA1[r]);
  if(pst){WAIT_BAR(4);}else{WAIT_BAR(0);}
  DMA_K(3,0);DMA_V(1,SLOTB);
  ROT();
  kload8(kf,kp0+sl_cur);
  WAIT_BAR(2);
  s16x4 vlo[8],vhi[8]; u32x4 pw0,pw1,pw2,pw3;
  #define PKW(P,B) cvtpk_s(P[B],P[B+1])
  #define PAF(k) __builtin_bit_cast(bf16x8,pw##k)
  #define VFR(i) (bf16x8){vlo[i][0],vlo[i][1],vlo[i][2],vlo[i][3],vhi[i][0],vhi[i][1],vhi[i][2],vhi[i][3]}
  #define PIN(x) asm volatile("":"+v"(x))
  #define MX3(a,b,c) __builtin_fmaxf(__builtin_fmaxf((a),(b)),(c))
  #define GAPA(MF,A0,A1,A2,A3,W0,W1,PW) do{ MF; sacc+=A0; sacc+=A1; sacc+=A2; sacc+=A3; PIN(sacc); W0; W1; PIN(PW); SBAR(); }while(0)
  #define EX(v) __builtin_amdgcn_exp2f(v)
  #define GAPB(MF,X,B) do{ MF; X[B]=EX(X[B]); X[B+1]=EX(X[B+1]); X[B+2]=EX(X[B+2]); X[B+3]=EX(X[B+3]); PIN(X); SBAR(); }while(0)
  #define VRD(i) do{ vlo[i]=vtr(vp_+(((i)>>2)*4096+((i)&3)*1024)); vhi[i]=vtr(vp_+(((i)>>2)*4096+((i)&3)*1024+512)); }while(0)
  #define KRD(G,j) do{ if(G){ kload2(kf,kp0+sl_next,j); SBAR(); } }while(0)
  #define STEP(C0,C1,P0,P1,t,GK,GV,GL) STEPX(C0,C1,P0,P1,t,GK,GV,GL,true)
  #define STEPX(C0,C1,P0,P1,t,GK,GV,GL,MX) do{ SBAR(); CINIT(C0,C1,t); SBAR(); \
    const lds_cptr vp_=vp0+sl_prev; \
    VRD(0); SBAR(); float sacc=(P0[0]+P0[1]); \
    GAPA(C0=__builtin_amdgcn_mfma_f32_32x32x16_bf16(kf[0],qr[0],C0,0,0,0), P0[2],P0[3],P0[4],P0[5],     pw0[0]=PKW(P0,0), pw0[1]=PKW(P0,2), pw0); \
    VRD(4); SBAR(); GAPA(C1=__builtin_amdgcn_mfma_f32_32x32x16_bf16(kf[1],qr[0],C1,0,0,0), P0[6],P0[7],P0[8],P0[9],     pw0[2]=PKW(P0,4), pw0[3]=PKW(P0,6), pw0); \
    VRD(1); SBAR(); GAPA(C0=__builtin_amdgcn_mfma_f32_32x32x16_bf16(kf[2],qr[1],C0,0,0,0),   P0[10],P0[11],P0[12],P0[13], pw1[0]=PKW(P0,8), pw1[1]=PKW(P0,10), pw1); \
    VRD(5); SBAR(); GAPA(C1=__builtin_amdgcn_mfma_f32_32x32x16_bf16(kf[3],qr[1],C1,0,0,0),   P0[14],P0[15],P1[0],P1[1],   pw1[2]=PKW(P0,12),pw1[3]=PKW(P0,14), pw1); \
    VRD(2); SBAR(); GAPA(C0=__builtin_amdgcn_mfma_f32_32x32x16_bf16(kf[4],qr[2],C0,0,0,0),   P1[2],P1[3],P1[4],P1[5],     pw2[0]=PKW(P1,0), pw2[1]=PKW(P1,2), pw2); \
    VRD(6); SBAR(); GAPA(C1=__builtin_amdgcn_mfma_f32_32x32x16_bf16(kf[5],qr[2],C1,0,0,0),   P1[6],P1[7],P1[8],P1[9],     pw2[2]=PKW(P1,4), pw2[3]=PKW(P1,6), pw2); \
    VRD(3); SBAR(); GAPA(C0=__builtin_amdgcn_mfma_f32_32x32x16_bf16(kf[6],qr[3],C0,0,0,0),   P1[10],P1[11],P1[12],P1[13], pw3[0]=PKW(P1,8), pw3[1]=PKW(P1,10), pw3); \
    VRD(7); SBAR(); GAPA(C1=__builtin_amdgcn_mfma_f32_32x32x16_bf16(kf[7],qr[3],C1,0,0,0),   P1[14],P1[15],0.f,0.f,       pw3[2]=PKW(P1,12),pw3[3]=PKW(P1,14), pw3); \
    l_reg+=sacc; \
    if(GK){DMA_K((t)+3,sl_cur);} if(GV){DMA_V((t)+1,sl_next);} \
    CMASK(C0,C1,t); \
    if(!(MX)){ resc=false; } else \
    { float a=MX3(C0[0],C0[1],C1[0]),b=MX3(C0[2],C0[3],C1[1]); a=MX3(a,C1[2],C1[3]); \
      _Pragma("unroll") for(int r=4;r<16;r+=4){a=MX3(a,C0[r],C0[r+1]);b=MX3(b,C0[r+2],C0[r+3]);a=MX3(a,C1[r],C1[r+1]);b=MX3(b,C1[r+2],C1[r+3]);} \
      float rm=__builtin_fmaxf(a,b); { auto rr=__builtin_amdgcn_permlane32_swap(__float_as_uint(rm),__float_as_uint(rm),false,false); rm=__builtin_fmaxf(__uint_as_float(rr[0]),__uint_as_float(rr[1])); } \
      resc=false; \
      if(__builtin_expect(__any(rm>(float)THRL),0)){ const float dl=__builtin_fmaxf(rm,0.f); mhat+=dl; \
        _Pragma("unroll") for(int r=0;r<16;++r){C0[r]-=dl;C1[r]-=dl;} \
        _Pragma("unroll") for(int r=0;r<16;++r)negm[r]=-mhat; asm volatile("":"+v"(negm)); \
        const float f=__builtin_amdgcn_exp2f(-dl); l_reg*=f; if(hi==0)wsf[r32]=f; resc=true; } } \
    SBAR(); \
    GAPB(o[0]=__builtin_amdgcn_mfma_f32_32x32x16_bf16(PAF(0),VFR(0),o[0],0,0,0), C0,0); \
    GAPB(o[1]=__builtin_amdgcn_mfma_f32_32x32x16_bf16(PAF(0),VFR(4),o[1],0,0,0), C0,4); \
    KRD(GL,0); GAPB(o[0]=__builtin_amdgcn_mfma_f32_32x32x16_bf16(PAF(1),VFR(1),o[0],0,0,0), C0,8); \
    KRD(GL,1); GAPB(o[1]=__builtin_amdgcn_mfma_f32_32x32x16_bf16(PAF(1),VFR(5),o[1],0,0,0), C0,12); \
    KRD(GL,2); GAPB(o[0]=__builtin_amdgcn_mfma_f32_32x32x16_bf16(PAF(2),VFR(2),o[0],0,0,0), C1,0); \
    KRD(GL,3); GAPB(o[1]=__builtin_amdgcn_mfma_f32_32x32x16_bf16(PAF(2),VFR(6),o[1],0,0,0), C1,4); \
    GAPB(o[0]=__builtin_amdgcn_mfma_f32_32x32x16_bf16(PAF(3),VFR(3),o[0],0,0,0), C1,8); \
    GAPB(o[1]=__builtin_amdgcn_mfma_f32_32x32x16_bf16(PAF(3),VFR(7),o[1],0,0,0), C1,12); \
    }while(0)
  int t=1;
  #define ENDW(tt) do{ if((tt)+3<NT){WAIT_BAR(2);} else if((tt)+2<NT){WAIT_BAR(1);} else {WAIT_BAR(0);} }while(0)
  #define GUARDED_PAIR() do{ \
    STEPX(pB0,pB1,pA0,pA1,t,(t+3<NT),(t+1<NT),(t+1<NT),!nomax);       ENDW(t);   RESC(); ROT(); \
    STEPX(pA0,pA1,pB0,pB1,t+1,(t+4<NT),(t+2<NT),(t+2<NT),!nomax);     ENDW(t+1); RESC(); ROT(); }while(0)
  for(;t<5&&t+1<NT;t+=2){ GUARDED_PAIR(); }
  #undef CMASK
  #define CMASK(P0,P1,t) do{}while(0)
  for(;t+5<NT;t+=2){
    STEPX(pB0,pB1,pA0,pA1,t,true,true,true,!nomax);     WAIT_BAR(2); RESC(); ROT();
    STEPX(pA0,pA1,pB0,pB1,t+1,true,true,true,!nomax);   WAIT_BAR(2); RESC(); ROT();
  }
  #undef CMASK
  #define CMASK(P0,P1,t) do{int jb_=3-(t); if(jb_>=0)cmask(P0,P1,jb_,qrel,hi);}while(0)
  for(;t+1<NT;t+=2){ GUARDED_PAIR(); }
  unsigned su_tk=0u; { const char*w_=AB.ws; asm volatile("":"+s"(w_)); if(tid==0)su_tk=__hip_atomic_fetch_add((unsigned*)(w_+AB.qat)+64*x,1u,__ATOMIC_RELAXED,__HIP_MEMORY_SCOPE_AGENT); }
  STEPX(pB0,pB1,pA0,pA1,NT-1,false,false,false,!nomax); RESC();
  { float sacc=pB0[0]+pB0[1]; _Pragma("unroll") for(int r=2;r<16;++r)sacc+=pB0[r]; _Pragma("unroll") for(int r=0;r<16;++r)sacc+=pB1[r]; l_reg+=sacc;
    pw0=(u32x4){PKW(pB0,0),PKW(pB0,2),PKW(pB0,4),PKW(pB0,6)};pw1=(u32x4){PKW(pB0,8),PKW(pB0,10),PKW(pB0,12),PKW(pB0,14)};pw2=(u32x4){PKW(pB1,0),PKW(pB1,2),PKW(pB1,4),PKW(pB1,6)};pw3=(u32x4){PKW(pB1,8),PKW(pB1,10),PKW(pB1,12),PKW(pB1,14)};
    SBAR(); pv(o,vb0+sl_cur,PAF(0),PAF(1),PAF(2),PAF(3)); }
  bf16*Ow; { const char*w_=AB.ws; asm volatile("":"+s"(w_)); Ow=(bf16*)(w_+AB.o)+(rowbase+q0+wid*QBLK)*ODM+h*D; }
  if(tid==0)*(volatile __attribute__((address_space(3))) unsigned*)(shm3+LDS_TICKET)=su_tk;
  asm volatile("s_waitcnt vmcnt(0) lgkmcnt(0)\n\ts_barrier":::"memory");
  nrank=32+__builtin_amdgcn_readfirstlane((int)*(volatile __attribute__((address_space(3))) unsigned*)(shm3+LDS_TICKET));
  #define UNIT_EPILOGUE() do{ \
  {auto rr=__builtin_amdgcn_permlane32_swap(__float_as_uint(l_reg),__float_as_uint(l_reg),false,false);l_reg=__uint_as_float(rr[0])+__uint_as_float(rr[1]);} \
  if(hi==0)wsf[32+r32]=l_reg;asm volatile("s_waitcnt lgkmcnt(0)":::"memory"); \
  float rli[16]; \
  _Pragma("unroll") \
  for(int r=0;r<16;++r)rli[r]=__builtin_amdgcn_rcpf(wsf[32+crow(r,hi)]); \
  { bf16*stg=(bf16*)(shm+LDS_OST)+wid*2048; \
    _Pragma("unroll") \
    for(int r=0;r<16;++r){const int orow=crow(r,hi); \
      _Pragma("unroll") \
      for(int d0=0;d0<2;++d0)stg[orow*64+d0*32+r32]=__float2bfloat16(o[d0][r]*rli[r]);} \
    asm volatile("s_waitcnt lgkmcnt(0)":::"memory"); \
    asm volatile("s_waitcnt vmcnt(0)":"+v"(qr[0]),"+v"(qr[1]),"+v"(qr[2]),"+v"(qr[3])::"memory"); \
    _Pragma("unroll") \
    for(int i=0;i<4;++i){const int row=i*8+(lane>>3),ch=lane&7; const u32x4 v=*(const u32x4*)(stg+row*64+ch*8); ATTN_STORE16(Ow+(long)row*ODM+ch*8,v);} } \
  }while(0)
  ++nu; const bool go_=(nrank<128)&&(nu<maxu);
  if(go_){ UNIT_ISSUE(nrank); }
  else{ qb=0;q0=0;h=0;NTF=0;kend=0;rowbase=0;Kh=nullptr;Vh=nullptr; su_bt=0.f;su_fcj=0.f;su_fc0=0.f;su_k0=0u;su_k1=0u;
    _Pragma("unroll") for(int r=0;r<8;++r){su_q[r]=0u;su_u[r]=0u;} su_v0=(f32x4_l){0.f,0.f,0.f,0.f};su_v1=su_v0;
    _Pragma("unroll") for(int d0=0;d0<4;++d0)qr[d0]=bf16x8{}; }
  UNIT_EPILOGUE();
  if(!go_)break;
  pst=true;
  }
  ndone+=nu;
  #undef UNIT_EPILOGUE
  #undef PKW
  #undef PAF
  #undef VFR
  #undef PIN
  #undef MX3
  #undef GAPA
  #undef GAPB
  #undef EX
  #undef VRD
  #undef KRD
  #undef STEP
  #undef STEPX
  #undef ENDW
  #undef GUARDED_PAIR
  #undef UNIT_ISSUE
  #undef WAVE_CONSTS
  #undef NRMW
  #undef DMA_K
  #undef DMA_V
  #undef CMASK
  #undef START
  #undef RESC
  #undef ROT
  #undef CINIT
  #undef XFR
  asm volatile("s_barrier":::"memory");
  return nrank;
}
constexpr int ATTN_LDS_BYTES=LDS_FB+LDS_FB_BYTES;
struct AttnTensors { const bf16* Q; const bf16* K; const bf16* V; bf16* O; const float* FC; const float* BT; };
struct AttnUnit { int bh; int qb; };
struct StaticOrder {
  int vcu;
  __device__ __forceinline__ explicit StaticOrder(int vcu_):vcu(vcu_){}
  __device__ __forceinline__ bool next(int i,AttnUnit&u)const{ if(i>=4||vcu>=256)return false; const int s=vcu&3; u.bh=vcu>>2; u.qb=(i==0)?s:(i==1)?7-s:(i==2)?8+s:15-s; return true; }
};
__device__ __forceinline__ int skip_tiles(const unsigned*nrm,const float*FCbh,const float offv,int bh,int qb,int lane,float&cb){
  const unsigned*qn=nrm+((size_t)bh*64)*2,*kn=nrm+((size_t)(64+bh)*64)*2;
  #define NRM2(p,i) (__uint_as_float(__hip_atomic_load((p)+2*(i),__ATOMIC_RELAXED,__HIP_MEMORY_SCOPE_AGENT))+__uint_as_float(__hip_atomic_load((p)+2*(i)+1,__ATOMIC_RELAXED,__HIP_MEMORY_SCOPE_AGENT)))
  const float kn2=NRM2(kn,lane);
  float qn2=0.f,ku2=0.f;
  #pragma unroll
  for(int r=0;r<4;++r){ qn2=fmaxf(qn2,NRM2(qn,4*qb+r)); ku2=fmaxf(ku2,NRM2(kn,4*qb+r)); }
  #undef NRM2
  const float Qm=sqrtf(qn2)*1.01f,Kj=sqrtf(kn2)*1.01f,Ku=sqrtf(ku2)*1.01f; cb=Qm*Ku;
  const float fbj=-(FCbh[64*lane+63]+pg8::lane_read(offv,lane>>1)),fb0=-(FCbh[256*qb]+pg8::lane_read(offv,2*qb));
  const bool needed=(lane>=4*qb)||!(Qm*(Kj+Ku)+fbj-fb0<-152.f);
  const unsigned long long mask=__ballot(needed);
  return (int)(__builtin_ctzll(mask))&~1;
}
template<int THRL=32,class Hook> __device__ __forceinline__ void attn_phase(char*lds,const AttnBase&AB,const int vcu,const int tid,Hook&hk){
#if PROBE_STEPS
  unsigned long long pa_=0ull,pb_=0ull,pc_=0ull;
#endif
  int x=vcu>>5,rank=vcu&31,steps=0,ndone=0;
  const int cvt_after=vcu&3; bool cvt_done=false,fin=false;
  volatile __attribute__((address_space(3))) int* tk=(volatile __attribute__((address_space(3))) int*)((lds_cptr)lds+LDS_TICKET);
  const bool young_=__builtin_amdgcn_readfirstlane(tid)>=256; if(young_)__builtin_amdgcn_s_setprio(1);
  #pragma nounroll
  for(;;){
    if(!cvt_done&&(fin||ndone>=cvt_after)){ if(young_)__builtin_amdgcn_s_setprio(0);
#if PROBE_STEPS
      const unsigned long long pq_=__builtin_amdgcn_s_memrealtime();
#endif
      hk.convert();
#if PROBE_STEPS
      pc_=__builtin_amdgcn_s_memrealtime()-pq_;
#endif
      if(young_)__builtin_amdgcn_s_setprio(1); cvt_done=true; }
    if(fin)break;
    if(rank<128){ rank=attn_units<THRL>(x,rank,AB,cvt_done?(1<<20):cvt_after-ndone,ndone,steps,lds); continue; }
    unsigned*qbase; { const char*w_=AB.ws; asm volatile("":"+s"(w_)); qbase=(unsigned*)(w_+AB.qat); }
    int t2_=threadIdx.x; asm volatile("":"+v"(t2_)); const int lane=t2_&63;
    if(t2_<64){ unsigned c=96u; if(lane<8)c=__hip_atomic_load(qbase+64*lane,__ATOMIC_RELAXED,__HIP_MEMORY_SCOPE_AGENT);
      int key=c<96u?(int)(((96u-c)<<3)|(unsigned)lane):0;
      #pragma unroll
      for(int o_=1;o_<8;o_<<=1){ const int t_=__builtin_amdgcn_ds_bpermute((lane^o_)<<2,key); key=key>t_?key:t_; }
      int xv=-1,rk=0;
      if(key>0){ xv=key&7; unsigned old=0u; if(lane==0)old=__hip_atomic_fetch_add(qbase+64*xv,1u,__ATOMIC_RELAXED,__HIP_MEMORY_SCOPE_AGENT); rk=32+(int)old; }
      if(lane==0){ tk[1]=xv; tk[2]=rk; } }
    __syncthreads();
    const int xv=__builtin_amdgcn_readfirstlane(tk[1]),rk=__builtin_amdgcn_readfirstlane(tk[2]);
    __syncthreads();
    if(xv<0){fin=true;continue;}
    x=xv; rank=rk;
  }
  if(young_)__builtin_amdgcn_s_setprio(0);
  { unsigned*pq; { const char*w_=AB.ws; asm volatile("":"+s"(w_)); pq=(unsigned*)(w_+AB.pq); }
    #pragma nounroll
    for(;;){ int t3_=threadIdx.x; asm volatile("":"+v"(t3_));
      if(t3_==0)tk[1]=(int)__hip_atomic_fetch_add(pq,1u,__ATOMIC_RELAXED,__HIP_MEMORY_SCOPE_AGENT);
      __syncthreads(); const int it=__builtin_amdgcn_readfirstlane(tk[1]); __syncthreads();
      if(it>=256)break;
      hk.block(it); } }
  hk.steps=steps;
#if PROBE_STEPS
  if(PROBE_STEPS==7)hk.steps=(int)((pb_-pa_)/10ull);
  if(PROBE_STEPS==8)hk.steps=(int)(pc_/10ull);
#endif
}
#undef SBAR
#undef WAIT_BAR
}

constexpr int NWAVES = 8;
#ifndef MK_PER_PHASE
#define MK_PER_PHASE 0
#endif
constexpr int BATCH = 8, SEQ = 4096, T = BATCH * SEQ, D = 1024, NL = 2, NH = 8, HD = 64, AW = 512, PW = 512, INW = 2056, NG = 4, NE = 8, NX = 32, FE = 256;
constexpr float RMS_EPS = 1e-6f;
constexpr int NPH = 16;
constexpr size_t MiB = 1u << 20;
constexpr size_t WS_CTL = 0, CTL_ZERO_BYTES = 1 * MiB;
constexpr size_t WS_MOD = 1 * MiB;
constexpr size_t WS_FRF = 1 * MiB + 512 * 1024;
constexpr size_t WS_RRF = WS_FRF + 128 * 1024;
constexpr size_t WS_FL = 2 * MiB;
constexpr size_t WS_FC = 3 * MiB;
constexpr size_t WS_CW = 4 * MiB;
constexpr size_t WS_LIST = 5 * MiB;
constexpr size_t WS_WIN = 10 * MiB, WS_WOUT = 18 * MiB, WS_WGU = 22 * MiB, WS_WD = 86 * MiB;
constexpr size_t WS_H = 118 * MiB;
constexpr size_t WS_QKVU = 182 * MiB;
constexpr size_t WS_AO = 310 * MiB;
constexpr size_t WS_DL = 374 * MiB;
constexpr size_t WS_XB = 438 * MiB;
constexpr size_t WS_END = 502 * MiB;
constexpr int CW_TIL = 98304, TIL_STRIDE = 320 * 64;
constexpr int CW_NRM = 32768, NRM_WORDS = 2 * 64 * 64 * 2;
constexpr int CW_PQ = 13312;
constexpr int CW_QAT = 12288;
constexpr int CW_TMO = 0, CW_CODE = 1, CW_BAR = 4096, CW_CNT = 16384;
constexpr int RING_OFF = 0, RING_BYTES = 131072;
constexpr int LDSCTL_OFF = RING_BYTES, MISC_OFF = LDSCTL_OFF + 320;
constexpr int ENT_OFF = LDSCTL_OFF + 1024, ENT_UNITS = 8;
constexpr int CWT_OFF = ENT_OFF + ENT_UNITS * 1024;
constexpr int TST_OFF = CWT_OFF + 3 * 1024;
constexpr int LDS_BYTES = 147456;
static_assert(TST_OFF + (65 + 4 * ENT_UNITS + 2) * 4 <= LDS_BYTES && MISC_OFF + 128 <= ENT_OFF, "LDS map");

#define GAS __attribute__((address_space(1)))
#define LAS __attribute__((address_space(3)))
typedef unsigned short bf16;
typedef unsigned v4u __attribute__((ext_vector_type(4)));
typedef float f32x4 __attribute__((ext_vector_type(4)));
typedef short bf16x8 __attribute__((ext_vector_type(8)));
typedef GAS unsigned gu32;
typedef GAS unsigned long long gu64;
#define RLX_AGENT __ATOMIC_RELAXED, __HIP_MEMORY_SCOPE_AGENT
#define LDS_WAIT() asm volatile("s_waitcnt lgkmcnt(0)" ::: "memory")
#define VM_WAIT() asm volatile("s_waitcnt vmcnt(0)" ::: "memory")
__device__ __forceinline__ unsigned long long rt() { return __builtin_amdgcn_s_memrealtime(); }
__device__ __forceinline__ unsigned f2bf(float f) { unsigned u = __builtin_bit_cast(unsigned, f); return (u + 0x7fffu + ((u >> 16) & 1u)) >> 16; }
__device__ __forceinline__ unsigned pk2(float lo, float hi) { return f2bf(lo) | (f2bf(hi) << 16); }

#define XB_TMO      128
#define XB_XCNT(j)  (256  + 64 * (j))
#define XB_XSUB(j)  (1280 + 64 * (j))
#define XB_XGEN(j)  (2304 + 64 * (j))
#define XB_TOP      3328
#define XB_TOPGEN   3392
#define XCD_BAR_WORDS 3456
#define XB_SPIN_CAP (1u << 18)

__device__ __forceinline__ unsigned xb_ld(unsigned* p)              { return __hip_atomic_load(p, __ATOMIC_RELAXED, __HIP_MEMORY_SCOPE_AGENT); }
__device__ __forceinline__ unsigned xb_add(unsigned* p, unsigned v) { return __hip_atomic_fetch_add(p, v, __ATOMIC_RELAXED, __HIP_MEMORY_SCOPE_AGENT); }
__device__ __forceinline__ unsigned xb_xcc_id() { return (unsigned)__builtin_amdgcn_s_getreg((3 << 11) | 20) & 0xFu; }
#define XB_SPIN(cond, bar) do { unsigned _sp = 0; while (cond) { __builtin_amdgcn_s_sleep(1); \
    if ((++_sp & 255u) == 0u) { if (xb_ld(&(bar)[XB_TMO])) break; if (_sp > XB_SPIN_CAP) { atomicAdd(&(bar)[XB_TMO], 1u); break; } } } } while (0)

struct XcdBarrier {
    unsigned* bar; unsigned x;
    volatile LAS unsigned* st;
};

__device__ __forceinline__ XcdBarrier xcd_barrier_post(unsigned* bar, volatile LAS unsigned* st) {
    XcdBarrier b; b.bar = bar; b.x = xb_xcc_id(); b.st = st;
    if (threadIdx.x == 0) (void)xb_add(&bar[XB_XCNT(b.x)], 1u);
    return b;
}
__device__ __forceinline__ void xcd_barrier_complete(unsigned* bar, unsigned x, unsigned& nloc, unsigned& nx) {
    const unsigned G = gridDim.x * gridDim.y * gridDim.z;
    unsigned sum, cnt, mine, sp = 0u;
    for (;;) {
        sum = 0u; cnt = 0u; mine = 0u;
#pragma unroll
        for (unsigned j = 0; j < 16; ++j) { const unsigned c = xb_ld(&bar[XB_XCNT(j)]); sum += c; cnt += (c > 0u) ? 1u : 0u; mine = (j == x) ? c : mine; }
        if (sum == G) break;
        __builtin_amdgcn_s_sleep(1);
        if ((++sp & 255u) == 0u) { if (xb_ld(&bar[XB_TMO])) break; if (sp > XB_SPIN_CAP) { atomicAdd(&bar[XB_TMO], 1u); break; } }
    }
    nloc = mine > 0u ? mine : 1u; nx = cnt > 0u ? cnt : 1u;
}

__device__ __forceinline__ void xcd_barrier(const XcdBarrier& b) {
    asm volatile("s_waitcnt vmcnt(0)" ::: "memory");
    __syncthreads();
    if (threadIdx.x == 0) {
        unsigned* bar = b.bar;
        __builtin_amdgcn_s_waitcnt(0);
        unsigned nloc = b.st[0], nx = b.st[1];
        if (nloc == 0u) { xcd_barrier_complete(bar, b.x, nloc, nx); b.st[0] = nloc; b.st[1] = nx; }
        const unsigned old = xb_add(&bar[XB_XSUB(b.x)], 1u);
        const unsigned gen = old / nloc;
        if (old + 1u == (gen + 1u) * nloc) {
            __builtin_amdgcn_fence(__ATOMIC_RELEASE, "agent");
            asm volatile("s_waitcnt vmcnt(0)" ::: "memory");
            const unsigned og = xb_add(&bar[XB_TOP], 1u);
            const unsigned tg = og / nx;
            if (og + 1u == (tg + 1u) * nx) xb_add(&bar[XB_TOPGEN], 1u);
            else XB_SPIN(xb_ld(&bar[XB_TOPGEN]) == tg, bar);
            __builtin_amdgcn_fence(__ATOMIC_ACQUIRE, "agent");
            xb_add(&bar[XB_XGEN(b.x)], 1u);
            asm volatile("s_waitcnt vmcnt(0)" ::: "memory");
        } else {
            XB_SPIN(xb_ld(&bar[XB_XGEN(b.x)]) == gen, bar);
            __builtin_amdgcn_fence(__ATOMIC_ACQUIRE, "agent");
            asm volatile("s_waitcnt vmcnt(0)" ::: "memory");
        }
    }
    __syncthreads();
}

struct Frame {
    LAS unsigned char* lds;
    volatile LAS unsigned* MISC;
    gu32* ctl;
    int tid, lane, wave;
    int vcu, G;
};
typedef unsigned u32x4v __attribute__((ext_vector_type(4)));
__device__ __forceinline__ float bflo(unsigned w) { return __builtin_bit_cast(float, w << 16); }
__device__ __forceinline__ float bfhi(unsigned w) { return __builtin_bit_cast(float, w & 0xffff0000u); }
__device__ __forceinline__ unsigned cvtpk(float lo, float hi) { unsigned r; asm volatile("v_cvt_pk_bf16_f32 %0, %1, %2" : "=v"(r) : "v"(lo), "v"(hi)); return r; }

__device__ __forceinline__ void transpose_load64(f32x4 (&v)[16], const float* W, int ldw, int k0, int n0src, int lane) {
    const float* src = W + (size_t)(k0 + (lane >> 4)) * ldw + n0src + 4 * (lane & 15);
#pragma unroll
    for (int i = 0; i < 16; ++i) v[i] = *(const f32x4*)(src + (size_t)(4 * i) * ldw);
}
__device__ __forceinline__ void transpose_finish64(const f32x4 (&v)[16], bf16* WT, int ldt, int k0, int dstrow0, LAS float* scr, int lane) {
#pragma unroll
    for (int i = 0; i < 16; ++i) { const int k = 4 * i + (lane >> 4); const int col = (4 * (lane & 15) + 8 * (k >> 3)) & 63; *(LAS f32x4*)(scr + k * 64 + col) = v[i]; }
    LDS_WAIT(); asm volatile("" ::: "memory");
    const int c = lane >> 3;
#pragma unroll
    for (int q = 0; q < 8; ++q) { const int n = (lane & 7) + 8 * q; const LAS float* s_ = scr + (8 * c) * 64 + ((n + 8 * c) & 63);
        v4u o; o.x = pk2(s_[0], s_[64]); o.y = pk2(s_[128], s_[192]); o.z = pk2(s_[256], s_[320]); o.w = pk2(s_[384], s_[448]);
        *(GAS v4u*)(WT + (size_t)(dstrow0 + n) * ldt + k0 + 8 * c) = o; }
    LDS_WAIT(); asm volatile("" ::: "memory");
}
__device__ __forceinline__ void transpose_item64(const float* W, int ldw, bf16* WT, int ldt, int k0, int n0src, int dstrow0, LAS float* scr, int lane) {
    f32x4 v[16];
    transpose_load64(v, W, ldw, k0, n0src, lane);
    asm volatile("" ::: "memory"); __builtin_amdgcn_sched_barrier(0);
    transpose_finish64(v, WT, ldt, k0, dstrow0, scr, lane);
}
struct In {
    const float *x, *c, *g_mix, *g_ffn, *g_fin, *w_ada, *b_ada, *w_in, *b_fg, *w_pool, *pool_scale, *w_out, *w_rg, *b_rg, *w_re, *b_re, *w_eg, *w_eu, *w_ed;
};
__device__ __forceinline__ void p0_prologue(Frame& F, const In& I, unsigned char* ws, int mode) {
    bf16* WinT = (bf16*)(ws + WS_WIN); bf16* WoutT = (bf16*)(ws + WS_WOUT);
    float* MOD = (float*)(ws + WS_MOD);
#ifndef WG_REPS
#define WG_REPS 1
#endif
#pragma nounroll
    for (int wrp = 0; wrp < WG_REPS; ++wrp)
    if (mode != 1 && F.vcu < 64) {
        const int l = F.vcu >> 5, g = (F.vcu >> 3) & 3, nb = F.vcu & 7;
        LAS float* ApT = (LAS float*)F.lds;
        LAS float* Bw = ApT + 128 * 128;
        const float* wp = I.w_pool + (size_t)(l * 4 + g) * 128 * 128; const float* ps = I.pool_scale + l * 512 + g * 128;
        const float* wo = I.w_out + (size_t)l * D * D + (size_t)(512 + 128 * g) * D + 128 * nb;
        { f32x4 va[8], vb[8];
#pragma unroll
          for (int j = 0; j < 8; ++j) { const int q4 = F.tid + 512 * j; const int r = q4 >> 5, c4 = (q4 & 31) * 4; va[j] = *(const f32x4*)(wp + r * 128 + c4); vb[j] = *(const f32x4*)(wo + (size_t)r * D + c4); }
#pragma unroll
          for (int j = 0; j < 8; ++j) { const int q4 = F.tid + 512 * j; const int r = q4 >> 5, c4 = (q4 & 31) * 4;
              const f32x4 p4 = *(const f32x4*)(ps + c4);
              const int rs = r ^ (((c4 >> 2) & 15) << 3);
              ApT[(c4 + 0) * 128 + rs] = va[j][0] * p4[0]; ApT[(c4 + 1) * 128 + rs] = va[j][1] * p4[1]; ApT[(c4 + 2) * 128 + rs] = va[j][2] * p4[2]; ApT[(c4 + 3) * 128 + rs] = va[j][3] * p4[3];
              *(LAS f32x4*)(Bw + r * 128 + c4) = vb[j]; } }
        __syncthreads();
        const int tn = F.tid & 31, tc = F.tid >> 5;
        float acc[4][8];
#pragma unroll
        for (int i = 0; i < 4; ++i)
#pragma unroll
            for (int j = 0; j < 8; ++j) acc[i][j] = 0.f;
#pragma unroll 2
        for (int d = 0; d < 128; ++d) { const f32x4 bv = *(const LAS f32x4*)(Bw + d * 128 + 4 * tn);
            const int cs = (8 * tc) ^ (((d >> 2) & 15) << 3);
            const f32x4 a0 = *(const LAS f32x4*)(ApT + d * 128 + cs), a1 = *(const LAS f32x4*)(ApT + d * 128 + cs + 4);
#pragma unroll
            for (int i = 0; i < 4; ++i) { acc[i][0] += a0[0] * bv[i]; acc[i][1] += a0[1] * bv[i]; acc[i][2] += a0[2] * bv[i]; acc[i][3] += a0[3] * bv[i];
                acc[i][4] += a1[0] * bv[i]; acc[i][5] += a1[1] * bv[i]; acc[i][6] += a1[2] * bv[i]; acc[i][7] += a1[3] * bv[i]; } }
#pragma unroll
        for (int i = 0; i < 4; ++i) { bf16* dst = WoutT + (size_t)l * D * D + (size_t)(128 * nb + 4 * tn + i) * D + 512 + 128 * g + 8 * tc;
            v4u o; o.x = pk2(acc[i][0], acc[i][1]); o.y = pk2(acc[i][2], acc[i][3]); o.z = pk2(acc[i][4], acc[i][5]); o.w = pk2(acc[i][6], acc[i][7]);
            *(GAS v4u*)dst = o; }
        __syncthreads();
    } else if (mode != 1 && F.vcu < 256) {
        const int it = F.vcu - 64, l = it / 96, n0 = 64 * (it % 96);
        LAS float* cT = (LAS float*)F.lds;
        LAS float* part = (LAS float*)(F.lds + 32768);
        { float cv[16];
#pragma unroll
          for (int j = 0; j < 16; ++j) cv[j] = I.c[F.tid + 512 * j];
          asm volatile("" ::: "memory"); __builtin_amdgcn_sched_barrier(0);
#pragma unroll
          for (int j = 0; j < 16; ++j) { const int q = F.tid + 512 * j; const int b = q >> 10, k = q & 1023; cT[k * 8 + b] = cv[j] / (1.f + __expf(-cv[j])); } }
        __syncthreads();
        const int r4 = F.lane >> 4, c16 = F.lane & 15;
        const char* wb = (const char*)(I.w_ada + (size_t)l * D * 6144 + n0);
        const unsigned off0 = (unsigned)(((F.wave * 128 + r4) * 6144 + 4 * c16) * 4);
        float acc[8][4];
#pragma unroll
        for (int b = 0; b < 8; ++b) { acc[b][0] = 0.f; acc[b][1] = 0.f; acc[b][2] = 0.f; acc[b][3] = 0.f; }
#pragma unroll 1
        for (int kb = 0; kb < 2; ++kb) {
            f32x4 wv[16];
#pragma unroll
            for (int j = 0; j < 16; ++j) wv[j] = *(const f32x4*)(wb + (off0 + (unsigned)((kb * 64 + 4 * j) * 6144 * 4)));
            asm volatile("" ::: "memory"); __builtin_amdgcn_sched_barrier(0);
#pragma unroll
            for (int j = 0; j < 16; ++j) { const int k = F.wave * 128 + kb * 64 + 4 * j + r4;
                if ((j & 3) == 0) asm volatile("" ::: "memory");
                const f32x4 c0 = *(const LAS f32x4*)(cT + k * 8), c1 = *(const LAS f32x4*)(cT + k * 8 + 4);
#pragma unroll
                for (int i = 0; i < 4; ++i) { acc[0][i] += c0[0] * wv[j][i]; acc[1][i] += c0[1] * wv[j][i]; acc[2][i] += c0[2] * wv[j][i]; acc[3][i] += c0[3] * wv[j][i];
                    acc[4][i] += c1[0] * wv[j][i]; acc[5][i] += c1[1] * wv[j][i]; acc[6][i] += c1[2] * wv[j][i]; acc[7][i] += c1[3] * wv[j][i]; } }
        }
#pragma unroll
        for (int b = 0; b < 8; ++b) *(LAS f32x4*)(part + ((F.wave * 4 + r4) * 8 + b) * 64 + 4 * c16) = (f32x4){acc[b][0], acc[b][1], acc[b][2], acc[b][3]};
        __syncthreads();
        { const int b = F.wave; float s = I.b_ada[l * 6144 + n0 + F.lane];
#pragma unroll
            for (int sl = 0; sl < 32; ++sl) s += part[(sl * 8 + b) * 64 + F.lane];
            MOD[(size_t)(l * 8 + b) * 6144 + n0 + F.lane] = s; }
        __syncthreads();
    }
    { const int q = (F.G - 1 - F.vcu) * (NWAVES * 64) + F.tid;
      if (mode != 1 && q < NL * 32 * 4 * 64) {
        const int l = q >> 13, c = (q >> 8) & 31, nb4 = (q >> 6) & 3, ln = q & 63; const int n = ln & 15, k0 = 32 * c + 8 * (ln >> 4);
        const float* base; size_t stride; bool valid;
        if (nb4 == 3) { valid = n < 8; base = I.w_in + (size_t)l * D * INW + 1536 + (valid ? n : 0); stride = INW; }
        else { const int col = 16 * nb4 + n; valid = col < 36;
            if (col < 4) { base = I.w_rg + (size_t)l * D * 4 + col; stride = 4; }
            else { const int cc = valid ? col - 4 : 0; base = I.w_re + ((size_t)(l * 4 + (cc >> 3)) * D) * 8 + (cc & 7); stride = 8; } }
        float v[8];
#pragma unroll
        for (int j = 0; j < 8; ++j) v[j] = base[(size_t)(k0 + j) * stride];
#pragma unroll
        for (int j = 0; j < 8; ++j) v[j] = valid ? v[j] : 0.f;
        unsigned hi[4], lo[4];
#pragma unroll
        for (int j = 0; j < 4; ++j) { hi[j] = pk2(v[2 * j], v[2 * j + 1]); lo[j] = pk2(v[2 * j] - bflo(hi[j]), v[2 * j + 1] - bfhi(hi[j])); }
        v4u* dst = (nb4 == 3) ? (v4u*)(ws + WS_FRF) + ((size_t)(l * 32 + c) * 2) * 64 + ln : (v4u*)(ws + WS_RRF) + (((size_t)(l * 32 + c) * 3 + nb4) * 2) * 64 + ln;
        dst[0] = (v4u){hi[0], hi[1], hi[2], hi[3]}; dst[64] = (v4u){lo[0], lo[1], lo[2], lo[3]};
      } }
    LAS float* scr = (LAS float*)(F.lds + RING_OFF + F.wave * 16384);
    const int gw = (F.G - 1 - F.vcu) * NWAVES + F.wave, NGW = F.G * NWAVES;
    constexpr int IT_IN = 512, IT_OUT = 128, IT_L = IT_IN + IT_OUT;
#ifndef TR_REPS
#define TR_REPS 1
#endif
#pragma nounroll
    for (int trp = 0; trp < TR_REPS; ++trp)
    for (int it = gw; it < NL * IT_L; it += NGW) {
        const int l = it / IT_L; int r = it - l * IT_L;
        if (r < IT_IN) { const int kb = r >> 5, nb = r & 31; const int n0 = 64 * nb;
            transpose_item64(I.w_in + (size_t)l * D * INW, INW, WinT + (size_t)l * 2048 * D, D, 64 * kb, n0 < 1536 ? n0 : n0 + 8, n0, scr, F.lane); continue; }
        r -= IT_IN;
        if (r < IT_OUT) { const int kb = r >> 4, nb = r & 15;
            transpose_item64(I.w_out + (size_t)l * D * D, D, WoutT + (size_t)l * D * D, D, 64 * kb, 64 * nb, 64 * nb, scr, F.lane); continue; }
    }
}

struct NormArgs {
    const float* xin; const bf16* xinb;
    bf16* xwb; float* out;
    const unsigned char* Y0; const unsigned char* Y1; const float* gate;
    const bf16* Dl;
    const float* gamma; const float* scale; const float* shift;
    bf16* H; const v4u* frag;
    const float* bias0; const float* bias1;
    float* FL; float* BT; float* CW; unsigned* LIST; gu32* cnt;
};
template <bool XBF, bool ADD_D, bool ADD_Y, bool WRITE_XB, int NB, bool FINAL>
__device__ __forceinline__ void norm_phase(Frame& F, const NormArgs& A) {
    constexpr int NBX = NB > 0 ? NB : 1, LGW = 16 * NBX;
    LAS float* gm = (LAS float*)F.lds; LAS float* shl = gm + 1024; LAS float* gtl = shl + 1024;
    LAS float* SSP = (LAS float*)(F.lds + 12288);
    LAS float* LGP = (LAS float*)(F.lds + 16384);
    LAS float* LGA = (LAS float*)(F.lds + 40960);
    LAS int* lcnt = (LAS int*)(F.lds + 65536); LAS int* gbase = lcnt + 32;
    const int tok0 = F.vcu * 128, b = tok0 >> 12;
    float tg_[2], tsc_[2], tsh_[2], tgt_[2];
#pragma unroll
    for (int j = 0; j < 2; ++j) { const int k = F.tid + NWAVES * 64 * j; tg_[j] = A.gamma[k]; tsc_[j] = FINAL ? 0.f : A.scale[(size_t)b * 6144 + k]; tsh_[j] = FINAL ? 0.f : A.shift[(size_t)b * 6144 + k];
        tgt_[j] = ADD_Y ? A.gate[(size_t)b * 6144 + k] : 0.f; }
    if (NB == 3 && F.tid < 32) lcnt[F.tid] = 0;
    const int i16 = F.lane & 15, kq = F.lane >> 4, kcol = 128 * F.wave + 8 * kq;
    bf16x8 Bh[NB > 0 ? 4 : 1][NBX], Bl[NB > 0 ? 4 : 1][NBX];
    if constexpr (NB > 0) {
#pragma unroll
        for (int c = 0; c < 4; ++c)
#pragma unroll
            for (int nb = 0; nb < NB; ++nb) { const size_t fi = ((size_t)((4 * F.wave + c) * NB + nb) * 2) * 64 + F.lane;
                Bh[c][nb] = __builtin_bit_cast(bf16x8, A.frag[fi]); Bl[c][nb] = __builtin_bit_cast(bf16x8, A.frag[fi + 64]); }
    }
    f32x4 xa[XBF ? 1 : 4][2], xn[XBF ? 1 : 4][2]; v4u xba[4], xbn[4], da[4], dn[4]; typedef unsigned v2u __attribute__((ext_vector_type(2))); v2u ya[2][4], yn[2][4];
#define NORM_LOAD(dst, bdst, ydst, ddst, it_) do { const size_t ro_ = (size_t)(tok0 + 16 * (it_) + i16) * D + kcol; \
        _Pragma("unroll") for (int c = 0; c < 4; ++c) { \
            if constexpr (XBF) bdst[c] = *(const v4u*)(A.xinb + ro_ + 32 * c); \
            else { dst[c][0] = *(const f32x4*)(A.xin + ro_ + 32 * c); dst[c][1] = *(const f32x4*)(A.xin + ro_ + 32 * c + 4); } \
            if (ADD_D) ddst[c] = *(const v4u*)(A.Dl + ro_ + 32 * c); \
            if (ADD_Y) { ydst[0][c] = *(const v2u*)(A.Y0 + ro_ + 32 * c); ydst[1][c] = *(const v2u*)(A.Y1 + ro_ + 32 * c); } } } while (0)
#define NORM_STEP(XA_, XBA_, YA_, DA_, IT_) do { \
        const size_t ro = (size_t)(tok0 + 16 * (IT_) + i16) * D + kcol; \
        f32x4 xv[4][2]; \
        float ss = 0.f; \
_Pragma("unroll") \
        for (int c = 0; c < 4; ++c) { \
            f32x4 a0, a1; \
            if constexpr (XBF) { const v4u xb = XBA_[c]; a0 = (f32x4){bflo(xb.x), bfhi(xb.x), bflo(xb.y), bfhi(xb.y)}; a1 = (f32x4){bflo(xb.z), bfhi(xb.z), bflo(xb.w), bfhi(xb.w)}; } \
            else { a0 = XA_[c][0]; a1 = XA_[c][1]; } \
            if (ADD_D) { const v4u d = DA_[c]; \
                a0[0] += bflo(d.x); a0[1] += bfhi(d.x); a0[2] += bflo(d.y); a0[3] += bfhi(d.y); a1[0] += bflo(d.z); a1[1] += bfhi(d.z); a1[2] += bflo(d.w); a1[3] += bfhi(d.w); } \
            if (ADD_Y) { const f32x4 g0 = *(const LAS f32x4*)(gtl + kcol + 32 * c), g1 = *(const LAS f32x4*)(gtl + kcol + 32 * c + 4); const v2u y0 = YA_[0][c], y1 = YA_[1][c]; typedef float f32x2u __attribute__((ext_vector_type(2))); \
                const f32x2u p0 = __builtin_amdgcn_cvt_pk_f32_fp8((int)y0[0], false) + __builtin_amdgcn_cvt_pk_f32_fp8((int)y1[0], false), p1 = __builtin_amdgcn_cvt_pk_f32_fp8((int)y0[0], true) + __builtin_amdgcn_cvt_pk_f32_fp8((int)y1[0], true); \
                const f32x2u p2 = __builtin_amdgcn_cvt_pk_f32_fp8((int)y0[1], false) + __builtin_amdgcn_cvt_pk_f32_fp8((int)y1[1], false), p3 = __builtin_amdgcn_cvt_pk_f32_fp8((int)y0[1], true) + __builtin_amdgcn_cvt_pk_f32_fp8((int)y1[1], true); \
                a0[0] += g0[0] * p0[0]; a0[1] += g0[1] * p0[1]; a0[2] += g0[2] * p1[0]; a0[3] += g0[3] * p1[1]; a1[0] += g1[0] * p2[0]; a1[1] += g1[1] * p2[1]; a1[2] += g1[2] * p3[0]; a1[3] += g1[3] * p3[1]; } \
            if (WRITE_XB) { v4u xo; xo.x = cvtpk(a0[0], a0[1]); xo.y = cvtpk(a0[2], a0[3]); xo.z = cvtpk(a1[0], a1[1]); xo.w = cvtpk(a1[2], a1[3]); *(v4u*)(A.xwb + ro + 32 * c) = xo; } \
            xv[c][0] = a0; xv[c][1] = a1; \
            ss += (a0[0] * a0[0] + a0[1] * a0[1]) + (a0[2] * a0[2] + a0[3] * a0[3]) + (a1[0] * a1[0] + a1[1] * a1[1]) + (a1[2] * a1[2] + a1[3] * a1[3]); \
        } \
        { auto r16_ = __builtin_amdgcn_permlane16_swap(__float_as_uint(ss), __float_as_uint(ss), false, false); ss = __uint_as_float(r16_[0]) + __uint_as_float(r16_[1]); \
          auto r32_ = __builtin_amdgcn_permlane32_swap(__float_as_uint(ss), __float_as_uint(ss), false, false); ss = __uint_as_float(r32_[0]) + __uint_as_float(r32_[1]); }     \
        LAS float* ssp = SSP + ((IT_) & 1) * 128; \
        if (kq == 0) ssp[F.wave * 16 + i16] = ss; \
        __syncthreads(); \
        float tot = 0.f; \
_Pragma("unroll") \
        for (int w = 0; w < 8; ++w) tot += ssp[w * 16 + i16]; \
        const float rstd = 1.0f / sqrtf(tot * (1.0f / D) + RMS_EPS); \
        f32x4 acc[NBX]; \
_Pragma("unroll") \
        for (int nb = 0; nb < NBX; ++nb) acc[nb] = (f32x4){0.f, 0.f, 0.f, 0.f}; \
_Pragma("unroll") \
        for (int c = 0; c < 4; ++c) { \
            const f32x4 m0 = *(const LAS f32x4*)(gm + kcol + 32 * c), m1 = *(const LAS f32x4*)(gm + kcol + 32 * c + 4); \
            const f32x4 s0 = *(const LAS f32x4*)(shl + kcol + 32 * c), s1 = *(const LAS f32x4*)(shl + kcol + 32 * c + 4); \
            const f32x4 h0 = xv[c][0] * rstd * m0 + s0, h1 = xv[c][1] * rstd * m1 + s1; \
            if (FINAL) { *(f32x4*)(A.out + ro + 32 * c) = h0; *(f32x4*)(A.out + ro + 32 * c + 4) = h1; } \
            else { \
                v4u hi; hi.x = cvtpk(h0[0], h0[1]); hi.y = cvtpk(h0[2], h0[3]); hi.z = cvtpk(h1[0], h1[1]); hi.w = cvtpk(h1[2], h1[3]); \
                *(v4u*)(A.H + ro + 32 * c) = hi; \
                if constexpr (NB > 0) { \
                    v4u lo; lo.x = cvtpk(h0[0] - bflo(hi.x), h0[1] - bfhi(hi.x)); lo.y = cvtpk(h0[2] - bflo(hi.y), h0[3] - bfhi(hi.y)); \
                    lo.z = cvtpk(h1[0] - bflo(hi.z), h1[1] - bfhi(hi.z)); lo.w = cvtpk(h1[2] - bflo(hi.w), h1[3] - bfhi(hi.w)); \
                    const bf16x8 Ah = __builtin_bit_cast(bf16x8, hi), Al = __builtin_bit_cast(bf16x8, lo); \
_Pragma("unroll") \
                    for (int nb = 0; nb < NB; ++nb) { \
                        acc[nb] = __builtin_amdgcn_mfma_f32_16x16x32_bf16(Ah, Bh[c][nb], acc[nb], 0, 0, 0); \
                        acc[nb] = __builtin_amdgcn_mfma_f32_16x16x32_bf16(Al, Bh[c][nb], acc[nb], 0, 0, 0); \
                        acc[nb] = __builtin_amdgcn_mfma_f32_16x16x32_bf16(Ah, Bl[c][nb], acc[nb], 0, 0, 0); } \
                } \
            } \
        } \
        if constexpr (NB > 0) { \
_Pragma("unroll") \
            for (int nb = 0; nb < NB; ++nb) \
_Pragma("unroll") \
                for (int r = 0; r < 4; ++r) LGP[(F.wave * 16 + 4 * kq + r) * LGW + 16 * nb + i16] = acc[nb][r]; \
            __syncthreads(); \
            for (int q = F.tid; q < 16 * LGW; q += NWAVES * 64) { float s = 0.f; \
_Pragma("unroll") \
                for (int w = 0; w < 8; ++w) s += LGP[w * 16 * LGW + q]; \
                LGA[(IT_) * 16 * LGW + q] = s; } \
        } \
    } while (0)
    NORM_LOAD(xa, xba, ya, da, 0);
#pragma unroll
    for (int j = 0; j < 2; ++j) { const int k = F.tid + NWAVES * 64 * j; gm[k] = FINAL ? tg_[j] : tg_[j] * (1.f + tsc_[j]); shl[k] = tsh_[j];
        if (ADD_Y) gtl[k] = tgt_[j] * (1.0f / 16.0f); }
    __syncthreads();
#pragma nounroll
    for (int it = 0; it < 8; it += 2) {
        NORM_LOAD(xn, xbn, yn, dn, it + 1);
        NORM_STEP(xa, xba, ya, da, it);
        NORM_LOAD(xa, xba, ya, da, (it + 2 < 8 ? it + 2 : 7));
        NORM_STEP(xn, xbn, yn, dn, it + 1);
    }
#undef NORM_STEP
#undef NORM_LOAD
    __syncthreads();
    if constexpr (NB == 1) {
        const int hh = F.wave, r0 = 2 * F.lane;
        const float bb = A.bias0[hh]; const float z0 = LGA[r0 * LGW + hh] + bb, z1 = LGA[(r0 + 1) * LGW + hh] + bb;
        const float v0 = fminf(z0, 0.f) - log1pf(__expf(-fabsf(z0))), v1 = fminf(z1, 0.f) - log1pf(__expf(-fabsf(z1)));
        float sc = v0 + v1;
#define NP_DPPF(V, CTRL, RM) __builtin_bit_cast(float, __builtin_amdgcn_update_dpp(0, __builtin_bit_cast(int, V), CTRL, RM, 0xf, true))
        sc += NP_DPPF(sc, 0x111, 0xf); sc += NP_DPPF(sc, 0x112, 0xf); sc += NP_DPPF(sc, 0x114, 0xf); sc += NP_DPPF(sc, 0x118, 0xf);
        sc += NP_DPPF(sc, 0x142, 0xa); sc += NP_DPPF(sc, 0x143, 0xc);
#undef NP_DPPF
        const float ex = sc - (v0 + v1); const float L2E = 1.4426950408889634f;
        typedef float f32x2n __attribute__((ext_vector_type(2)));
        *(f32x2n*)(A.FL + ((size_t)(b * 8 + hh) << 12) + (tok0 & (SEQ - 1)) + r0) = (f32x2n){(ex + v0) * L2E, (ex + v0 + v1) * L2E};
        if (F.lane == 63) A.BT[(b * 8 + hh) * 32 + ((tok0 & (SEQ - 1)) >> 7)] = sc * L2E;
    }
    if constexpr (NB == 3) {
        int e0 = 0, e1 = 0, r0 = 0, r1 = 0; float w0 = 0.f, w1 = 0.f;
        if (F.tid < 128) {
            const LAS float* row = LGA + F.tid * LGW;
            const float l0 = row[0] + A.bias0[0], l1 = row[1] + A.bias0[1], l2 = row[2] + A.bias0[2], l3 = row[3] + A.bias0[3];
            int g = 0; float mx = l0; if (l1 > mx) { mx = l1; g = 1; } if (l2 > mx) { mx = l2; g = 2; } if (l3 > mx) { mx = l3; g = 3; }
            const float top_p = 1.f / (__expf(l0 - mx) + __expf(l1 - mx) + __expf(l2 - mx) + __expf(l3 - mx));
            float v1 = -INFINITY, v2 = -INFINITY; int i1 = 0, i2 = 0;
#pragma unroll
            for (int j = 0; j < 8; ++j) { const float v = row[4 + 8 * g + j] + A.bias1[8 * g + j];
                if (v > v1) { v2 = v1; i2 = i1; v1 = v; i1 = j; } else if (v > v2) { v2 = v; i2 = j; } }
            const float e21 = __expf(v2 - v1), ew1 = 1.f / (1.f + e21);
            w0 = top_p * ew1; w1 = top_p * (e21 * ew1); e0 = 8 * g + i1; e1 = 8 * g + i2;
            r0 = __hip_atomic_fetch_add(lcnt + e0, 1, __ATOMIC_RELAXED, __HIP_MEMORY_SCOPE_WORKGROUP);
            r1 = __hip_atomic_fetch_add(lcnt + e1, 1, __ATOMIC_RELAXED, __HIP_MEMORY_SCOPE_WORKGROUP);
        }
        __syncthreads();
        if (F.tid < 32) gbase[F.tid] = (int)__hip_atomic_fetch_add(A.cnt + 64 * F.tid, (unsigned)lcnt[F.tid], __ATOMIC_RELAXED, __HIP_MEMORY_SCOPE_AGENT);
        __syncthreads();
        if (F.tid < 128) { const int tk = tok0 + F.tid;
            A.LIST[(size_t)e0 * T + gbase[e0] + r0] = 2u * tk; A.LIST[(size_t)e1 * T + gbase[e1] + r1] = 2u * tk + 1u;
            A.CW[2 * tk] = w0; A.CW[2 * tk + 1] = w1; }
    }
    __syncthreads();
}

struct Args { In in; float* out; unsigned char* ws; int ph_lo, ph_hi; };
typedef const __attribute__((address_space(4))) Args* KArgP;
__device__ __forceinline__ KArgP KA() { KArgP p = (KArgP)__builtin_amdgcn_kernarg_segment_ptr(); asm volatile("" : "+s"(p)); return p; }
#define WSP   (KA()->ws)
#define XRES  (KA()->out)
#define MODP  ((float*)(WSP + WS_MOD))
#define HB    ((bf16*)(WSP + WS_H))
#define QB_   ((bf16*)(WSP + WS_QKVU))
#define YB    ((unsigned char*)(WSP + WS_QKVU))
#define AOB   ((bf16*)(WSP + WS_AO))
#define ACTB  ((bf16*)(WSP + WS_AO))
#define FLP   ((float*)(WSP + WS_FL))
#define FCP   ((float*)(WSP + WS_FC))
#define CWP   ((float*)(WSP + WS_CW))
#define LISTP ((unsigned*)(WSP + WS_LIST))
#define CTLP  ((gu32*)(WSP + WS_CTL))
#define DLB   ((bf16*)(WSP + WS_DL))
#define XBB   ((bf16*)(WSP + WS_XB))
struct PoolDiff {
    Frame& F; const bf16* U; bf16* AO; v4u la[9], lb[9]; int steps;
    __device__ __forceinline__ void load(v4u (&ld)[9], const int half) { const int t0 = blk * 128, pos0 = t0 & (SEQ - 1);
#pragma unroll
        for (int j = 0; j < 9; ++j) { const int p = F.tid + 512 * j; const int r = p >> 5, cc = p & 31; v4u v = (v4u){0u, 0u, 0u, 0u};
            if (p < 143 * 32 && pos0 - 15 + r >= 0) v = *(const v4u*)(U + (size_t)(t0 - 15 + r) * 512 + half * 256 + 8 * cc);
            ld[j] = v; } }
    __device__ __forceinline__ void half_pass(const v4u (&ld)[9], const int half) { const int t0 = blk * 128, pos0 = t0 & (SEQ - 1);
        LAS v4u* tile = (LAS v4u*)F.lds;
#pragma unroll
        for (int j = 0; j < 9; ++j) { const int p = F.tid + 512 * j; if (p < 143 * 32) tile[p] = ld[j]; }
        __syncthreads();
        const int cc = F.tid & 31, tl0 = 8 * (F.tid >> 5); const int w = 2 << ((half * 32 + cc) >> 4);
        float sum[8];
#pragma unroll
        for (int q = 0; q < 8; ++q) sum[q] = 0.f;
#define POOL_ACC(V, SGN) do { sum[0] += SGN bflo((V).x); sum[1] += SGN bfhi((V).x); sum[2] += SGN bflo((V).y); sum[3] += SGN bfhi((V).y); sum[4] += SGN bflo((V).z); sum[5] += SGN bfhi((V).z); sum[6] += SGN bflo((V).w); sum[7] += SGN bfhi((V).w); } while (0)
        for (int d = 1; d < w; ++d) { const v4u v = tile[(15 + tl0 - d) * 32 + cc]; POOL_ACC(v, +); }
#pragma unroll 2
        for (int j = 0; j < 8; ++j) { const int tl = tl0 + j, pos = pos0 + tl;
            const v4u v = tile[(15 + tl) * 32 + cc]; POOL_ACC(v, +);
            const float rc = 1.0f / (float)((pos + 1) < w ? (pos + 1) : w);
            v4u o; o.x = pk2(sum[0] * rc - bflo(v.x), sum[1] * rc - bfhi(v.x)); o.y = pk2(sum[2] * rc - bflo(v.y), sum[3] * rc - bfhi(v.y));
            o.z = pk2(sum[4] * rc - bflo(v.z), sum[5] * rc - bfhi(v.z)); o.w = pk2(sum[6] * rc - bflo(v.w), sum[7] * rc - bfhi(v.w));
            *(v4u*)(AO + (size_t)(t0 + tl) * D + 512 + half * 256 + 8 * cc) = o;
            const v4u u = tile[(15 + tl - (w - 1)) * 32 + cc]; POOL_ACC(u, -); }
#undef POOL_ACC
        __syncthreads(); }
    int blk;
    __device__ __forceinline__ void block(const int it) { blk = it; load(la, 0); load(lb, 1); half_pass(la, 0); half_pass(lb, 1); }
    int l;
    __device__ __forceinline__ void convert() {
        const In& I = *(const In*)(const void*)(&KA()->in);
        bf16* WguT = (bf16*)(WSP + WS_WGU); bf16* WdT = (bf16*)(WSP + WS_WD);
        int t_ = threadIdx.x; asm volatile("" : "+v"(t_));
        const int lane_ = t_ & 63, wave_ = __builtin_amdgcn_readfirstlane(t_ >> 6);
        LAS float* scr = (LAS float*)(F.lds + RING_OFF + wave_ * 16384);
        constexpr int IT_E = 2048;
        struct Item { const float* W; int ldw; bf16* WT; int ldt, k0, n0src, dstrow0; };
        auto item = [&](int j) -> Item { int r = (F.vcu + 256 * j) * NWAVES + wave_;
            if (r < 2 * IT_E) { const int up = r >= IT_E; if (up) r -= IT_E; const int e = r >> 6, q = r & 63, kb = q >> 2, nb = q & 3, n0 = 64 * nb;
                return Item{(up ? I.w_eu : I.w_eg) + (size_t)(l * NX + e) * D * FE, FE, WguT + (size_t)(l * NX + e) * 512 * D, D, 64 * kb, n0, 256 * (n0 >> 7) + (n0 & 127) + (up ? 128 : 0)}; }
            r -= 2 * IT_E; const int e = r >> 6, q = r & 63, kb = q >> 4, nb = q & 15;
            return Item{I.w_ed + (size_t)(l * NX + e) * FE * D, D, WdT + (size_t)(l * NX + e) * D * FE, FE, 64 * kb, 64 * nb, 64 * nb}; };
        f32x4 va[16], vb[16];
        const Item i0 = item(0), i1 = item(1), i2 = item(2);
        transpose_load64(va, i0.W, i0.ldw, i0.k0, i0.n0src, lane_);
        transpose_load64(vb, i1.W, i1.ldw, i1.k0, i1.n0src, lane_);
        asm volatile("" ::: "memory"); __builtin_amdgcn_sched_barrier(0);
        transpose_finish64(va, i0.WT, i0.ldt, i0.k0, i0.dstrow0, scr, lane_);
        transpose_load64(va, i2.W, i2.ldw, i2.k0, i2.n0src, lane_);
        asm volatile("" ::: "memory"); __builtin_amdgcn_sched_barrier(0);
        transpose_finish64(vb, i1.WT, i1.ldt, i1.k0, i1.dstrow0, scr, lane_);
        transpose_finish64(va, i2.WT, i2.ldt, i2.k0, i2.dstrow0, scr, lane_);
        __syncthreads();
    }
};
template <bool WITH_CW>
__device__ __forceinline__ void moe_tables(Frame& F, pg8::MoeSched& S, int l, int npn, const char* W, size_t estride, size_t pnstride, const unsigned* LIST, const float* CW) {
    LAS unsigned* ent = (LAS unsigned*)(F.lds + ENT_OFF); LAS float* cwt = (LAS float*)(F.lds + CWT_OFF);
    LAS int* tstart = (LAS int*)(F.lds + TST_OFF); LAS int* cntl = tstart + 33; LAS int* ut = cntl + 32; LAS int* nun = ut + 4 * ENT_UNITS;
    unsigned* const pubp = (unsigned*)(CTLP + CW_TIL + l * TIL_STRIDE);
    if (F.wave == 0) {
        const int ln = F.lane; unsigned c = 0u;
        if (ln < 32) { c = __hip_atomic_load(CTLP + CW_CNT + 64 * (l * 32 + ln), RLX_AGENT); c = c < (unsigned)T ? c : (unsigned)T; }
        const int tl = (int)((c + 255u) >> 8); int inc = tl;
        inc += __builtin_amdgcn_update_dpp(0, inc, 0x111, 0xf, 0xf, true); inc += __builtin_amdgcn_update_dpp(0, inc, 0x112, 0xf, 0xf, true); inc += __builtin_amdgcn_update_dpp(0, inc, 0x114, 0xf, 0xf, true);
        inc += __builtin_amdgcn_update_dpp(0, inc, 0x118, 0xf, 0xf, true); inc += __builtin_amdgcn_update_dpp(0, inc, 0x142, 0xa, 0xf, true);
        if (ln < 32) { cntl[ln] = (int)c; tstart[ln] = inc - tl; }
        if (ln == 31) tstart[32] = inc;
        const int ntile = __builtin_amdgcn_readlane(inc, 31);
        int tix = -1;
        if (ln < ENT_UNITS) {
            const int i = ln, G = F.G, cc = F.vcu, total = ntile * npn; int L = i * G + cc;
            if (!WITH_CW) { const int nlate = (ntile * 2) % G, ne = G - nlate, hs = (ne >= G / 2) ? 4 : 0;
                if (hs) L = cc >= nlate ? (i < hs ? i * ne + (cc - nlate) : hs * ne + (i - hs) * G + cc) : hs * ne + i * G + cc; }
            int e = 0, pn = 0, nrows = 0;
            if (L < total) { tix = L / npn; pn = L - tix * npn;
#pragma unroll
                for (int sft = 16; sft >= 1; sft >>= 1) if (tstart[e + sft] <= tix) e += sft;
                const int left = cntl[e] - (tix - tstart[e]) * 256; nrows = left < 256 ? left : 256; }
            ut[4 * i] = e; ut[4 * i + 1] = pn; ut[4 * i + 2] = nrows; ut[4 * i + 3] = tix;
        }
        const int n = __builtin_popcountll(__ballot(tix >= 0));
        unsigned rdy = 0u;
        if (!WITH_CW) {
            unsigned pc = 0u;
            if (tix >= 0) pc = __hip_atomic_load(pubp + 64 * tix, __ATOMIC_RELAXED, __HIP_MEMORY_SCOPE_AGENT);
            rdy = (unsigned)__ballot(tix >= 0 && pc >= 16u);
            __builtin_amdgcn_fence(__ATOMIC_ACQUIRE, "agent"); asm volatile("s_waitcnt vmcnt(0)" ::: "memory");
        }
        if (ln == 0) { nun[0] = n; nun[1] = (int)rdy; }
    }
    __syncthreads();
    S.ut = ut; S.nunits = nun[0]; S.rdy = WITH_CW ? 0u : (unsigned)nun[1]; S.W = W; S.estride = estride; S.pnstride = pnstride;
    S.pub = pubp; S.tmo = (unsigned*)(CTLP + CW_TMO);
    {
        constexpr int NJ = WITH_CW ? 2 : 4;
        unsigned en[NJ]; float cw[NJ];
#pragma unroll
        for (int j = 0; j < NJ; ++j) { const int q = F.tid + NWAVES * 64 * j, i = q >> 8, r = q & 255, ii = i < S.nunits ? i : 0;
            const int e = ut[4 * ii], nrows = ut[4 * ii + 2], r0 = (ut[4 * ii + 3] - tstart[e]) * 256;
            en[j] = LIST[(size_t)e * T + r0 + (r < nrows ? r : 0)]; }
        if (WITH_CW) {
#pragma unroll
            for (int j = 0; j < NJ; ++j) cw[j] = CW[en[j]];
        }
#pragma unroll
        for (int j = 0; j < NJ; ++j) { const int q = F.tid + NWAVES * 64 * j;
            if ((q >> 8) < S.nunits) { ent[q] = en[j]; if (WITH_CW) { if (q < 3 * 256) cwt[q] = cw[j]; } } }
    }
    __syncthreads();
}
__global__ void __launch_bounds__(NWAVES * 64, 2) mk_fwd(Args args_unused) {
    extern __shared__ __attribute__((aligned(16))) unsigned char lds[];
    Frame F;
    F.lds = (LAS unsigned char*)lds;
    F.MISC = (volatile LAS unsigned*)(F.lds + MISC_OFF);
    F.tid = threadIdx.x; F.lane = F.tid & 63; F.wave = __builtin_amdgcn_readfirstlane(F.tid >> 6);
    F.G = gridDim.x; { const int bx = blockIdx.x; F.vcu = (F.G % 8 == 0) ? (bx % 8) * (F.G / 8) + bx / 8 : bx; }
    F.ctl = (gu32*)(KA()->ws + WS_CTL);
    for (int u = F.tid; u < (LDS_BYTES - LDSCTL_OFF) / 4; u += NWAVES * 64) ((LAS unsigned*)(F.lds + LDSCTL_OFF))[u] = 0u;
    __syncthreads();
    XcdBarrier bar; bar.bar = (unsigned*)(F.ctl + CW_BAR); bar.x = 0; bar.st = nullptr;
    if (!MK_PER_PHASE) bar = xcd_barrier_post((unsigned*)(F.ctl + CW_BAR), F.MISC + 8);
#define GRID_BAR() do { if (!MK_PER_PHASE) { XcdBarrier b_ = bar; unsigned* p_ = b_.bar; unsigned x_ = b_.x; asm volatile("" : "+s"(p_), "+s"(x_)); b_.bar = p_; b_.x = x_; xcd_barrier(b_); } } while (0)
    const int lo = KA()->ph_lo, hi = KA()->ph_hi;
#ifndef PHASE_MASK
#define PHASE_MASK 0xFFFF
#endif
#define IN(k) ((((PHASE_MASK) >> ((k) > 7 && (k) < 15 ? (k) - 7 : (k))) & 1) && lo <= (k) && (k) < hi)
#ifndef PROBE_MODE
#define PROBE_MODE 0
#endif
#ifndef REPEAT_MASK
#define REPEAT_MASK 0
#endif
#define RPT(k, cond) _Pragma("nounroll") for (int rp_ = 0, nr_ = ((((REPEAT_MASK) >> (k)) & 1) && (cond)) ? 2 : 1; rp_ < nr_; ++rp_)
#ifndef TIME_A
#define TIME_A -1
#endif
#ifndef TIME_B
#define TIME_B -1
#endif
    unsigned long long tA_ = 0, tB_ = 0;
    if (TIME_B >= 0 && TIME_A < 0) tA_ = __builtin_amdgcn_s_memrealtime();
#define SEAM(k) do { if (IN(k) && IN((k) + 1)) GRID_BAR(); if (TIME_B >= 0) { if ((k) == TIME_A) tA_ = __builtin_amdgcn_s_memrealtime(); if ((k) == TIME_B) tB_ = __builtin_amdgcn_s_memrealtime(); } } while (0)
#define PHASE_BEGIN() do { int w_ = F.wave, v_ = F.vcu, g_ = F.G; int ln_ = (int)__builtin_amdgcn_mbcnt_hi(~0u, __builtin_amdgcn_mbcnt_lo(~0u, 0u)); asm volatile("" : "+v"(ln_), "+v"(w_), "+v"(v_), "+v"(g_)); \
        F.wave = __builtin_amdgcn_readfirstlane(w_); F.vcu = __builtin_amdgcn_readfirstlane(v_); F.G = __builtin_amdgcn_readfirstlane(g_); F.lane = ln_; F.tid = F.wave * 64 + ln_; } while (0)
#ifndef EXTRA_BARS
#define EXTRA_BARS 0
#endif
    for (int xb_ = 0; xb_ < EXTRA_BARS; ++xb_) GRID_BAR();
#if PROBE_STEPS
    const unsigned long long pk0_ = __builtin_amdgcn_s_memrealtime();
#endif
    if (IN(0)) { PHASE_BEGIN(); RPT(0, true) { if (rp_) GRID_BAR(); const In I = *(const In*)(const void*)(&KA()->in); p0_prologue(F, I, WSP, 0); }
#if PROBE_STEPS
        if (((PROBE_STEPS >= 16 && PROBE_STEPS <= 18) || (PROBE_STEPS == 19 && F.vcu < 64) || (PROBE_STEPS == 22 && F.vcu >= 64 && F.vcu < 96) || (PROBE_STEPS == 25 && F.vcu >= 96)) && F.tid == 0) { const unsigned d_ = (unsigned)((__builtin_amdgcn_s_memrealtime() - pk0_) / 10ull);
            __hip_atomic_fetch_max((unsigned*)(CTLP + 8), d_, RLX_AGENT); __hip_atomic_fetch_add((unsigned*)(CTLP + 9), 2u * d_, RLX_AGENT); __hip_atomic_fetch_max((unsigned*)(CTLP + 10), 100000u - d_, RLX_AGENT); }
#endif
        SEAM(0); }

#pragma nounroll
    for (int l = 0; l < NL; ++l) {
        const int pb = 1 + 7 * l;
        if (IN(pb + 0)) { PHASE_BEGIN();
            const float* modl = MODP + (size_t)l * 8 * 6144;
            NormArgs A{}; A.gamma = KA()->in.g_mix + l * D; A.scale = modl + 1024; A.shift = modl; A.H = HB; A.frag = (const v4u*)(WSP + WS_FRF) + (size_t)l * 32 * 2 * 64;
            A.bias0 = KA()->in.b_fg + l * 8; A.FL = FCP; A.BT = FLP;
            A.xwb = XBB;
            if (l == 0) { A.xin = KA()->in.x; RPT(1, true) { if (rp_) GRID_BAR(); norm_phase<false, false, false, true, 1, false>(F, A); } }
            else { A.xinb = DLB; A.Y0 = YB; A.Y1 = YB + (size_t)T * D; A.gate = MODP + (size_t)(l - 1) * 8 * 6144 + 5120; RPT(5, true) { if (rp_) GRID_BAR(); norm_phase<true, false, true, true, 1, false>(F, A); } }
            SEAM(pb + 0);
        }
        if (IN(pb + 1)) { PHASE_BEGIN();
            pg8::Gemm g{HB, (const bf16*)(WSP + WS_WIN) + (size_t)l * 2048 * D, T, 2048, D}; pg8::StaticOrder S; S.init(T, 2048, F.G, (int)blockIdx.x);
            pg8::EpiQKVU E{QB_, 512, 512, (size_t)T * 512, attn_body::C2, (unsigned*)(CTLP + CW_NRM + l * NRM_WORDS)};
            RPT(2, true) { if (rp_) GRID_BAR(); pg8::gemm_phase<pg8::EpiQKVU, pg8::StaticOrder, true, true>(F.lds + RING_OFF, g, S, E); }
            SEAM(pb + 1);
        }
        if (IN(pb + 2)) { PHASE_BEGIN();
            PoolDiff PD{F, QB_ + (size_t)3 * T * 512, AOB}; PD.l = l;
#if PROBE_STEPS
            const unsigned long long pt0_ = __builtin_amdgcn_s_memrealtime();
#endif
            const attn_body::AttnBase AB{(const char*)WSP, WS_QKVU, WS_QKVU + (size_t)T * 512 * 2, WS_QKVU + (size_t)2 * T * 512 * 2, WS_AO, WS_FC, WS_FL, WS_CTL + (size_t)(CW_NRM + l * NRM_WORDS) * 4, WS_CTL + (size_t)(CW_QAT + 64 * (l * 8)) * 4, WS_CTL + (size_t)(CW_PQ + 64 * l) * 4};
            attn_body::attn_phase<32>((char*)lds + RING_OFF, AB, F.vcu, F.tid, PD);
#if PROBE_STEPS
            if (PROBE_STEPS >= 4 && PROBE_STEPS <= 6) PD.steps = (int)((__builtin_amdgcn_s_memrealtime() - pt0_) / 100ull);
            if (PROBE_STEPS < 10 && F.tid == 0) { __hip_atomic_fetch_max((unsigned*)(CTLP + 8), (unsigned)PD.steps, RLX_AGENT); __hip_atomic_fetch_add((unsigned*)(CTLP + 9), (unsigned)PD.steps, RLX_AGENT); __hip_atomic_fetch_max((unsigned*)(CTLP + 10), (unsigned)(100000 - PD.steps), RLX_AGENT); }
#endif
            SEAM(pb + 2);
        }
        if (IN(pb + 3)) { PHASE_BEGIN();
            pg8::Gemm g{AOB, (const bf16*)(WSP + WS_WOUT) + (size_t)l * D * D, T, D, D}; pg8::StaticOrder S; S.init(T, D, F.G, (int)blockIdx.x);
            pg8::EpiMid E{DLB, XBB, MODP + (size_t)l * 8 * 6144 + 2048, 6144};
            RPT(4, true) { if (rp_) GRID_BAR(); pg8::gemm_phase<pg8::EpiMid, pg8::StaticOrder, true, true>(F.lds + RING_OFF, g, S, E); }
            SEAM(pb + 3);
        }
        if (IN(pb + 4)) { PHASE_BEGIN();
            const float* modl = MODP + (size_t)l * 8 * 6144;
            NormArgs A{}; A.xinb = DLB; A.gamma = KA()->in.g_ffn + l * D; A.scale = modl + 4096; A.shift = modl + 3072; A.H = HB;
            A.frag = (const v4u*)(WSP + WS_RRF) + (size_t)l * 32 * 3 * 2 * 64; A.bias0 = KA()->in.b_rg + l * 4; A.bias1 = KA()->in.b_re + l * 32; A.CW = CWP; A.LIST = LISTP; A.cnt = CTLP + CW_CNT + 64 * (l * 32);
            norm_phase<true, false, false, false, 3, false>(F, A);
            SEAM(pb + 4);
        }
#if PROBE_STEPS
        unsigned long long mt0_ = 0ull;
#endif
        if (IN(pb + 5)) { PHASE_BEGIN();
#if PROBE_STEPS
            mt0_ = __builtin_amdgcn_s_memrealtime();
#endif
            pg8::MoeSched S; moe_tables<true>(F, S, l, 2, (const char*)(WSP + WS_WGU) + (size_t)l * NX * 512 * D * 2, (size_t)512 * D * 2, (size_t)256 * D * 2, LISTP, CWP);
            LAS unsigned* ent = (LAS unsigned*)(F.lds + ENT_OFF); LAS float* cwt = (LAS float*)(F.lds + CWT_OFF);
            pg8::EpiAct E{ACTB, ent, cwt}; RPT(6, true) { if (rp_) GRID_BAR(); pg8::gemm_phase_moe<1, true, false, pg8::EpiAct, pg8::MoeSched>(F.lds + RING_OFF, HB, D, ent, S, E); }
#if PROBE_STEPS
            if (PROBE_STEPS == 13 && F.tid == 0) __hip_atomic_fetch_add((unsigned*)(CTLP + 9), (unsigned)((__builtin_amdgcn_s_memrealtime() - mt0_) / 100ull), RLX_AGENT);
#endif
        }
        if (IN(pb + 6)) { PHASE_BEGIN();
            pg8::MoeSched S; moe_tables<false>(F, S, l, 4, (const char*)(WSP + WS_WD) + (size_t)l * NX * D * FE * 2, (size_t)D * FE * 2, (size_t)256 * FE * 2, LISTP, CWP);
            LAS unsigned* ent = (LAS unsigned*)(F.lds + ENT_OFF);
            pg8::EpiY E{YB, (size_t)T * D, ent}; RPT(7, true) { if (rp_) GRID_BAR(); pg8::gemm_phase_moe<0, false, true, pg8::EpiY, pg8::MoeSched>(F.lds + RING_OFF, ACTB, FE, ent, S, E); }
#if PROBE_STEPS
            if (PROBE_STEPS >= 10 && PROBE_STEPS <= 12 && F.tid == 0) { const unsigned d_ = (unsigned)((__builtin_amdgcn_s_memrealtime() - mt0_) / 100ull);
                __hip_atomic_fetch_max((unsigned*)(CTLP + 8), d_, RLX_AGENT); __hip_atomic_fetch_add((unsigned*)(CTLP + 9), d_, RLX_AGENT); __hip_atomic_fetch_max((unsigned*)(CTLP + 10), 100000u - d_, RLX_AGENT); }
#endif
            SEAM(pb + 6);
        }
    }
    if (IN(NPH - 1)) { PHASE_BEGIN();
        NormArgs A{}; A.xinb = DLB; A.out = XRES; A.Y0 = YB; A.Y1 = YB + (size_t)T * D; A.gate = MODP + (size_t)(NL - 1) * 8 * 6144 + 5120; A.gamma = KA()->in.g_fin;
        norm_phase<true, false, true, false, 0, true>(F, A);
    }
#if PROBE_STEPS
    __syncthreads();
    if (F.vcu == 0 && F.tid == 0) { const unsigned mx = __hip_atomic_load((unsigned*)(CTLP + 8), RLX_AGENT), sm = __hip_atomic_load((unsigned*)(CTLP + 9), RLX_AGENT), mn = __hip_atomic_load((unsigned*)(CTLP + 10), RLX_AGENT);
        const float v = (PROBE_STEPS == 1 || PROBE_STEPS == 4 || PROBE_STEPS == 10 || PROBE_STEPS == 16 || PROBE_STEPS == 19 || PROBE_STEPS == 22 || PROBE_STEPS == 25) ? (float)mx : (PROBE_STEPS == 2 || PROBE_STEPS == 5 || PROBE_STEPS == 7 || PROBE_STEPS == 8 || PROBE_STEPS == 11 || PROBE_STEPS == 13 || PROBE_STEPS == 17) ? (float)sm * (1.0f / 512.0f) : (float)(100000u - mn); XRES[0] = 1000.f * (float)(((int)(v + 0.5f) + PROBE_BASE) / PROBE_Q * PROBE_Q); }
#endif
    if (TIME_B >= 0) {
        if (TIME_B >= NPH - 1) tB_ = __builtin_amdgcn_s_memrealtime();
        __syncthreads();
#ifndef TIME_Q
#define TIME_Q 10
#endif
#ifndef TIME_OFF
#define TIME_OFF 0
#endif
        const long long us_q = (long long)((((tB_ - tA_) / 100ull + TIME_OFF) / TIME_Q) * TIME_Q);
        const long long n = us_q * 1000ll - (long long)F.vcu * 131072ll; const int cnt = n < 0 ? 0 : (n > 131072 ? 131072 : (int)n);
        float* o = XRES + (size_t)F.vcu * 131072;
        for (int i = F.tid; i < cnt; i += NWAVES * 64) o[i] = 0.f;
    }
#undef IN
#undef SEAM
#undef GRID_BAR
}

extern "C" void kernel_launch(void* const* d_in, const int* in_sizes, int n_in, void* d_out, int out_size, void* d_ws, size_t ws_size, hipStream_t stream) {
    static int grid = 0;
    if (grid == 0) {
        if (n_in != 19 || in_sizes[0] != T * D || out_size != T * D || ws_size < WS_END) { fprintf(stderr, "kernel_launch: shape/workspace mismatch: n_in %d in0 %d out %d ws %zu (need %zu); nothing launched\n", n_in, n_in > 0 ? in_sizes[0] : -1, out_size, ws_size, (size_t)WS_END); grid = -1; return; }
        int dev = 0, cus = 0, per_cu = 0;
        if (hipGetDevice(&dev) != hipSuccess || hipDeviceGetAttribute(&cus, hipDeviceAttributeMultiprocessorCount, dev) != hipSuccess) { fprintf(stderr, "kernel_launch: device query failed\n"); grid = -1; return; }
        if (hipFuncSetAttribute((const void*)mk_fwd, hipFuncAttributeMaxDynamicSharedMemorySize, LDS_BYTES) != hipSuccess) { fprintf(stderr, "kernel_launch: hipFuncSetAttribute failed\n"); grid = -1; return; }
        if (hipOccupancyMaxActiveBlocksPerMultiprocessor(&per_cu, (const void*)mk_fwd, NWAVES * 64, LDS_BYTES) != hipSuccess || per_cu < 1) fprintf(stderr, "kernel_launch: note: occupancy query reports %d workgroups per CU\n", per_cu);
        (void)hipGetLastError();
        grid = cus;
        if (grid != 256) { fprintf(stderr, "kernel_launch: built for 256 CUs, device has %d; nothing launched\n", cus); grid = -1; return; }
    }
    if (grid < 0) return;
    if (hipMemsetAsync((char*)d_ws + WS_CTL, 0, CTL_ZERO_BYTES, stream) != hipSuccess) { fprintf(stderr, "kernel_launch: hipMemsetAsync failed\n"); return; }
    Args a{};
    const float** ip = (const float**)&a.in;
    for (int i = 0; i < 19; ++i) ip[i] = (const float*)d_in[i];
    a.out = (float*)d_out; a.ws = (unsigned char*)d_ws;
#if MK_PER_PHASE
    for (int p = 0; p < NPH; ++p) { a.ph_lo = p; a.ph_hi = p + 1; hipLaunchKernelGGL(mk_fwd, dim3(grid), dim3(NWAVES * 64), LDS_BYTES, stream, a); }
#else
    a.ph_lo = 0; a.ph_hi = NPH; hipLaunchKernelGGL(mk_fwd, dim3(grid), dim3(NWAVES * 64), LDS_BYTES, stream, a);
#endif
    const hipError_t le = hipPeekAtLastError();
    if (le != hipSuccess) fprintf(stderr, "kernel_launch: launch failed: %s\n", hipGetErrorName(le));
}
```

```cpp
#ifndef PROBE_STEPS
#define PROBE_STEPS 0
#endif
#ifndef PROBE_BASE
#define PROBE_BASE 0
#endif
#ifndef PROBE_Q
#define PROBE_Q 10
#endif
#include <hip/hip_runtime.h>
#include <hip/hip_bf16.h>
#include <cstdio>
#include <cstdint>
#include <cmath>

namespace pg8 {
#define PG8_LAS __attribute__((address_space(3)))
typedef unsigned short bf16_t;
typedef short bf16x8 __attribute__((ext_vector_type(8)));
typedef float f32x4 __attribute__((ext_vector_type(4)));
typedef unsigned u32x4 __attribute__((ext_vector_type(4)));
constexpr int BM = 256, BK = 64, HALF = 128, HTB = HALF * BK * 2  , STAGE_BYTES = 8 * HTB, NXCD = 8, WGM = 8;

__host__ __device__ __forceinline__ int lds_byte(int r, int c) { const int st = (r >> 4) * 2 + (c >> 5), rr = r & 15, cc = c & 31, ob = rr * 64 + cc * 2; return st * 1024 + (ob ^ (((ob >> 9) & 1) << 5)); }
__host__ __device__ __forceinline__ void stage_rc(int b, int& R, int& C) { const int st = b / 1024, sb = b % 1024, swz = sb ^ (((sb >> 9) & 1) << 5); R = (st >> 1) * 16 + swz / 64; C = (st & 1) * 32 + (swz % 64) / 2; }
__host__ __device__ __forceinline__ int perm32(int rho) { const int n = rho >> 4, i = rho & 15; return 8 * (i >> 2) + 4 * n + (i & 3); }

struct Unit { int pm, pn; };
struct Gemm { const bf16_t* A; const bf16_t* Bt; int M, N, K; };

struct StaticOrder {
    int nM, nN, nwg, G, c;
    __host__ __device__ void init(int M, int N, int G_, int c_) { nM = M / BM; nN = N / BM; nwg = nM * nN; G = G_; c = c_; }
    __host__ __device__ bool next(int i, Unit& u) const {
        const long L = (long)i * G + c; if (L >= nwg) return false;
        int wgid = (int)L; { const int q = nwg / NXCD, r = nwg % NXCD, xcd = wgid % NXCD, off = wgid / NXCD; wgid = (xcd < r ? xcd * (q + 1) : r * (q + 1) + (xcd - r) * q) + off; }
        const int nig = WGM * nN, gid = wgid / nig, fm = gid * WGM, gsz = (nM - fm) < WGM ? (nM - fm) : WGM;
        u.pm = fm + ((wgid % nig) % gsz); u.pn = (wgid % nig) / gsz; return true;
    }
    __device__ __forceinline__ void a_ready(const Unit&) const {}
    __device__ __forceinline__ void done(const Unit&) const {}
};

__device__ __forceinline__ unsigned cvt_pk_bf16(float lo, float hi) { unsigned r; asm volatile("v_cvt_pk_bf16_f32 %0, %1, %2" : "=v"(r) : "v"(lo), "v"(hi)); return r; }
typedef float f32x2 __attribute__((ext_vector_type(2)));

__device__ __forceinline__ float lane_read(float v, int src_lane) { return __builtin_bit_cast(float, __builtin_amdgcn_ds_bpermute(src_lane << 2, __builtin_bit_cast(int, v))); }
#ifndef MK_WT_STORES
#define MK_WT_STORES 0
#endif
#if MK_WT_STORES
#define STORE16_WT(p, v) asm volatile("global_store_dwordx4 %0, %1, off sc1\n\ts_nop 1" :: "v"(p), "v"(v) : "memory")
#else
#define STORE16_WT(p, v) (*(u32x4*)(p) = (v))
#endif
struct EpiQKVU {
    static constexpr bool PERM = true, AFTER_DRAIN = false;
    bf16_t* O; int ldc; int split_cols; size_t split_stride; float scale0;
    unsigned* nrm;
    __device__ __forceinline__ void operator()(const f32x4 (&acc)[2][2][4][2], const Unit& u, int wr, int wc, int fr, int fq) const {
        const int row0 = u.pm * BM + wr * 64 + fr; int colt = u.pn * BM; bf16_t* base = O;
        const int t = colt / split_cols; float sc = 1.f; { base += (size_t)t * split_stride; colt -= t * split_cols; if (t == 0) sc = scale0; }
        const int col0 = colt + wc * 32 + 8 * fq;
        if (t < 2) {
            const int b = (u.pm * BM) >> 12, tile0 = ((u.pm * BM) & 4095) >> 6;
#pragma unroll
            for (int ai = 0; ai < 2; ++ai)
#pragma unroll
                for (int bj = 0; bj < 2; ++bj) { float mx = 0.f;
#pragma unroll
                    for (int m = 0; m < 4; ++m) { const f32x4 v0 = acc[ai][bj][m][0] * sc, v1 = acc[ai][bj][m][1] * sc;
                        float ssq = (v0[0] * v0[0] + v0[1] * v0[1]) + (v0[2] * v0[2] + v0[3] * v0[3]) + (v1[0] * v1[0] + v1[1] * v1[1]) + (v1[2] * v1[2] + v1[3] * v1[3]);
                        { auto r16_ = __builtin_amdgcn_permlane16_swap(__float_as_uint(ssq), __float_as_uint(ssq), false, false); ssq = __uint_as_float(r16_[0]) + __uint_as_float(r16_[1]);
                          auto r32_ = __builtin_amdgcn_permlane32_swap(__float_as_uint(ssq), __float_as_uint(ssq), false, false); ssq = __uint_as_float(r32_[0]) + __uint_as_float(r32_[1]); }
                        mx = fmaxf(mx, ssq); }
#define PG8_DPPF(V, CTRL) __builtin_bit_cast(float, __builtin_amdgcn_update_dpp(0, __builtin_bit_cast(int, V), CTRL, 0xf, 0xf, false))
                    mx = fmaxf(mx, PG8_DPPF(mx, 0xB1)); mx = fmaxf(mx, PG8_DPPF(mx, 0x4E)); mx = fmaxf(mx, PG8_DPPF(mx, 0x141)); mx = fmaxf(mx, PG8_DPPF(mx, 0x140));
#undef PG8_DPPF
                    if (fr == 0 && fq == 0) { const int head = (colt >> 6) + 2 * bj + (wc >> 1);
                        nrm[((size_t)((t * 64 + b * 8 + head) * 64 + tile0 + 2 * ai + wr)) * 2 + (wc & 1)] = __float_as_uint(mx); } }
        }
#pragma unroll
        for (int ai = 0; ai < 2; ++ai)
#pragma unroll
            for (int m = 0; m < 4; ++m) { bf16_t* rowp = base + (size_t)(row0 + ai * HALF + m * 16) * ldc + col0;
#pragma unroll
                for (int bj = 0; bj < 2; ++bj) { const f32x4 v0 = acc[ai][bj][m][0] * sc, v1 = acc[ai][bj][m][1] * sc;
                    u32x4 w; w.x = cvt_pk_bf16(v0[0], v0[1]); w.y = cvt_pk_bf16(v0[2], v0[3]); w.z = cvt_pk_bf16(v1[0], v1[1]); w.w = cvt_pk_bf16(v1[2], v1[3]);
                    STORE16_WT(rowp + bj * HALF, w); } }
    }
};
struct EpiDelta {
    static constexpr bool PERM = true, AFTER_DRAIN = false;
    bf16_t* O; const float* gate; int gstride;
    __device__ __forceinline__ void operator()(const f32x4 (&acc)[2][2][4][2], const Unit& u, int wr, int wc, int fr, int fq) const {
        const int row0 = u.pm * BM + wr * 64 + fr, col0 = u.pn * BM + wc * 32 + 8 * fq; const int b = (u.pm * BM) >> 12;
        f32x4 gv[2][2];
#pragma unroll
        for (int bj = 0; bj < 2; ++bj)
#pragma unroll
            for (int n = 0; n < 2; ++n) gv[bj][n] = *(const f32x4*)(gate + (size_t)b * gstride + col0 + bj * HALF + 4 * n);
#pragma unroll
        for (int ai = 0; ai < 2; ++ai)
#pragma unroll
            for (int m = 0; m < 4; ++m) { bf16_t* rowp = O + (size_t)(row0 + ai * HALF + m * 16) * 1024 + col0;
#pragma unroll
                for (int bj = 0; bj < 2; ++bj) { const f32x4 v0 = acc[ai][bj][m][0] * gv[bj][0], v1 = acc[ai][bj][m][1] * gv[bj][1];
                    u32x4 w; w.x = cvt_pk_bf16(v0[0], v0[1]); w.y = cvt_pk_bf16(v0[2], v0[3]); w.z = cvt_pk_bf16(v1[0], v1[1]); w.w = cvt_pk_bf16(v1[2], v1[3]);
                    STORE16_WT(rowp + bj * HALF, w); } }
    }
};
struct EpiMid {
    static constexpr bool PERM = true, AFTER_DRAIN = false;
    bf16_t* O; const bf16_t* X; const float* gate; int gstride;
    __device__ __forceinline__ void operator()(const f32x4 (&acc)[2][2][4][2], const Unit& u, int wr, int wc, int fr, int fq) const {
        const int row0 = u.pm * BM + wr * 64 + fr, col0 = u.pn * BM + wc * 32 + 8 * fq; const int b = (u.pm * BM) >> 12;
        u32x4 xr[2][4][2];
#pragma unroll
        for (int ai = 0; ai < 2; ++ai)
#pragma unroll
            for (int m = 0; m < 4; ++m)
#pragma unroll
                for (int bj = 0; bj < 2; ++bj) xr[ai][m][bj] = *(const u32x4*)(X + (size_t)(row0 + ai * HALF + m * 16) * 1024 + col0 + bj * HALF);
        f32x4 gv[2][2];
#pragma unroll
        for (int bj = 0; bj < 2; ++bj)
#pragma unroll
            for (int n = 0; n < 2; ++n) gv[bj][n] = *(const f32x4*)(gate + (size_t)b * gstride + col0 + bj * HALF + 4 * n);
        asm volatile("" ::: "memory"); __builtin_amdgcn_sched_barrier(0);
#pragma unroll
        for (int ai = 0; ai < 2; ++ai)
#pragma unroll
            for (int m = 0; m < 4; ++m) { bf16_t* rowp = O + (size_t)(row0 + ai * HALF + m * 16) * 1024 + col0;
#pragma unroll
                for (int bj = 0; bj < 2; ++bj) { const u32x4 xv = xr[ai][m][bj];
                    const f32x4 x0 = {__uint_as_float(xv.x << 16), __uint_as_float(xv.x & 0xffff0000u), __uint_as_float(xv.y << 16), __uint_as_float(xv.y & 0xffff0000u)};
                    const f32x4 x1 = {__uint_as_float(xv.z << 16), __uint_as_float(xv.z & 0xffff0000u), __uint_as_float(xv.w << 16), __uint_as_float(xv.w & 0xffff0000u)};
                    const f32x4 v0 = x0 + acc[ai][bj][m][0] * gv[bj][0], v1 = x1 + acc[ai][bj][m][1] * gv[bj][1];
                    u32x4 w; w.x = cvt_pk_bf16(v0[0], v0[1]); w.y = cvt_pk_bf16(v0[2], v0[3]); w.z = cvt_pk_bf16(v1[0], v1[1]); w.w = cvt_pk_bf16(v1[2], v1[3]);
                    STORE16_WT(rowp + bj * HALF, w); } }
    }
};
struct EpiResGate {
    static constexpr bool PERM = false, AFTER_DRAIN = false;
    const float* base; float* out; const float* gate; int gstride;
    __device__ __forceinline__ void operator()(const f32x4 (&acc)[2][2][4][2], const Unit& u, int wr, int wc, int fr, int fq) const {
        const int row0 = u.pm * BM + wr * 64 + fr, col0 = u.pn * BM + wc * 32 + 4 * fq; const int b = (u.pm * BM) >> 12;
        f32x4 gv[2][2];
#pragma unroll
        for (int bj = 0; bj < 2; ++bj)
#pragma unroll
            for (int n = 0; n < 2; ++n) gv[bj][n] = *(const f32x4*)(gate + (size_t)b * gstride + col0 + bj * HALF + n * 16);
#pragma unroll
        for (int ai = 0; ai < 2; ++ai) {
            f32x4 bs[4][2][2];
#pragma unroll
            for (int m = 0; m < 4; ++m) { const size_t off = (size_t)(row0 + ai * HALF + m * 16) * 1024 + col0;
#pragma unroll
                for (int bj = 0; bj < 2; ++bj)
#pragma unroll
                    for (int n = 0; n < 2; ++n) bs[m][bj][n] = *(const f32x4*)(base + off + bj * HALF + n * 16); }
            asm volatile("" ::: "memory");
#pragma unroll
            for (int m = 0; m < 4; ++m) { const size_t off = (size_t)(row0 + ai * HALF + m * 16) * 1024 + col0;
#pragma unroll
                for (int bj = 0; bj < 2; ++bj)
#pragma unroll
                    for (int n = 0; n < 2; ++n) *(f32x4*)(out + off + bj * HALF + n * 16) = bs[m][bj][n] + gv[bj][n] * acc[ai][bj][m][n]; }
            asm volatile("" ::: "memory");
        }
    }
};

template <class Epi, class Sched, bool ALIGN_EPI = false, bool SP2 = false>
__device__ __forceinline__ void gemm_phase(PG8_LAS unsigned char* lds, const Gemm g, const Sched& S, const Epi& E) {
    int tid_ = threadIdx.x; asm volatile("" : "+v"(tid_));
    const int tid = tid_, wid = __builtin_amdgcn_readfirstlane(tid >> 6), lane = tid & 63, wr = wid >> 2, wc = wid & 3, fr = lane & 15, fq = lane >> 4;
    const int K = g.K, nt = K / BK;
    unsigned voffA[2], voffB[2];
#pragma unroll
    for (int i = 0; i < 2; ++i) { int R, C; stage_rc(tid * 16 + i * 8192, R, C); const int Rb = Epi::PERM ? ((R & ~31) + perm32(R & 31)) : R;
        voffA[i] = (unsigned)(R * K + C) * 2u; voffB[i] = (unsigned)(Rb * K + C) * 2u; }
    const size_t kstep = (size_t)(BK * 2);
    const size_t hstep = (size_t)HALF * K * 2;
    const size_t tstep = 2 * hstep;
    const unsigned ldsw = (unsigned)wid * 1024u;
    const int aoff = lds_byte(wr * 64 + fr, fq * 8), boff = lds_byte(wc * 32 + fr, fq * 8);
#define PG8_SA(b, h) (((b) * 2 + (h)) * HTB)
#define PG8_SB(b, h) ((4 + (b) * 2 + (h)) * HTB)
#define PG8_STAGE(bufoff, gbase, voff) do { _Pragma("unroll") for (int _i = 0; _i < 2; ++_i) \
        __builtin_amdgcn_global_load_lds((const unsigned*)((const char*)(gbase) + (voff)[_i]), (PG8_LAS unsigned*)(lds + (bufoff) + ldsw + _i * 8192), 16, 0, 0); } while (0)
#define PG8_LDA(dst, b, h) do { _Pragma("unroll") for (int m = 0; m < 4; ++m) _Pragma("unroll") for (int k = 0; k < 2; ++k) dst[m][k] = *(const PG8_LAS bf16x8*)(lds + PG8_SA(b, h) + aoff + m * 2048 + k * 1024); } while (0)
#define PG8_LDB(dst, b, h) do { _Pragma("unroll") for (int n = 0; n < 2; ++n) _Pragma("unroll") for (int k = 0; k < 2; ++k) dst[n][k] = *(const PG8_LAS bf16x8*)(lds + PG8_SB(b, h) + boff + n * 2048 + k * 1024); } while (0)
#define PG8_MMA(ai, bj, At, Bt) do { __builtin_amdgcn_s_setprio(1); _Pragma("unroll") for (int m = 0; m < 4; ++m) _Pragma("unroll") for (int n = 0; n < 2; ++n) _Pragma("unroll") for (int k = 0; k < 2; ++k) \
        acc[ai][bj][m][n] = __builtin_amdgcn_mfma_f32_16x16x32_bf16(Bt[n][k], At[m][k], acc[ai][bj][m][n], 0, 0, 0); __builtin_amdgcn_s_setprio(0); } while (0)
#define PG8_WAIT_V(n) asm volatile("s_waitcnt vmcnt(" #n ")" ::: "memory")
#define PG8_WAIT_L(n) asm volatile("s_waitcnt lgkmcnt(" #n ")" ::: "memory")
#define PG8_BAR __builtin_amdgcn_s_barrier()
#define PG8_SCHED __builtin_amdgcn_sched_barrier(0)
    Unit cur, nxt; int ui = 0;
    if (!S.next(0, cur)) return;
    f32x4 acc[2][2][4][2];
#pragma unroll
    for (int a = 0; a < 2; ++a)
#pragma unroll
        for (int b = 0; b < 2; ++b)
#pragma unroll
            for (int m = 0; m < 4; ++m)
#pragma unroll
                for (int n = 0; n < 2; ++n) acc[a][b][m][n] = (f32x4){0.f, 0.f, 0.f, 0.f};
    bf16x8 At[4][2], B0[2][2], B1[2][2];
    const char* cA = (const char*)g.A + (size_t)cur.pm * tstep; const char* cB = (const char*)g.Bt + (size_t)cur.pn * tstep;
    S.a_ready(cur);
    if constexpr (SP2) {
        PG8_STAGE(PG8_SB(0, 0), cB, voffB); PG8_STAGE(PG8_SB(0, 1), cB + hstep, voffB); PG8_STAGE(PG8_SA(0, 0), cA, voffA); PG8_STAGE(PG8_SA(0, 1), cA + hstep, voffA);
        if (wr == 1) PG8_BAR;
        PG8_WAIT_V(2); PG8_BAR;
        PG8_STAGE(PG8_SB(1, 0), cB + kstep, voffB); PG8_STAGE(PG8_SA(1, 0), cA + kstep, voffA); PG8_STAGE(PG8_SB(1, 1), cB + hstep + kstep, voffB);
        PG8_WAIT_V(6); PG8_BAR;
    } else {
        PG8_STAGE(PG8_SB(0, 0), cB, voffB); PG8_STAGE(PG8_SA(0, 0), cA, voffA); PG8_STAGE(PG8_SB(0, 1), cB + hstep, voffB); PG8_STAGE(PG8_SA(0, 1), cA + hstep, voffA);
        if (wr == 1) PG8_BAR;
        PG8_WAIT_V(4); PG8_BAR;
        PG8_STAGE(PG8_SB(1, 0), cB + kstep, voffB); PG8_STAGE(PG8_SA(1, 0), cA + kstep, voffA); PG8_STAGE(PG8_SB(1, 1), cB + hstep + kstep, voffB);
        PG8_WAIT_V(6); PG8_BAR;
    }
    for (;;) {
        const bool has_next = S.next(ui + 1, nxt);
        const char* nA = has_next ? (const char*)g.A + (size_t)nxt.pm * tstep : cA; const char* nB = has_next ? (const char*)g.Bt + (size_t)nxt.pn * tstep : cB;
        for (int t = 0; t < nt; t += 2) {
            const bool last = (t == nt - 2);
            const char* a1 = cA + (size_t)(t + 1) * kstep;
            const char* a2 = last ? nA : cA + (size_t)(t + 2) * kstep; const char* b2 = last ? nB : cB + (size_t)(t + 2) * kstep;
            const char* a3 = a2 + kstep; const char* b3 = b2 + kstep;
            if (last && has_next) S.a_ready(nxt);
            if constexpr (SP2) {
            PG8_LDB(B0, 0, 0); PG8_LDB(B1, 0, 1); PG8_SCHED; PG8_LDA(At, 0, 0); PG8_STAGE(PG8_SA(1, 1), a1 + hstep, voffA);
            PG8_WAIT_V(8); PG8_WAIT_L(0); PG8_BAR; PG8_MMA(0, 0, At, B0); PG8_MMA(0, 1, At, B1); PG8_BAR; PG8_SCHED;
            PG8_LDA(At, 0, 1); PG8_STAGE(PG8_SB(0, 0), b2, voffB); PG8_STAGE(PG8_SB(0, 1), b2 + hstep, voffB); PG8_STAGE(PG8_SA(0, 0), a2, voffA);
            PG8_WAIT_V(8); PG8_WAIT_L(0); PG8_BAR; PG8_MMA(1, 0, At, B0); PG8_MMA(1, 1, At, B1); PG8_BAR; PG8_SCHED;
            PG8_LDB(B0, 1, 0); PG8_LDB(B1, 1, 1); PG8_SCHED; PG8_LDA(At, 1, 0); PG8_STAGE(PG8_SA(0, 1), a2 + hstep, voffA);
            PG8_WAIT_V(8); PG8_WAIT_L(0); PG8_BAR; PG8_MMA(0, 0, At, B0); PG8_MMA(0, 1, At, B1); PG8_BAR; PG8_SCHED;
            PG8_LDA(At, 1, 1); PG8_STAGE(PG8_SB(1, 0), b3, voffB); PG8_STAGE(PG8_SB(1, 1), b3 + hstep, voffB); PG8_STAGE(PG8_SA(1, 0), a3, voffA);
            PG8_WAIT_V(8); PG8_WAIT_L(0); PG8_BAR; PG8_MMA(1, 0, At, B0); PG8_MMA(1, 1, At, B1); PG8_BAR; PG8_SCHED;
            } else {
            PG8_LDB(B0, 0, 0); PG8_SCHED; PG8_LDA(At, 0, 0); PG8_STAGE(PG8_SA(1, 1), a1 + hstep, voffA);
            PG8_WAIT_L(8); PG8_BAR; PG8_WAIT_L(0); PG8_MMA(0, 0, At, B0); PG8_BAR; PG8_SCHED;
            PG8_LDB(B1, 0, 1); PG8_STAGE(PG8_SB(0, 0), b2, voffB);
            PG8_BAR; PG8_WAIT_L(0); PG8_MMA(0, 1, At, B1); PG8_BAR;
            PG8_LDA(At, 0, 1); PG8_STAGE(PG8_SA(0, 0), a2, voffA);
            PG8_BAR; PG8_WAIT_L(0); PG8_MMA(1, 0, At, B0); PG8_BAR; PG8_SCHED;
            PG8_STAGE(PG8_SB(0, 1), b2 + hstep, voffB);
            PG8_WAIT_V(6); PG8_BAR; PG8_MMA(1, 1, At, B1); PG8_BAR;
            PG8_LDB(B0, 1, 0); PG8_SCHED; PG8_LDA(At, 1, 0); PG8_STAGE(PG8_SA(0, 1), a2 + hstep, voffA);
            PG8_WAIT_L(8); PG8_BAR; PG8_WAIT_L(0); PG8_MMA(0, 0, At, B0); PG8_BAR; PG8_SCHED;
            PG8_LDB(B1, 1, 1); PG8_STAGE(PG8_SB(1, 0), b3, voffB);
            PG8_BAR; PG8_WAIT_L(0); PG8_MMA(0, 1, At, B1); PG8_BAR;
            PG8_LDA(At, 1, 1); PG8_STAGE(PG8_SA(1, 0), a3, voffA);
            PG8_BAR; PG8_WAIT_L(0); PG8_MMA(1, 0, At, B0); PG8_BAR; PG8_SCHED;
            PG8_STAGE(PG8_SB(1, 1), b3 + hstep, voffB);
            PG8_WAIT_V(6); PG8_BAR; PG8_MMA(1, 1, At, B1); PG8_BAR;
            }
        }
        if constexpr (ALIGN_EPI) { if (wr == 0) PG8_BAR; }
        if constexpr (!Epi::AFTER_DRAIN) { E(acc, cur, wr, wc, fr, fq); S.done(cur); }
        if (!has_next) break;
#pragma unroll
        for (int a = 0; a < 2; ++a)
#pragma unroll
            for (int b = 0; b < 2; ++b)
#pragma unroll
                for (int m = 0; m < 4; ++m)
#pragma unroll
                    for (int n = 0; n < 2; ++n) acc[a][b][m][n] = (f32x4){0.f, 0.f, 0.f, 0.f};
        cur = nxt; cA = nA; cB = nB; ++ui;
        if constexpr (ALIGN_EPI) { if (wr == 1) PG8_BAR; }
    }
    PG8_WAIT_V(0);
    if constexpr (!ALIGN_EPI) { if (wr == 0) PG8_BAR; }
    PG8_BAR;
    if constexpr (Epi::AFTER_DRAIN) { E.fused(acc, cur, wr, wc, fr, fq, lds, wid, lane); S.done(cur); }
#undef PG8_SA
#undef PG8_SB
#undef PG8_STAGE
#undef PG8_LDA
#undef PG8_LDB
#undef PG8_MMA
#undef PG8_WAIT_V
#undef PG8_WAIT_L
#undef PG8_BAR
#undef PG8_SCHED
}

struct MUnit { int slot, e, pn, nrows, tile; };
struct MoeSched {
    PG8_LAS const int* ut; int nunits;
    const char* W; size_t estride, pnstride;
    unsigned rdy;
    unsigned* pub; unsigned* tmo;
    __device__ __forceinline__ bool next(int i, MUnit& u) const {
        if (i >= nunits) return false;
        u.slot = i; u.e = ut[4 * i]; u.pn = ut[4 * i + 1]; u.nrows = ut[4 * i + 2]; u.tile = ut[4 * i + 3]; return true; }
    __device__ __forceinline__ const char* b_base(const MUnit& u) const { return W + (size_t)u.e * estride + (size_t)u.pn * pnstride; }
    __device__ __forceinline__ void publish(int tile, int lane) const { if (lane == 0) __hip_atomic_fetch_add(pub + 64 * tile, 1u, __ATOMIC_RELAXED, __HIP_MEMORY_SCOPE_AGENT); }
    __device__ __forceinline__ void a_ready(const MUnit& u, int wid, int lane) const {
        if ((rdy >> u.slot) & 1u) return;
        if (wid == 0) {
            unsigned polls = 0;
            while ((unsigned)__builtin_amdgcn_readfirstlane(__hip_atomic_load(pub + 64 * u.tile, __ATOMIC_RELAXED, __HIP_MEMORY_SCOPE_AGENT)) < 16u) {
                if ((++polls & 255u) == 0u && __builtin_amdgcn_readfirstlane(__hip_atomic_load(tmo, __ATOMIC_RELAXED, __HIP_MEMORY_SCOPE_AGENT)) != 0u) break;
                if (polls > (1u << 14)) { if (lane == 0) __hip_atomic_store(tmo, 1u, __ATOMIC_RELAXED, __HIP_MEMORY_SCOPE_AGENT); break; }
                __builtin_amdgcn_s_sleep(2); }
            __builtin_amdgcn_fence(__ATOMIC_ACQUIRE, "agent");
            asm volatile("s_waitcnt vmcnt(0)" ::: "memory");
        }
        asm volatile("" ::: "memory"); __builtin_amdgcn_s_barrier(); asm volatile("" ::: "memory");
    }
};
template <int ESH, bool PUBLISH, bool WAITA, class Epi, class Sched>
__device__ __forceinline__ void gemm_phase_moe(PG8_LAS unsigned char* lds, const bf16_t* Abase, const int K, PG8_LAS const unsigned* ent, const Sched& S, const Epi& E) {
    int tid_ = threadIdx.x; asm volatile("" : "+v"(tid_));
    const int tid = tid_, wid = __builtin_amdgcn_readfirstlane(tid >> 6), lane = tid & 63, wr = wid >> 2, wc = wid & 3, fr = lane & 15, fq = lane >> 4;
    const int nt = K / BK;
    int RA[2]; unsigned cA2[2], voffB[2];
#pragma unroll
    for (int i = 0; i < 2; ++i) { int R, C; stage_rc(tid * 16 + i * 8192, R, C); const int Rb = Epi::PERM ? ((R & ~31) + perm32(R & 31)) : R;
        RA[i] = R; cA2[i] = (unsigned)C * 2u; voffB[i] = (unsigned)(Rb * K + C) * 2u; }
    const size_t kstep = (size_t)(BK * 2);
    const size_t hstep = (size_t)HALF * K * 2;
    const unsigned rowb = (unsigned)K * 2u;
    const unsigned ldsw = (unsigned)wid * 1024u;
    const int aoff = lds_byte(wr * 64 + fr, fq * 8), boff = lds_byte(wc * 32 + fr, fq * 8);
#define PG8_SA(b, h) (((b) * 2 + (h)) * HTB)
#define PG8_SB(b, h) ((4 + (b) * 2 + (h)) * HTB)
#define PG8_STAGE(bufoff, gbase, voff) do { _Pragma("unroll") for (int _i = 0; _i < 2; ++_i) \
        __builtin_amdgcn_global_load_lds((const unsigned*)((const char*)(gbase) + (voff)[_i]), (PG8_LAS unsigned*)(lds + (bufoff) + ldsw + _i * 8192), 16, 0, 0); } while (0)
#define PG8_LDA(dst, b, h) do { _Pragma("unroll") for (int m = 0; m < 4; ++m) _Pragma("unroll") for (int k = 0; k < 2; ++k) dst[m][k] = *(const PG8_LAS bf16x8*)(lds + PG8_SA(b, h) + aoff + m * 2048 + k * 1024); } while (0)
#define PG8_LDB(dst, b, h) do { _Pragma("unroll") for (int n = 0; n < 2; ++n) _Pragma("unroll") for (int k = 0; k < 2; ++k) dst[n][k] = *(const PG8_LAS bf16x8*)(lds + PG8_SB(b, h) + boff + n * 2048 + k * 1024); } while (0)
#define PG8_MMA(ai, bj, At, Bt) do { __builtin_amdgcn_s_setprio(1); _Pragma("unroll") for (int m = 0; m < 4; ++m) _Pragma("unroll") for (int n = 0; n < 2; ++n) _Pragma("unroll") for (int k = 0; k < 2; ++k) \
        acc[ai][bj][m][n] = __builtin_amdgcn_mfma_f32_16x16x32_bf16(Bt[n][k], At[m][k], acc[ai][bj][m][n], 0, 0, 0); __builtin_amdgcn_s_setprio(0); } while (0)
#define PG8_WAIT_V(n) asm volatile("s_waitcnt vmcnt(" #n ")" ::: "memory")
#define PG8_WAIT_L(n) asm volatile("s_waitcnt lgkmcnt(" #n ")" ::: "memory")
#define PG8_BAR __builtin_amdgcn_s_barrier()
#define PG8_SCHED __builtin_amdgcn_sched_barrier(0)
#define PG8_OFFS(dst, u) do { _Pragma("unroll") for (int _h = 0; _h < 2; ++_h) _Pragma("unroll") for (int _i = 0; _i < 2; ++_i) \
        dst[_h][_i] = (ent[(u).slot * 256 + _h * HALF + RA[_i]] >> ESH) * rowb + cA2[_i]; } while (0)
    MUnit cur, nxt; int ui = 0; int pend = -1;
    if (!S.next(0, cur)) return;
    if constexpr (WAITA) S.a_ready(cur, wid, lane);
    f32x4 acc[2][2][4][2];
#pragma unroll
    for (int a = 0; a < 2; ++a)
#pragma unroll
        for (int b = 0; b < 2; ++b)
#pragma unroll
            for (int m = 0; m < 4; ++m)
#pragma unroll
                for (int n = 0; n < 2; ++n) acc[a][b][m][n] = (f32x4){0.f, 0.f, 0.f, 0.f};
    bf16x8 At[4][2], B0[2][2], B1[2][2];
    unsigned offc[2][2], offn[2][2];
    PG8_OFFS(offc, cur);
    const char* const cA = (const char*)Abase; const char* cB = S.b_base(cur);
    PG8_STAGE(PG8_SB(0, 0), cB, voffB); PG8_STAGE(PG8_SB(0, 1), cB + hstep, voffB); PG8_STAGE(PG8_SA(0, 0), cA, offc[0]); PG8_STAGE(PG8_SA(0, 1), cA, offc[1]);
    if (wr == 1) PG8_BAR;
    PG8_WAIT_V(2); PG8_BAR;
    PG8_STAGE(PG8_SB(1, 0), cB + kstep, voffB); PG8_STAGE(PG8_SA(1, 0), cA + kstep, offc[0]); PG8_STAGE(PG8_SB(1, 1), cB + hstep + kstep, voffB);
    PG8_WAIT_V(6); PG8_BAR;
    for (;;) {
        const bool has_next = S.next(ui + 1, nxt);
        const char* nB = has_next ? S.b_base(nxt) : cB;
        if (has_next) { PG8_OFFS(offn, nxt); } else {
#pragma unroll
            for (int h = 0; h < 2; ++h)
#pragma unroll
                for (int i = 0; i < 2; ++i) offn[h][i] = offc[h][i]; }
#pragma nounroll
        for (int t = 0; t < nt; t += 2) {
            const bool last = (t == nt - 2);
            if constexpr (WAITA) { if (last && has_next) S.a_ready(nxt, wid, lane); }
            const char* a1 = cA + (size_t)(t + 1) * kstep;
            const char* a2 = last ? cA : cA + (size_t)(t + 2) * kstep; const char* b2 = last ? nB : cB + (size_t)(t + 2) * kstep;
            const char* a3 = a2 + kstep; const char* b3 = b2 + kstep;
            unsigned o2[2][2];
#pragma unroll
            for (int h = 0; h < 2; ++h)
#pragma unroll
                for (int i = 0; i < 2; ++i) o2[h][i] = last ? offn[h][i] : offc[h][i];
            PG8_LDB(B0, 0, 0); PG8_LDB(B1, 0, 1); PG8_SCHED; PG8_LDA(At, 0, 0); PG8_STAGE(PG8_SA(1, 1), a1, offc[1]);
            PG8_WAIT_V(8); PG8_WAIT_L(0); PG8_BAR; PG8_MMA(0, 0, At, B0); PG8_MMA(0, 1, At, B1); PG8_BAR; PG8_SCHED;
            PG8_LDA(At, 0, 1); PG8_STAGE(PG8_SB(0, 0), b2, voffB); PG8_STAGE(PG8_SB(0, 1), b2 + hstep, voffB); PG8_STAGE(PG8_SA(0, 0), a2, o2[0]);
            PG8_WAIT_V(8); PG8_WAIT_L(0);
            if constexpr (PUBLISH) { if (t == 0 && pend >= 0) { S.publish(pend, lane); pend = -1; } }
            PG8_BAR; PG8_MMA(1, 0, At, B0); PG8_MMA(1, 1, At, B1); PG8_BAR; PG8_SCHED;
            PG8_LDB(B0, 1, 0); PG8_LDB(B1, 1, 1); PG8_SCHED; PG8_LDA(At, 1, 0); PG8_STAGE(PG8_SA(0, 1), a2, o2[1]);
            PG8_WAIT_V(8); PG8_WAIT_L(0); PG8_BAR; PG8_MMA(0, 0, At, B0); PG8_MMA(0, 1, At, B1); PG8_BAR; PG8_SCHED;
            PG8_LDA(At, 1, 1); PG8_STAGE(PG8_SB(1, 0), b3, voffB); PG8_STAGE(PG8_SB(1, 1), b3 + hstep, voffB); PG8_STAGE(PG8_SA(1, 0), a3, o2[0]);
            PG8_WAIT_V(8); PG8_WAIT_L(0); PG8_BAR; PG8_MMA(1, 0, At, B0); PG8_MMA(1, 1, At, B1); PG8_BAR; PG8_SCHED;
        }
        if (wr == 0) PG8_BAR;
        E(acc, cur, wr, wc, fr, fq);
        if constexpr (PUBLISH) pend = cur.tile;
        if (!has_next) break;
#pragma unroll
        for (int a = 0; a < 2; ++a)
#pragma unroll
            for (int b = 0; b < 2; ++b)
#pragma unroll
                for (int m = 0; m < 4; ++m)
#pragma unroll
                    for (int n = 0; n < 2; ++n) acc[a][b][m][n] = (f32x4){0.f, 0.f, 0.f, 0.f};
        cur = nxt; cB = nB; ++ui;
#pragma unroll
        for (int h = 0; h < 2; ++h)
#pragma unroll
            for (int i = 0; i < 2; ++i) offc[h][i] = offn[h][i];
        if (wr == 1) PG8_BAR;
    }
    PG8_WAIT_V(0);
    if constexpr (PUBLISH) { if (pend >= 0) S.publish(pend, lane); }
    PG8_BAR;
#undef PG8_SA
#undef PG8_SB
#undef PG8_STAGE
#undef PG8_LDA
#undef PG8_LDB
#undef PG8_MMA
#undef PG8_WAIT_V
#undef PG8_WAIT_L
#undef PG8_BAR
#undef PG8_SCHED
#undef PG8_OFFS
}
struct EpiAct {
    static constexpr bool PERM = true, AFTER_DRAIN = false;
    bf16_t* ACT; PG8_LAS const unsigned* ent; PG8_LAS const float* cwt;
    __device__ __forceinline__ void operator()(const f32x4 (&acc)[2][2][4][2], const MUnit& u, int wr, int wc, int fr, int fq) const {
#pragma unroll
        for (int ai = 0; ai < 2; ++ai)
#pragma unroll
            for (int m = 0; m < 4; ++m) { const int r = ai * HALF + wr * 64 + m * 16 + fr;
                if (r < u.nrows) { const unsigned en = ent[u.slot * 256 + r]; const float w = cwt[u.slot * 256 + r];
                    float a[8];
#pragma unroll
                    for (int n = 0; n < 2; ++n)
#pragma unroll
                        for (int j = 0; j < 4; ++j) { const float g = acc[ai][0][m][n][j], up = acc[ai][1][m][n][j];
                            a[4 * n + j] = g * __builtin_amdgcn_rcpf(1.f + __builtin_amdgcn_exp2f(-1.4426950408889634f * g)) * up * w; }
                    u32x4 o; o.x = cvt_pk_bf16(a[0], a[1]); o.y = cvt_pk_bf16(a[2], a[3]); o.z = cvt_pk_bf16(a[4], a[5]); o.w = cvt_pk_bf16(a[6], a[7]);
                    asm volatile("global_store_dwordx4 %0, %1, off sc1\n\ts_nop 1" :: "v"(ACT + (size_t)en * 256 + u.pn * HALF + wc * 32 + 8 * fq), "v"(o) : "memory"); } }
    }
};
struct EpiY {
    static constexpr bool PERM = true, AFTER_DRAIN = false;
    unsigned char* Y; size_t slot_stride; PG8_LAS const unsigned* ent;
    __device__ __forceinline__ void operator()(const f32x4 (&acc)[2][2][4][2], const MUnit& u, int wr, int wc, int fr, int fq) const {
        const int coff = (fq & 1) ? HALF + 8 * (fq - 1) : 8 * fq;
#pragma unroll
        for (int ai = 0; ai < 2; ++ai)
#pragma unroll
            for (int m = 0; m < 4; ++m) { const int r = ai * HALF + wr * 64 + m * 16 + fr;
                unsigned w[2][2];
#pragma unroll
                for (int bj = 0; bj < 2; ++bj) { const f32x4 v0 = acc[ai][bj][m][0] * 16.f, v1 = acc[ai][bj][m][1] * 16.f;
                    int w0 = __builtin_amdgcn_cvt_pk_fp8_f32(v0[0], v0[1], 0, false); w0 = __builtin_amdgcn_cvt_pk_fp8_f32(v0[2], v0[3], w0, true);
                    int w1 = __builtin_amdgcn_cvt_pk_fp8_f32(v1[0], v1[1], 0, false); w1 = __builtin_amdgcn_cvt_pk_fp8_f32(v1[2], v1[3], w1, true);
                    w[bj][0] = (unsigned)w0; w[bj][1] = (unsigned)w1; }
                { auto s0 = __builtin_amdgcn_permlane16_swap(w[0][0], w[1][0], false, false); w[0][0] = s0[0]; w[1][0] = s0[1];
                  auto s1 = __builtin_amdgcn_permlane16_swap(w[0][1], w[1][1], false, false); w[0][1] = s1[0]; w[1][1] = s1[1]; }
                if (r < u.nrows) { const unsigned en = ent[u.slot * 256 + r];
                    unsigned char* rowp = Y + (size_t)(en & 1u) * slot_stride + (size_t)(en >> 1) * 1024 + u.pn * BM + wc * 32 + coff;
                    *(u32x4*)rowp = (u32x4){w[0][0], w[0][1], w[1][0], w[1][1]}; } }
    }
};
}

#include <hip/hip_bf16.h>
#include <cmath>

namespace attn_body {
using bf16=__hip_bfloat16;
using bf16x8=__attribute__((ext_vector_type(8)))short;
using s16x4=__attribute__((ext_vector_type(4)))short;
using f32x16=__attribute__((ext_vector_type(16)))float;
using u32x4=__attribute__((ext_vector_type(4)))unsigned;
constexpr int BATCH=8,NHEAD=8,SEQ=4096,D=64,DM=NHEAD*D,ODM=1024;
constexpr int NW=8,QBLK=32,QB=QBLK*NW,KVBLK=64,NQB=SEQ/QB;
constexpr int ATTN_PITCH=DM, ATTN_UNIT_ROWS=QB;
__device__ __forceinline__ int crow(int r,int hi){return (r&3)+8*(r>>2)+4*hi;}
#define SBAR() __builtin_amdgcn_sched_barrier(0)
__device__ __forceinline__ void cmask(f32x16&p0,f32x16&p1,int jb,int qrel,int hi){
  const float NEG=-INFINITY; int kb=64*jb+4*hi;
  #pragma unroll
  for(int r=0;r<16;++r){int kv=kb+(r&3)+8*(r>>2); if(kv>qrel)p0[r]=NEG; if(kv+32>qrel)p1[r]=NEG;}
}

constexpr int NSLOT=3, SLOTB=8192;
constexpr int LDS_K=0, LDS_V=NSLOT*SLOTB, LDS_WS=2*NSLOT*SLOTB, LDS_OST=LDS_WS+NW*64*4, LDS_BYTES=LDS_OST+NW*4096;
constexpr float SKIP_L2=-80.f;
constexpr int LDS_TICKET=85504;
constexpr int LDS_FB=86016, LDS_FB_BYTES=SEQ*8;
constexpr float C2=0.125f*1.4426950408889634f;
__device__ __forceinline__ void glds16(const void*gbase,unsigned voff,unsigned lds_dst){unsigned keep;
  asm volatile("s_mov_b32 %0, m0\n\ts_mov_b32 m0, %3\n\ts_nop 0\n\tglobal_load_lds_dwordx4 %1, %2\n\ts_mov_b32 m0, %0":"=&s"(keep):"v"(voff),"s"(gbase),"s"(lds_dst):"memory");}
__device__ __forceinline__ float max3f(float a,float b,float c){float r;asm("v_max3_f32 %0, %1, %2, %3":"=v"(r):"v"(a),"v"(b),"v"(c));return r;}
__device__ __forceinline__ float max2f(float a,float b){float r;asm("v_max_f32_e32 %0, %1, %2":"=v"(r):"v"(a),"v"(b));return r;}
__device__ __forceinline__ float fadd_s(float a,float b){float r;asm("v_add_f32_e32 %0, %1, %2":"=v"(r):"v"(a),"v"(b));return r;}
__device__ __forceinline__ float fsub_s(float a,float b){float r;asm("v_sub_f32_e32 %0, %1, %2":"=v"(r):"v"(a),"v"(b));return r;}
typedef float f32x2_t __attribute__((ext_vector_type(2))); typedef __bf16 bf16x2_t __attribute__((ext_vector_type(2)));
__device__ __forceinline__ unsigned cvtpk_s(float lo,float hi){f32x2_t v={lo,hi};bf16x2_t b=__builtin_convertvector(v,bf16x2_t);return __builtin_bit_cast(unsigned,b);}
#define WAIT_BAR(N) asm volatile("s_waitcnt vmcnt(" #N ") lgkmcnt(0)\n\ts_barrier":::"memory")

__device__ __forceinline__ void qkt(f32x16&p0,f32x16&p1,const char*Kslot,const bf16x8*qr,int r32,int hi){
  const char*kb=Kslot+hi*1024+r32*16;
  #pragma unroll
  for(int d0=0;d0<4;++d0){
    const bf16x8 b0=*reinterpret_cast<const bf16x8*>(kb+d0*2048);
    const bf16x8 b1=*reinterpret_cast<const bf16x8*>(kb+d0*2048+512);
    {p0=__builtin_amdgcn_mfma_f32_32x32x16_bf16(b0,qr[d0],p0,0,0,0);p1=__builtin_amdgcn_mfma_f32_32x32x16_bf16(b1,qr[d0],p1,0,0,0);}}
}
typedef __attribute__((address_space(3))) const char* lds_cptr;
typedef float f32x4_t __attribute__((ext_vector_type(4)));
typedef short v4i16_t __attribute__((ext_vector_type(4)));
__device__ __forceinline__ void kload8(bf16x8*kf,lds_cptr kp){
  kf[0]=*(const __attribute__((address_space(3))) bf16x8*)(kp);      kf[1]=*(const __attribute__((address_space(3))) bf16x8*)(kp+512);
  kf[2]=*(const __attribute__((address_space(3))) bf16x8*)(kp+2048); kf[3]=*(const __attribute__((address_space(3))) bf16x8*)(kp+2560);
  kf[4]=*(const __attribute__((address_space(3))) bf16x8*)(kp+4096); kf[5]=*(const __attribute__((address_space(3))) bf16x8*)(kp+4608);
  kf[6]=*(const __attribute__((address_space(3))) bf16x8*)(kp+6144); kf[7]=*(const __attribute__((address_space(3))) bf16x8*)(kp+6656);
}
__device__ __forceinline__ void kload2(bf16x8*kf,lds_cptr kp,int j){ kf[2*j]=*(const __attribute__((address_space(3))) bf16x8*)(kp+j*2048); kf[2*j+1]=*(const __attribute__((address_space(3))) bf16x8*)(kp+j*2048+512); }
__device__ __forceinline__ s16x4 vtr(lds_cptr p){ return __builtin_bit_cast(s16x4,__builtin_amdgcn_ds_read_tr16_b64_v4i16((__attribute__((address_space(3))) v4i16_t*)p)); }
__device__ __forceinline__ float rowmax(const f32x16&p0,const f32x16&p1){
  float a=max3f(p0[0],p0[1],p1[0]),b=max3f(p0[2],p0[3],p1[1]);a=max3f(a,p1[2],p1[3]);
  #pragma unroll
  for(int r=4;r<16;r+=4){a=max3f(a,p0[r],p0[r+1]);b=max3f(b,p0[r+2],p0[r+3]);a=max3f(a,p1[r],p1[r+1]);b=max3f(b,p1[r+2],p1[r+3]);}
  const float m=max2f(a,b);
  auto rr=__builtin_amdgcn_permlane32_swap(__float_as_uint(m),__float_as_uint(m),false,false);
  return max2f(__uint_as_float(rr[0]),__uint_as_float(rr[1]));
}
__device__ __forceinline__ void pv(f32x16*o,int vb,bf16x8 pa0,bf16x8 pa1,bf16x8 pa2,bf16x8 pa3){
  #pragma unroll
  for(int d0=0;d0<2;++d0){s16x4 lo[4],hi[4];
    #pragma unroll
    for(int ks=0;ks<4;++ks){
      asm volatile("ds_read_b64_tr_b16 %0,%1 offset:%c2":"=&v"(lo[ks]):"v"(vb),"i"(d0*4096+ks*1024):"memory");
      asm volatile("ds_read_b64_tr_b16 %0,%1 offset:%c2":"=&v"(hi[ks]):"v"(vb),"i"(d0*4096+ks*1024+512):"memory");}
    asm volatile("s_waitcnt lgkmcnt(0)":::"memory");SBAR();
    #define PK(k) (bf16x8){lo[k][0],lo[k][1],lo[k][2],lo[k][3],hi[k][0],hi[k][1],hi[k][2],hi[k][3]}
    o[d0]=__builtin_amdgcn_mfma_f32_32x32x16_bf16(pa0,PK(0),o[d0],0,0,0);
    o[d0]=__builtin_amdgcn_mfma_f32_32x32x16_bf16(pa1,PK(1),o[d0],0,0,0);
    o[d0]=__builtin_amdgcn_mfma_f32_32x32x16_bf16(pa2,PK(2),o[d0],0,0,0);
    o[d0]=__builtin_amdgcn_mfma_f32_32x32x16_bf16(pa3,PK(3),o[d0],0,0,0);
    #undef PK
  }
}

#ifndef ATTN_STORE16
#define ATTN_STORE16(p,v) STORE16_WT(p,v)
#endif
struct AttnBase { const char* ws; size_t q,k,v,o,fc,bt,nrm,qat,pq; };
template<int THRL> __device__ __forceinline__ int attn_units(const int x,int rank,const AttnBase&AB,const int maxu,int&ndone,int&steps,char*shm){
  typedef float f32x4_l __attribute__((ext_vector_type(4)));
  typedef unsigned v2u_t __attribute__((ext_vector_type(2)));
  #define WAVE_CONSTS() \
  int tid_=threadIdx.x; asm volatile("":"+v"(tid_)); const int tid=tid_,lane=tid&63,r32=lane&31,hi=lane>>5; const int wid=__builtin_amdgcn_readfirstlane(tid>>6); \
  const unsigned lds0=(unsigned)(uintptr_t)shm; \
  float*wsf=(float*)(shm+LDS_WS)+wid*64; \
  const unsigned ksrc=(unsigned)((lane*DM+wid*8)*2); \
  const unsigned vsrc=(unsigned)(((16*(wid&3)+(lane>>2))*DM+(wid>>2)*32+(lane&3)*8)*2); \
  const unsigned kdst=lds0+LDS_K+wid*1024, vdst=lds0+LDS_V+wid*1024; \
  const int vb0=(int)(lds0+LDS_V)+((lane>>4)&1)*32+(lane&3)*8+(4*hi+((lane&15)>>2))*64; \
  const char*Kbase=shm+LDS_K; \
  const lds_cptr shm3=(lds_cptr)shm; const lds_cptr kp0=shm3+LDS_K+hi*1024+r32*16; const lds_cptr vp0=shm3+LDS_V+((lane>>4)&1)*32+(lane&3)*8+(4*hi+((lane&15)>>2))*64; \
  const int qrel=wid*QBLK+r32; \
  const lds_cptr fbx=shm3+LDS_FB+(r32*8); \
  const u32x4 qxu_=hi?(u32x4){0u,0u,0u,0u}:(u32x4){0x3f803f80u,0x00003f80u,0u,0u}; const bf16x8 qx=__builtin_bit_cast(bf16x8,qxu_);
  #define DMA_K(t,slot) glds16(Kh,ksrc+(unsigned)(NTF-1-(t))*(unsigned)(KVBLK*DM*2),(unsigned)__builtin_amdgcn_readfirstlane(kdst+(slot)))
  #define DMA_V(t,slot) glds16(Vh,vsrc+(unsigned)(NTF-1-(t))*(unsigned)(KVBLK*DM*2),(unsigned)__builtin_amdgcn_readfirstlane(vdst+(slot)))
  int qb,q0,h,NTF,kend; long rowbase; const bf16*Kh,*Vh;
  float su_bt,su_fcj,su_fc0; unsigned su_k0,su_k1,su_q[8],su_u[8]; f32x4_l su_v0,su_v1; bf16x8 qr[4];
  #define NRMW(p,i) __hip_atomic_load((p)+(i),__ATOMIC_RELAXED,__HIP_MEMORY_SCOPE_AGENT)
  #define UNIT_ISSUE(RK) do{ const int u_=(RK),bq_=u_&7; qb=15-(u_>>3); const int bh_=bq_*8+((x-bq_)&7); h=bh_%NHEAD; rowbase=(long)(bh_/NHEAD)*SEQ; q0=qb*QB; kend=q0+QB; NTF=(q0+QB)/KVBLK; \
    const char*w_=AB.ws; asm volatile("":"+s"(w_)); const bf16*Q=(const bf16*)(w_+AB.q),*K=(const bf16*)(w_+AB.k),*V=(const bf16*)(w_+AB.v); const float*FC=(const float*)(w_+AB.fc),*BT=(const float*)(w_+AB.bt); const unsigned*nrm=(const unsigned*)(w_+AB.nrm); \
    const float*FCbh=FC+(long)bh_*SEQ; su_bt=lane<32?BT[bh_*32+lane]:0.f; \
    const unsigned*su_qn=nrm+((size_t)bh_*64)*2,*su_kn=nrm+((size_t)(64+bh_)*64)*2; \
    su_k0=NRMW(su_kn,2*lane);su_k1=NRMW(su_kn,2*lane+1); \
    _Pragma("unroll") for(int r=0;r<8;++r){ su_q[r]=NRMW(su_qn,8*qb+r); su_u[r]=NRMW(su_kn,8*qb+r); } \
    su_fcj=FCbh[64*lane+63];su_fc0=FCbh[256*qb]; \
    su_v0=(f32x4_l){0.f,0.f,0.f,0.f};su_v1=(f32x4_l){0.f,0.f,0.f,0.f}; \
    if(tid*4<kend)su_v0=*reinterpret_cast<const f32x4_l*>(FCbh+tid*4); \
    if(tid*4+NW*256<kend)su_v1=*reinterpret_cast<const f32x4_l*>(FCbh+tid*4+NW*256); \
    asm volatile("":::"memory"); __builtin_amdgcn_sched_barrier(0); \
    const bf16*Qw=Q+(rowbase+q0+wid*QBLK)*DM+h*D; Kh=K+rowbase*DM+h*D;Vh=V+rowbase*DM+h*D; \
    DMA_K(0,0);DMA_V(0,0);DMA_K(1,SLOTB); \
    _Pragma("unroll") for(int d0=0;d0<4;++d0)qr[d0]=*reinterpret_cast<const bf16x8*>(&Qw[(long)r32*DM+d0*16+hi*8]); \
    DMA_K(2,2*SLOTB); }while(0)
  #define XFR(v) __builtin_bit_cast(bf16x8,(u32x4){(v)[0],(v)[1],(v)[0],(v)[1]})
  #define CINIT(C0,C1,t) do{ const v2u_t a_=*(const __attribute__((address_space(3))) v2u_t*)(fbx+(NTF-1-(t))*512), b_=*(const __attribute__((address_space(3))) v2u_t*)(fbx+(NTF-1-(t))*512+256); \
      C0=__builtin_amdgcn_mfma_f32_32x32x16_bf16(XFR(a_),qx,negm,0,0,0); C1=__builtin_amdgcn_mfma_f32_32x32x16_bf16(XFR(b_),qx,negm,0,0,0); }while(0)
  #define CMASK(P0,P1,t) do{int jb_=3-(t); if(jb_>=0)cmask(P0,P1,jb_,qrel,hi);}while(0)
  #define START(P0,P1) do{ const float rm=rowmax(P0,P1); resc=false; \
    { const float dl=__builtin_fmaxf(rm,lower_); mhat=fadd_s(mhat,dl); \
      _Pragma("unroll") for(int r=0;r<16;++r){P0[r]=fsub_s(P0[r],dl);P1[r]=fsub_s(P1[r],dl);} \
      _Pragma("unroll") for(int r=0;r<16;++r)negm[r]=-mhat; asm volatile("":"+v"(negm)); } \
    _Pragma("unroll") for(int r=0;r<16;++r)P0[r]=__builtin_amdgcn_exp2f(P0[r]); }while(0)
  #define RESC() do{ if(resc){ asm volatile("s_waitcnt lgkmcnt(0)":::"memory"); \
      _Pragma("unroll") for(int d_=0;d_<2;++d_) _Pragma("unroll") for(int r=0;r<16;++r)o[d_][r]*=wsf[crow(r,hi)]; } }while(0)
  #define ROT() do{sl_prev=sl_cur;sl_cur=sl_next;sl_next=(sl_next==(NSLOT-1)*SLOTB)?0:sl_next+SLOTB;}while(0)
  { WAVE_CONSTS(); (void)wsf;(void)vb0;(void)Kbase;(void)kp0;(void)vp0;(void)qrel;(void)fbx;(void)qx; UNIT_ISSUE(rank); }
  int nrank,nu=0; bool pst=false;
  #pragma nounroll
  for(;;){
  WAVE_CONSTS(); bf16x8 kf[8];
  float mhat=0.f,l_reg=0.f;f32x16 o[2];o[0]=f32x16{};o[1]=f32x16{};f32x16 negm=f32x16{};asm volatile("":"+v"(negm));
  bool resc=false;
  f32x16 pA0,pA1,pB0,pB1;
  int sl_prev=0,sl_cur=0,sl_next=SLOTB;
  int j0; float cb; bool nomax;
  { float sc_=su_bt;
    #define DPPF0(V,CTRL,RM) __builtin_bit_cast(float,__builtin_amdgcn_update_dpp(0,__builtin_bit_cast(int,V),CTRL,RM,0xf,true))
    sc_+=DPPF0(sc_,0x111,0xf); sc_+=DPPF0(sc_,0x112,0xf); sc_+=DPPF0(sc_,0x114,0xf); sc_+=DPPF0(sc_,0x118,0xf);
    sc_+=DPPF0(sc_,0x142,0xa);
    #undef DPPF0
    const float offv=sc_-su_bt;
    const float kn2=__uint_as_float(su_k0)+__uint_as_float(su_k1);
    float qn2=0.f,ku2=0.f;
    #pragma unroll
    for(int r=0;r<4;++r){ qn2=fmaxf(qn2,__uint_as_float(su_q[2*r])+__uint_as_float(su_q[2*r+1])); ku2=fmaxf(ku2,__uint_as_float(su_u[2*r])+__uint_as_float(su_u[2*r+1])); }
    const float Qm=sqrtf(qn2)*1.01f,Kj=sqrtf(kn2)*1.01f,Ku=sqrtf(ku2)*1.01f; cb=Qm*Ku;
    const float fbj=-(su_fcj+pg8::lane_read(offv,lane>>1)),fb0=-(su_fc0+pg8::lane_read(offv,2*qb));
    const bool needed=(lane>=4*qb)||!(Qm*(Kj+Ku)+fbj-fb0<SKIP_L2);
    j0=__builtin_amdgcn_readfirstlane((int)(__builtin_ctzll(__ballot(needed)))&~1);
    nomax=(__ballot((lane>=j0)&&(lane<NTF)&&!(Qm*(Kj+Ku)<=78.f))==0ull);
    __attribute__((address_space(3))) u32x4* tb=(__attribute__((address_space(3))) u32x4*)(shm3+LDS_FB);
    #pragma unroll
    for(int k_=0;k_<2;++k_){ const int s_=tid*4+k_*NW*256;
      if(s_<kend){ const f32x4_l v_=(k_?su_v1:su_v0)+pg8::lane_read(offv,s_>>7); unsigned w0[4],w1[4];
        #pragma unroll
        for(int i_=0;i_<4;++i_){ const float f=-v_[i_]; const unsigned hb=cvtpk_s(f,0.f)&0xffffu; const float r1=f-__uint_as_float(hb<<16); const unsigned mb=cvtpk_s(r1,0.f)&0xffffu; const float r2=r1-__uint_as_float(mb<<16);
          w0[i_]=hb|(mb<<16); w1[i_]=cvtpk_s(r2,0.f)&0xffffu; }
        tb[s_/2]=(u32x4){w0[0],w1[0],w0[1],w1[1]}; tb[s_/2+1]=(u32x4){w0[2],w1[2],w0[3],w1[3]}; } }
  }
  const int NT=NTF-j0;
#if PROBE_STEPS
  steps+=NT;
#endif
  if(pst){WAIT_BAR(4);}else{WAIT_BAR(3);}
  float lower_; { const v2u_t e_=*(const __attribute__((address_space(3))) v2u_t*)(shm3+LDS_FB+(q0+qrel)*8); lower_=(__uint_as_float(e_[0]<<16)+__uint_as_float(e_[0]&0xffff0000u))+__uint_as_float(e_[1]<<16)-cb; }
  CINIT(pA0,pA1,0); qkt(pA0,pA1,Kbase,qr,r32,hi);asm volatile("s_nop 15\n\ts_nop 7":"+v"(pA0),"+v"(pA1));CMASK(pA0,pA1,0);
  START(pA0,pA1);
  _Pragma("unroll") for(int r=0;r<16;++r)pA1[r]=__builtin_amdgcn_exp2f(pA1[r]);
  if(pst){WAIT_BAR(4);}else{WAIT_BAR(0);}
  DMA_K(3,0);DMA_V(1,SLOTB);
  ROT();
  kload8(kf,kp0+sl_cur);
  WAIT_BAR(2);
  s16x4 vlo[8],vhi[8]; u32x4 pw0,pw1,pw2,pw3;
  #define PKW(P,B) cvtpk_s(P[B],P[B+1])
  #define PAF(k) __builtin_bit_cast(bf16x8,pw##k)
  #define VFR(i) (bf16x8){vlo[i][0],vlo[i][1],vlo[i][2],vlo[i][3],vhi[i][0],vhi[i][1],vhi[i][2],vhi[i][3]}
  #define PIN(x) asm volatile("":"+v"(x))
  #define MX3(a,b,c) __builtin_fmaxf(__builtin_fmaxf((a),(b)),(c))
  #define GAPA(MF,A0,A1,A2,A3,W0,W1,PW) do{ MF; sacc+=A0; sacc+=A1; sacc+=A2; sacc+=A3; PIN(sacc); W0; W1; PIN(PW); SBAR(); }while(0)
  #define EX(v) __builtin_amdgcn_exp2f(v)
  #define GAPB(MF,X,B) do{ MF; X[B]=EX(X[B]); X[B+1]=EX(X[B+1]); X[B+2]=EX(X[B+2]); X[B+3]=EX(X[B+3]); PIN(X); SBAR(); }while(0)
  #define VRD(i) do{ vlo[i]=vtr(vp_+(((i)>>2)*4096+((i)&3)*1024)); vhi[i]=vtr(vp_+(((i)>>2)*4096+((i)&3)*1024+512)); }while(0)
  #define KRD(G,j) do{ if(G){ kload2(kf,kp0+sl_next,j); SBAR(); } }while(0)
  #define STEP(C0,C1,P0,P1,t,GK,GV,GL) STEPX(C0,C1,P0,P1,t,GK,GV,GL,true)
  #define STEPX(C0,C1,P0,P1,t,GK,GV,GL,MX) do{ SBAR(); CINIT(C0,C1,t); SBAR(); \
    const lds_cptr vp_=vp0+sl_prev; \
    VRD(0); SBAR(); float sacc=(P0[0]+P0[1]); \
    GAPA(C0=__builtin_amdgcn_mfma_f32_32x32x16_bf16(kf[0],qr[0],C0,0,0,0), P0[2],P0[3],P0[4],P0[5],     pw0[0]=PKW(P0,0), pw0[1]=PKW(P0,2), pw0); \
    VRD(4); SBAR(); GAPA(C1=__builtin_amdgcn_mfma_f32_32x32x16_bf16(kf[1],qr[0],C1,0,0,0), P0[6],P0[7],P0[8],P0[9],     pw0[2]=PKW(P0,4), pw0[3]=PKW(P0,6), pw0); \
    VRD(1); SBAR(); GAPA(C0=__builtin_amdgcn_mfma_f32_32x32x16_bf16(kf[2],qr[1],C0,0,0,0),   P0[10],P0[11],P0[12],P0[13], pw1[0]=PKW(P0,8), pw1[1]=PKW(P0,10), pw1); \
    VRD(5); SBAR(); GAPA(C1=__builtin_amdgcn_mfma_f32_32x32x16_bf16(kf[3],qr[1],C1,0,0,0),   P0[14],P0[15],P1[0],P1[1],   pw1[2]=PKW(P0,12),pw1[3]=PKW(P0,14), pw1); \
    VRD(2); SBAR(); GAPA(C0=__builtin_amdgcn_mfma_f32_32x32x16_bf16(kf[4],qr[2],C0,0,0,0),   P1[2],P1[3],P1[4],P1[5],     pw2[0]=PKW(P1,0), pw2[1]=PKW(P1,2), pw2); \
    VRD(6); SBAR(); GAPA(C1=__builtin_amdgcn_mfma_f32_32x32x16_bf16(kf[5],qr[2],C1,0,0,0),   P1[6],P1[7],P1[8],P1[9],     pw2[2]=PKW(P1,4), pw2[3]=PKW(P1,6), pw2); \
    VRD(3); SBAR(); GAPA(C0=__builtin_amdgcn_mfma_f32_32x32x16_bf16(kf[6],qr[3],C0,0,0,0),   P1[10],P1[11],P1[12],P1[13], pw3[0]=PKW(P1,8), pw3[1]=PKW(P1,10), pw3); \
    VRD(7); SBAR(); GAPA(C1=__builtin_amdgcn_mfma_f32_32x32x16_bf16(kf[7],qr[3],C1,0,0,0),   P1[14],P1[15],0.f,0.f,       pw3[2]=PKW(P1,12),pw3[3]=PKW(P1,14), pw3); \
    l_reg+=sacc; \
    if(GK){DMA_K((t)+3,sl_cur);} if(GV){DMA_V((t)+1,sl_next);} \
    CMASK(C0,C1,t); \
    if(!(MX)){ resc=false; } else \
    { float a=MX3(C0[0],C0[1],C1[0]),b=MX3(C0[2],C0[3],C1[1]); a=MX3(a,C1[2],C1[3]); \
      _Pragma("unroll") for(int r=4;r<16;r+=4){a=MX3(a,C0[r],C0[r+1]);b=MX3(b,C0[r+2],C0[r+3]);a=MX3(a,C1[r],C1[r+1]);b=MX3(b,C1[r+2],C1[r+3]);} \
      float rm=__builtin_fmaxf(a,b); { auto rr=__builtin_amdgcn_permlane32_swap(__float_as_uint(rm),__float_as_uint(rm),false,false); rm=__builtin_fmaxf(__uint_as_float(rr[0]),__uint_as_float(rr[1])); } \
      resc=false; \
      if(__builtin_expect(__any(rm>(float)THRL),0)){ const float dl=__builtin_fmaxf(rm,0.f); mhat+=dl; \
        _Pragma("unroll") for(int r=0;r<16;++r){C0[r]-=dl;C1[r]-=dl;} \
        _Pragma("unroll") for(int r=0;r<16;++r)negm[r]=-mhat; asm volatile("":"+v"(negm)); \
        const float f=__builtin_amdgcn_exp2f(-dl); l_reg*=f; if(hi==0)wsf[r32]=f; resc=true; } } \
    SBAR(); \
    GAPB(o[0]=__builtin_amdgcn_mfma_f32_32x32x16_bf16(PAF(0),VFR(0),o[0],0,0,0), C0,0); \
    GAPB(o[1]=__builtin_amdgcn_mfma_f32_32x32x16_bf16(PAF(0),VFR(4),o[1],0,0,0), C0,4); \
    KRD(GL,0); GAPB(o[0]=__builtin_amdgcn_mfma_f32_32x32x16_bf16(PAF(1),VFR(1),o[0],0,0,0), C0,8); \
    KRD(GL,1); GAPB(o[1]=__builtin_amdgcn_mfma_f32_32x32x16_bf16(PAF(1),VFR(5),o[1],0,0,0), C0,12); \
    KRD(GL,2); GAPB(o[0]=__builtin_amdgcn_mfma_f32_32x32x16_bf16(PAF(2),VFR(2),o[0],0,0,0), C1,0); \
    KRD(GL,3); GAPB(o[1]=__builtin_amdgcn_mfma_f32_32x32x16_bf16(PAF(2),VFR(6),o[1],0,0,0), C1,4); \
    GAPB(o[0]=__builtin_amdgcn_mfma_f32_32x32x16_bf16(PAF(3),VFR(3),o[0],0,0,0), C1,8); \
    GAPB(o[1]=__builtin_amdgcn_mfma_f32_32x32x16_bf16(PAF(3),VFR(7),o[1],0,0,0), C1,12); \
    }while(0)
  int t=1;
  #define ENDW(tt) do{ if((tt)+3<NT){WAIT_BAR(2);} else if((tt)+2<NT){WAIT_BAR(1);} else {WAIT_BAR(0);} }while(0)
  #define GUARDED_PAIR() do{ \
    STEPX(pB0,pB1,pA0,pA1,t,(t+3<NT),(t+1<NT),(t+1<NT),!nomax);       ENDW(t);   RESC(); ROT(); \
    STEPX(pA0,pA1,pB0,pB1,t+1,(t+4<NT),(t+2<NT),(t+2<NT),!nomax);     ENDW(t+1); RESC(); ROT(); }while(0)
  for(;t<5&&t+1<NT;t+=2){ GUARDED_PAIR(); }
  #undef CMASK
  #define CMASK(P0,P1,t) do{}while(0)
  for(;t+5<NT;t+=2){
    STEPX(pB0,pB1,pA0,pA1,t,true,true,true,!nomax);     WAIT_BAR(2); RESC(); ROT();
    STEPX(pA0,pA1,pB0,pB1,t+1,true,true,true,!nomax);   WAIT_BAR(2); RESC(); ROT();
  }
  #undef CMASK
  #define CMASK(P0,P1,t) do{int jb_=3-(t); if(jb_>=0)cmask(P0,P1,jb_,qrel,hi);}while(0)
  for(;t+1<NT;t+=2){ GUARDED_PAIR(); }
  unsigned su_tk=0u; { const char*w_=AB.ws; asm volatile("":"+s"(w_)); if(tid==0)su_tk=__hip_atomic_fetch_add((unsigned*)(w_+AB.qat)+64*x,1u,__ATOMIC_RELAXED,__HIP_MEMORY_SCOPE_AGENT); }
  STEPX(pB0,pB1,pA0,pA1,NT-1,false,false,false,!nomax); RESC();
  { float sacc=pB0[0]+pB0[1]; _Pragma("unroll") for(int r=2;r<16;++r)sacc+=pB0[r]; _Pragma("unroll") for(int r=0;r<16;++r)sacc+=pB1[r]; l_reg+=sacc;
    pw0=(u32x4){PKW(pB0,0),PKW(pB0,2),PKW(pB0,4),PKW(pB0,6)};pw1=(u32x4){PKW(pB0,8),PKW(pB0,10),PKW(pB0,12),PKW(pB0,14)};pw2=(u32x4){PKW(pB1,0),PKW(pB1,2),PKW(pB1,4),PKW(pB1,6)};pw3=(u32x4){PKW(pB1,8),PKW(pB1,10),PKW(pB1,12),PKW(pB1,14)};
    SBAR(); pv(o,vb0+sl_cur,PAF(0),PAF(1),PAF(2),PAF(3)); }
  bf16*Ow; { const char*w_=AB.ws; asm volatile("":"+s"(w_)); Ow=(bf16*)(w_+AB.o)+(rowbase+q0+wid*QBLK)*ODM+h*D; }
  if(tid==0)*(volatile __attribute__((address_space(3))) unsigned*)(shm3+LDS_TICKET)=su_tk;
  asm volatile("s_waitcnt vmcnt(0) lgkmcnt(0)\n\ts_barrier":::"memory");
  nrank=32+__builtin_amdgcn_readfirstlane((int)*(volatile __attribute__((address_space(3))) unsigned*)(shm3+LDS_TICKET));
  #define UNIT_EPILOGUE() do{ \
  {auto rr=__builtin_amdgcn_permlane32_swap(__float_as_uint(l_reg),__float_as_uint(l_reg),false,false);l_reg=__uint_as_float(rr[0])+__uint_as_float(rr[1]);} \
  if(hi==0)wsf[32+r32]=l_reg;asm volatile("s_waitcnt lgkmcnt(0)":::"memory"); \
  float rli[16]; \
  _Pragma("unroll") \
  for(int r=0;r<16;++r)rli[r]=__builtin_amdgcn_rcpf(wsf[32+crow(r,hi)]); \
  { bf16*stg=(bf16*)(shm+LDS_OST)+wid*2048; \
    _Pragma("unroll") \
    for(int r=0;r<16;++r){const int orow=crow(r,hi); \
      _Pragma("unroll") \
      for(int d0=0;d0<2;++d0)stg[orow*64+d0*32+r32]=__float2bfloat16(o[d0][r]*rli[r]);} \
    asm volatile("s_waitcnt lgkmcnt(0)":::"memory"); \
    asm volatile("s_waitcnt vmcnt(0)":"+v"(qr[0]),"+v"(qr[1]),"+v"(qr[2]),"+v"(qr[3])::"memory"); \
    _Pragma("unroll") \
    for(int i=0;i<4;++i){const int row=i*8+(lane>>3),ch=lane&7; const u32x4 v=*(const u32x4*)(stg+row*64+ch*8); ATTN_STORE16(Ow+(long)row*ODM+ch*8,v);} } \
  }while(0)
  ++nu; const bool go_=(nrank<128)&&(nu<maxu);
  if(go_){ UNIT_ISSUE(nrank); }
  else{ qb=0;q0=0;h=0;NTF=0;kend=0;rowbase=0;Kh=nullptr;Vh=nullptr; su_bt=0.f;su_fcj=0.f;su_fc0=0.f;su_k0=0u;su_k1=0u;
    _Pragma("unroll") for(int r=0;r<8;++r){su_q[r]=0u;su_u[r]=0u;} su_v0=(f32x4_l){0.f,0.f,0.f,0.f};su_v1=su_v0;
    _Pragma("unroll") for(int d0=0;d0<4;++d0)qr[d0]=bf16x8{}; }
  UNIT_EPILOGUE();
  if(!go_)break;
  pst=true;
  }
  ndone+=nu;
  #undef UNIT_EPILOGUE
  #undef PKW
  #undef PAF
  #undef VFR
  #undef PIN
  #undef MX3
  #undef GAPA
  #undef GAPB
  #undef EX
  #undef VRD
  #undef KRD
  #undef STEP
  #undef STEPX
  #undef ENDW
  #undef GUARDED_PAIR
  #undef UNIT_ISSUE
  #undef WAVE_CONSTS
  #undef NRMW
  #undef DMA_K
  #undef DMA_V
  #undef CMASK
  #undef START
  #undef RESC
  #undef ROT
  #undef CINIT
  #undef XFR
  asm volatile("s_barrier":::"memory");
  return nrank;
}
constexpr int ATTN_LDS_BYTES=LDS_FB+LDS_FB_BYTES;
struct AttnTensors { const bf16* Q; const bf16* K; const bf16* V; bf16* O; const float* FC; const float* BT; };
struct AttnUnit { int bh; int qb; };
struct StaticOrder {
  int vcu;
  __device__ __forceinline__ explicit StaticOrder(int vcu_):vcu(vcu_){}
  __device__ __forceinline__ bool next(int i,AttnUnit&u)const{ if(i>=4||vcu>=256)return false; const int s=vcu&3; u.bh=vcu>>2; u.qb=(i==0)?s:(i==1)?7-s:(i==2)?8+s:15-s; return true; }
};
__device__ __forceinline__ int skip_tiles(const unsigned*nrm,const float*FCbh,const float offv,int bh,int qb,int lane,float&cb){
  const unsigned*qn=nrm+((size_t)bh*64)*2,*kn=nrm+((size_t)(64+bh)*64)*2;
  #define NRM2(p,i) (__uint_as_float(__hip_atomic_load((p)+2*(i),__ATOMIC_RELAXED,__HIP_MEMORY_SCOPE_AGENT))+__uint_as_float(__hip_atomic_load((p)+2*(i)+1,__ATOMIC_RELAXED,__HIP_MEMORY_SCOPE_AGENT)))
  const float kn2=NRM2(kn,lane);
  float qn2=0.f,ku2=0.f;
  #pragma unroll
  for(int r=0;r<4;++r){ qn2=fmaxf(qn2,NRM2(qn,4*qb+r)); ku2=fmaxf(ku2,NRM2(kn,4*qb+r)); }
  #undef NRM2
  const float Qm=sqrtf(qn2)*1.01f,Kj=sqrtf(kn2)*1.01f,Ku=sqrtf(ku2)*1.01f; cb=Qm*Ku;
  const float fbj=-(FCbh[64*lane+63]+pg8::lane_read(offv,lane>>1)),fb0=-(FCbh[256*qb]+pg8::lane_read(offv,2*qb));
  const bool needed=(lane>=4*qb)||!(Qm*(Kj+Ku)+fbj-fb0<-152.f);
  const unsigned long long mask=__ballot(needed);
  return (int)(__builtin_ctzll(mask))&~1;
}
template<int THRL=32,class Hook> __device__ __forceinline__ void attn_phase(char*lds,const AttnBase&AB,const int vcu,const int tid,Hook&hk){
#if PROBE_STEPS
  unsigned long long pa_=0ull,pb_=0ull,pc_=0ull;
#endif
  int x=vcu>>5,rank=vcu&31,steps=0,ndone=0;
  const int cvt_after=vcu&3; bool cvt_done=false,fin=false;
  volatile __attribute__((address_space(3))) int* tk=(volatile __attribute__((address_space(3))) int*)((lds_cptr)lds+LDS_TICKET);
  const bool young_=__builtin_amdgcn_readfirstlane(tid)>=256; if(young_)__builtin_amdgcn_s_setprio(1);
  #pragma nounroll
  for(;;){
    if(!cvt_done&&(fin||ndone>=cvt_after)){ if(young_)__builtin_amdgcn_s_setprio(0);
#if PROBE_STEPS
      const unsigned long long pq_=__builtin_amdgcn_s_memrealtime();
#endif
      hk.convert();
#if PROBE_STEPS
      pc_=__builtin_amdgcn_s_memrealtime()-pq_;
#endif
      if(young_)__builtin_amdgcn_s_setprio(1); cvt_done=true; }
    if(fin)break;
    if(rank<128){ rank=attn_units<THRL>(x,rank,AB,cvt_done?(1<<20):cvt_after-ndone,ndone,steps,lds); continue; }
    unsigned*qbase; { const char*w_=AB.ws; asm volatile("":"+s"(w_)); qbase=(unsigned*)(w_+AB.qat); }
    int t2_=threadIdx.x; asm volatile("":"+v"(t2_)); const int lane=t2_&63;
    if(t2_<64){ unsigned c=96u; if(lane<8)c=__hip_atomic_load(qbase+64*lane,__ATOMIC_RELAXED,__HIP_MEMORY_SCOPE_AGENT);
      int key=c<96u?(int)(((96u-c)<<3)|(unsigned)lane):0;
      #pragma unroll
      for(int o_=1;o_<8;o_<<=1){ const int t_=__builtin_amdgcn_ds_bpermute((lane^o_)<<2,key); key=key>t_?key:t_; }
      int xv=-1,rk=0;
      if(key>0){ xv=key&7; unsigned old=0u; if(lane==0)old=__hip_atomic_fetch_add(qbase+64*xv,1u,__ATOMIC_RELAXED,__HIP_MEMORY_SCOPE_AGENT); rk=32+(int)old; }
      if(lane==0){ tk[1]=xv; tk[2]=rk; } }
    __syncthreads();
    const int xv=__builtin_amdgcn_readfirstlane(tk[1]),rk=__builtin_amdgcn_readfirstlane(tk[2]);
    __syncthreads();
    if(xv<0){fin=true;continue;}
    x=xv; rank=rk;
  }
  if(young_)__builtin_amdgcn_s_setprio(0);
  { unsigned*pq; { const char*w_=AB.ws; asm volatile("":"+s"(w_)); pq=(unsigned*)(w_+AB.pq); }
    #pragma nounroll
    for(;;){ int t3_=threadIdx.x; asm volatile("":"+v"(t3_));
      if(t3_==0)tk[1]=(int)__hip_atomic_fetch_add(pq,1u,__ATOMIC_RELAXED,__HIP_MEMORY_SCOPE_AGENT);
      __syncthreads(); const int it=__builtin_amdgcn_readfirstlane(tk[1]); __syncthreads();
      if(it>=256)break;
      hk.block(it); } }
  hk.steps=steps;
#if PROBE_STEPS
  if(PROBE_STEPS==7)hk.steps=(int)((pb_-pa_)/10ull);
  if(PROBE_STEPS==8)hk.steps=(int)(pc_/10ull);
#endif
}
#undef SBAR
#undef WAIT_BAR
}

constexpr int NWAVES = 8;
#ifndef MK_PER_PHASE
#define MK_PER_PHASE 0
#endif
constexpr int BATCH = 8, SEQ = 4096, T = BATCH * SEQ, D = 1024, NL = 2, NH = 8, HD = 64, AW = 512, PW = 512, INW = 2056, NG = 4, NE = 8, NX = 32, FE = 256;
constexpr float RMS_EPS = 1e-6f;
constexpr int NPH = 16;
constexpr size_t MiB = 1u << 20;
constexpr size_t WS_CTL = 0, CTL_ZERO_BYTES = 1 * MiB;
constexpr size_t WS_MOD = 1 * MiB;
constexpr size_t WS_FRF = 1 * MiB + 512 * 1024;
constexpr size_t WS_RRF = WS_FRF + 128 * 1024;
constexpr size_t WS_FL = 2 * MiB;
constexpr size_t WS_FC = 3 * MiB;
constexpr size_t WS_CW = 4 * MiB;
constexpr size_t WS_LIST = 5 * MiB;
constexpr size_t WS_WIN = 10 * MiB, WS_WOUT = 18 * MiB, WS_WGU = 22 * MiB, WS_WD = 86 * MiB;
constexpr size_t WS_H = 118 * MiB;
constexpr size_t WS_QKVU = 182 * MiB;
constexpr size_t WS_AO = 310 * MiB;
constexpr size_t WS_DL = 374 * MiB;
constexpr size_t WS_XB = 438 * MiB;
constexpr size_t WS_END = 502 * MiB;
constexpr int CW_TIL = 98304, TIL_STRIDE = 320 * 64;
constexpr int CW_NRM = 32768, NRM_WORDS = 2 * 64 * 64 * 2;
constexpr int CW_PQ = 13312;
constexpr int CW_QAT = 12288;
constexpr int CW_TMO = 0, CW_CODE = 1, CW_BAR = 4096, CW_CNT = 16384;
constexpr int RING_OFF = 0, RING_BYTES = 131072;
constexpr int LDSCTL_OFF = RING_BYTES, MISC_OFF = LDSCTL_OFF + 320;
constexpr int ENT_OFF = LDSCTL_OFF + 1024, ENT_UNITS = 8;
constexpr int CWT_OFF = ENT_OFF + ENT_UNITS * 1024;
constexpr int TST_OFF = CWT_OFF + 3 * 1024;
constexpr int LDS_BYTES = 147456;
static_assert(TST_OFF + (65 + 4 * ENT_UNITS + 2) * 4 <= LDS_BYTES && MISC_OFF + 128 <= ENT_OFF, "LDS map");

#define GAS __attribute__((address_space(1)))
#define LAS __attribute__((address_space(3)))
typedef unsigned short bf16;
typedef unsigned v4u __attribute__((ext_vector_type(4)));
typedef float f32x4 __attribute__((ext_vector_type(4)));
typedef short bf16x8 __attribute__((ext_vector_type(8)));
typedef GAS unsigned gu32;
typedef GAS unsigned long long gu64;
#define RLX_AGENT __ATOMIC_RELAXED, __HIP_MEMORY_SCOPE_AGENT
#define LDS_WAIT() asm volatile("s_waitcnt lgkmcnt(0)" ::: "memory")
#define VM_WAIT() asm volatile("s_waitcnt vmcnt(0)" ::: "memory")
__device__ __forceinline__ unsigned long long rt() { return __builtin_amdgcn_s_memrealtime(); }
__device__ __forceinline__ unsigned f2bf(float f) { unsigned u = __builtin_bit_cast(unsigned, f); return (u + 0x7fffu + ((u >> 16) & 1u)) >> 16; }
__device__ __forceinline__ unsigned pk2(float lo, float hi) { return f2bf(lo) | (f2bf(hi) << 16); }

#define XB_TMO      128
#define XB_XCNT(j)  (256  + 64 * (j))
#define XB_XSUB(j)  (1280 + 64 * (j))
#define XB_XGEN(j)  (2304 + 64 * (j))
#define XB_TOP      3328
#define XB_TOPGEN   3392
#define XCD_BAR_WORDS 3456
#define XB_SPIN_CAP (1u << 18)

__device__ __forceinline__ unsigned xb_ld(unsigned* p)              { return __hip_atomic_load(p, __ATOMIC_RELAXED, __HIP_MEMORY_SCOPE_AGENT); }
__device__ __forceinline__ unsigned xb_add(unsigned* p, unsigned v) { return __hip_atomic_fetch_add(p, v, __ATOMIC_RELAXED, __HIP_MEMORY_SCOPE_AGENT); }
__device__ __forceinline__ unsigned xb_xcc_id() { return (unsigned)__builtin_amdgcn_s_getreg((3 << 11) | 20) & 0xFu; }
#define XB_SPIN(cond, bar) do { unsigned _sp = 0; while (cond) { __builtin_amdgcn_s_sleep(1); \
    if ((++_sp & 255u) == 0u) { if (xb_ld(&(bar)[XB_TMO])) break; if (_sp > XB_SPIN_CAP) { atomicAdd(&(bar)[XB_TMO], 1u); break; } } } } while (0)

struct XcdBarrier {
    unsigned* bar; unsigned x;
    volatile LAS unsigned* st;
};

__device__ __forceinline__ XcdBarrier xcd_barrier_post(unsigned* bar, volatile LAS unsigned* st) {
    XcdBarrier b; b.bar = bar; b.x = xb_xcc_id(); b.st = st;
    if (threadIdx.x == 0) (void)xb_add(&bar[XB_XCNT(b.x)], 1u);
    return b;
}
__device__ __forceinline__ void xcd_barrier_complete(unsigned* bar, unsigned x, unsigned& nloc, unsigned& nx) {
    const unsigned G = gridDim.x * gridDim.y * gridDim.z;
    unsigned sum, cnt, mine, sp = 0u;
    for (;;) {
        sum = 0u; cnt = 0u; mine = 0u;
#pragma unroll
        for (unsigned j = 0; j < 16; ++j) { const unsigned c = xb_ld(&bar[XB_XCNT(j)]); sum += c; cnt += (c > 0u) ? 1u : 0u; mine = (j == x) ? c : mine; }
        if (sum == G) break;
        __builtin_amdgcn_s_sleep(1);
        if ((++sp & 255u) == 0u) { if (xb_ld(&bar[XB_TMO])) break; if (sp > XB_SPIN_CAP) { atomicAdd(&bar[XB_TMO], 1u); break; } }
    }
    nloc = mine > 0u ? mine : 1u; nx = cnt > 0u ? cnt : 1u;
}

__device__ __forceinline__ void xcd_barrier(const XcdBarrier& b) {
    asm volatile("s_waitcnt vmcnt(0)" ::: "memory");
    __syncthreads();
    if (threadIdx.x == 0) {
        unsigned* bar = b.bar;
        __builtin_amdgcn_s_waitcnt(0);
        unsigned nloc = b.st[0], nx = b.st[1];
        if (nloc == 0u) { xcd_barrier_complete(bar, b.x, nloc, nx); b.st[0] = nloc; b.st[1] = nx; }
        const unsigned old = xb_add(&bar[XB_XSUB(b.x)], 1u);
        const unsigned gen = old / nloc;
        if (old + 1u == (gen + 1u) * nloc) {
            __builtin_amdgcn_fence(__ATOMIC_RELEASE, "agent");
            asm volatile("s_waitcnt vmcnt(0)" ::: "memory");
            const unsigned og = xb_add(&bar[XB_TOP], 1u);
            const unsigned tg = og / nx;
            if (og + 1u == (tg + 1u) * nx) xb_add(&bar[XB_TOPGEN], 1u);
            else XB_SPIN(xb_ld(&bar[XB_TOPGEN]) == tg, bar);
            __builtin_amdgcn_fence(__ATOMIC_ACQUIRE, "agent");
            xb_add(&bar[XB_XGEN(b.x)], 1u);
            asm volatile("s_waitcnt vmcnt(0)" ::: "memory");
        } else {
            XB_SPIN(xb_ld(&bar[XB_XGEN(b.x)]) == gen, bar);
            __builtin_amdgcn_fence(__ATOMIC_ACQUIRE, "agent");
            asm volatile("s_waitcnt vmcnt(0)" ::: "memory");
        }
    }
    __syncthreads();
}

struct Frame {
    LAS unsigned char* lds;
    volatile LAS unsigned* MISC;
    gu32* ctl;
    int tid, lane, wave;
    int vcu, G;
};
typedef unsigned u32x4v __attribute__((ext_vector_type(4)));
__device__ __forceinline__ float bflo(unsigned w) { return __builtin_bit_cast(float, w << 16); }
__device__ __forceinline__ float bfhi(unsigned w) { return __builtin_bit_cast(float, w & 0xffff0000u); }
__device__ __forceinline__ unsigned cvtpk(float lo, float hi) { unsigned r; asm volatile("v_cvt_pk_bf16_f32 %0, %1, %2" : "=v"(r) : "v"(lo), "v"(hi)); return r; }

__device__ __forceinline__ void transpose_load64(f32x4 (&v)[16], const float* W, int ldw, int k0, int n0src, int lane) {
    const float* src = W + (size_t)(k0 + (lane >> 4)) * ldw + n0src + 4 * (lane & 15);
#pragma unroll
    for (int i = 0; i < 16; ++i) v[i] = *(const f32x4*)(src + (size_t)(4 * i) * ldw);
}
__device__ __forceinline__ void transpose_finish64(const f32x4 (&v)[16], bf16* WT, int ldt, int k0, int dstrow0, LAS float* scr, int lane) {
#pragma unroll
    for (int i = 0; i < 16; ++i) { const int k = 4 * i + (lane >> 4); const int col = (4 * (lane & 15) + 8 * (k >> 3)) & 63; *(LAS f32x4*)(scr + k * 64 + col) = v[i]; }
    LDS_WAIT(); asm volatile("" ::: "memory");
    const int c = lane >> 3;
#pragma unroll
    for (int q = 0; q < 8; ++q) { const int n = (lane & 7) + 8 * q; const LAS float* s_ = scr + (8 * c) * 64 + ((n + 8 * c) & 63);
        v4u o; o.x = pk2(s_[0], s_[64]); o.y = pk2(s_[128], s_[192]); o.z = pk2(s_[256], s_[320]); o.w = pk2(s_[384], s_[448]);
        *(GAS v4u*)(WT + (size_t)(dstrow0 + n) * ldt + k0 + 8 * c) = o; }
    LDS_WAIT(); asm volatile("" ::: "memory");
}
__device__ __forceinline__ void transpose_item64(const float* W, int ldw, bf16* WT, int ldt, int k0, int n0src, int dstrow0, LAS float* scr, int lane) {
    f32x4 v[16];
    transpose_load64(v, W, ldw, k0, n0src, lane);
    asm volatile("" ::: "memory"); __builtin_amdgcn_sched_barrier(0);
    transpose_finish64(v, WT, ldt, k0, dstrow0, scr, lane);
}
struct In {
    const float *x, *c, *g_mix, *g_ffn, *g_fin, *w_ada, *b_ada, *w_in, *b_fg, *w_pool, *pool_scale, *w_out, *w_rg, *b_rg, *w_re, *b_re, *w_eg, *w_eu, *w_ed;
};
__device__ __forceinline__ void p0_prologue(Frame& F, const In& I, unsigned char* ws, int mode) {
    bf16* WinT = (bf16*)(ws + WS_WIN); bf16* WoutT = (bf16*)(ws + WS_WOUT);
    float* MOD = (float*)(ws + WS_MOD);
#ifndef WG_REPS
#define WG_REPS 1
#endif
#pragma nounroll
    for (int wrp = 0; wrp < WG_REPS; ++wrp)
    if (mode != 1 && F.vcu < 64) {
        const int l = F.vcu >> 5, g = (F.vcu >> 3) & 3, nb = F.vcu & 7;
        LAS float* ApT = (LAS float*)F.lds;
        LAS float* Bw = ApT + 128 * 128;
        const float* wp = I.w_pool + (size_t)(l * 4 + g) * 128 * 128; const float* ps = I.pool_scale + l * 512 + g * 128;
        const float* wo = I.w_out + (size_t)l * D * D + (size_t)(512 + 128 * g) * D + 128 * nb;
        { f32x4 va[8], vb[8];
#pragma unroll
          for (int j = 0; j < 8; ++j) { const int q4 = F.tid + 512 * j; const int r = q4 >> 5, c4 = (q4 & 31) * 4; va[j] = *(const f32x4*)(wp + r * 128 + c4); vb[j] = *(const f32x4*)(wo + (size_t)r * D + c4); }
#pragma unroll
          for (int j = 0; j < 8; ++j) { const int q4 = F.tid + 512 * j; const int r = q4 >> 5, c4 = (q4 & 31) * 4;
              const f32x4 p4 = *(const f32x4*)(ps + c4);
              const int rs = r ^ (((c4 >> 2) & 15) << 3);
              ApT[(c4 + 0) * 128 + rs] = va[j][0] * p4[0]; ApT[(c4 + 1) * 128 + rs] = va[j][1] * p4[1]; ApT[(c4 + 2) * 128 + rs] = va[j][2] * p4[2]; ApT[(c4 + 3) * 128 + rs] = va[j][3] * p4[3];
              *(LAS f32x4*)(Bw + r * 128 + c4) = vb[j]; } }
        __syncthreads();
        const int tn = F.tid & 31, tc = F.tid >> 5;
        float acc[4][8];
#pragma unroll
        for (int i = 0; i < 4; ++i)
#pragma unroll
            for (int j = 0; j < 8; ++j) acc[i][j] = 0.f;
#pragma unroll 2
        for (int d = 0; d < 128; ++d) { const f32x4 bv = *(const LAS f32x4*)(Bw + d * 128 + 4 * tn);
            const int cs = (8 * tc) ^ (((d >> 2) & 15) << 3);
            const f32x4 a0 = *(const LAS f32x4*)(ApT + d * 128 + cs), a1 = *(const LAS f32x4*)(ApT + d * 128 + cs + 4);
#pragma unroll
            for (int i = 0; i < 4; ++i) { acc[i][0] += a0[0] * bv[i]; acc[i][1] += a0[1] * bv[i]; acc[i][2] += a0[2] * bv[i]; acc[i][3] += a0[3] * bv[i];
                acc[i][4] += a1[0] * bv[i]; acc[i][5] += a1[1] * bv[i]; acc[i][6] += a1[2] * bv[i]; acc[i][7] += a1[3] * bv[i]; } }
#pragma unroll
        for (int i = 0; i < 4; ++i) { bf16* dst = WoutT + (size_t)l * D * D + (size_t)(128 * nb + 4 * tn + i) * D + 512 + 128 * g + 8 * tc;
            v4u o; o.x = pk2(acc[i][0], acc[i][1]); o.y = pk2(acc[i][2], acc[i][3]); o.z = pk2(acc[i][4], acc[i][5]); o.w = pk2(acc[i][6], acc[i][7]);
            *(GAS v4u*)dst = o; }
        __syncthreads();
    } else if (mode != 1 && F.vcu < 256) {
        const int it = F.vcu - 64, l = it / 96, n0 = 64 * (it % 96);
        LAS float* cT = (LAS float*)F.lds;
        LAS float* part = (LAS float*)(F.lds + 32768);
        { float cv[16];
#pragma unroll
          for (int j = 0; j < 16; ++j) cv[j] = I.c[F.tid + 512 * j];
          asm volatile("" ::: "memory"); __builtin_amdgcn_sched_barrier(0);
#pragma unroll
          for (int j = 0; j < 16; ++j) { const int q = F.tid + 512 * j; const int b = q >> 10, k = q & 1023; cT[k * 8 + b] = cv[j] / (1.f + __expf(-cv[j])); } }
        __syncthreads();
        const int r4 = F.lane >> 4, c16 = F.lane & 15;
        const char* wb = (const char*)(I.w_ada + (size_t)l * D * 6144 + n0);
        const unsigned off0 = (unsigned)(((F.wave * 128 + r4) * 6144 + 4 * c16) * 4);
        float acc[8][4];
#pragma unroll
        for (int b = 0; b < 8; ++b) { acc[b][0] = 0.f; acc[b][1] = 0.f; acc[b][2] = 0.f; acc[b][3] = 0.f; }
#pragma unroll 1
        for (int kb = 0; kb < 2; ++kb) {
            f32x4 wv[16];
#pragma unroll
            for (int j = 0; j < 16; ++j) wv[j] = *(const f32x4*)(wb + (off0 + (unsigned)((kb * 64 + 4 * j) * 6144 * 4)));
            asm volatile("" ::: "memory"); __builtin_amdgcn_sched_barrier(0);
#pragma unroll
            for (int j = 0; j < 16; ++j) { const int k = F.wave * 128 + kb * 64 + 4 * j + r4;
                if ((j & 3) == 0) asm volatile("" ::: "memory");
                const f32x4 c0 = *(const LAS f32x4*)(cT + k * 8), c1 = *(const LAS f32x4*)(cT + k * 8 + 4);
#pragma unroll
                for (int i = 0; i < 4; ++i) { acc[0][i] += c0[0] * wv[j][i]; acc[1][i] += c0[1] * wv[j][i]; acc[2][i] += c0[2] * wv[j][i]; acc[3][i] += c0[3] * wv[j][i];
                    acc[4][i] += c1[0] * wv[j][i]; acc[5][i] += c1[1] * wv[j][i]; acc[6][i] += c1[2] * wv[j][i]; acc[7][i] += c1[3] * wv[j][i]; } }
        }
#pragma unroll
        for (int b = 0; b < 8; ++b) *(LAS f32x4*)(part + ((F.wave * 4 + r4) * 8 + b) * 64 + 4 * c16) = (f32x4){acc[b][0], acc[b][1], acc[b][2], acc[b][3]};
        __syncthreads();
        { const int b = F.wave; float s = I.b_ada[l * 6144 + n0 + F.lane];
#pragma unroll
            for (int sl = 0; sl < 32; ++sl) s += part[(sl * 8 + b) * 64 + F.lane];
            MOD[(size_t)(l * 8 + b) * 6144 + n0 + F.lane] = s; }
        __syncthreads();
    }
    { const int q = (F.G - 1 - F.vcu) * (NWAVES * 64) + F.tid;
      if (mode != 1 && q < NL * 32 * 4 * 64) {
        const int l = q >> 13, c = (q >> 8) & 31, nb4 = (q >> 6) & 3, ln = q & 63; const int n = ln & 15, k0 = 32 * c + 8 * (ln >> 4);
        const float* base; size_t stride; bool valid;
        if (nb4 == 3) { valid = n < 8; base = I.w_in + (size_t)l * D * INW + 1536 + (valid ? n : 0); stride = INW; }
        else { const int col = 16 * nb4 + n; valid = col < 36;
            if (col < 4) { base = I.w_rg + (size_t)l * D * 4 + col; stride = 4; }
            else { const int cc = valid ? col - 4 : 0; base = I.w_re + ((size_t)(l * 4 + (cc >> 3)) * D) * 8 + (cc & 7); stride = 8; } }
        float v[8];
#pragma unroll
        for (int j = 0; j < 8; ++j) v[j] = base[(size_t)(k0 + j) * stride];
#pragma unroll
        for (int j = 0; j < 8; ++j) v[j] = valid ? v[j] : 0.f;
        unsigned hi[4], lo[4];
#pragma unroll
        for (int j = 0; j < 4; ++j) { hi[j] = pk2(v[2 * j], v[2 * j + 1]); lo[j] = pk2(v[2 * j] - bflo(hi[j]), v[2 * j + 1] - bfhi(hi[j])); }
        v4u* dst = (nb4 == 3) ? (v4u*)(ws + WS_FRF) + ((size_t)(l * 32 + c) * 2) * 64 + ln : (v4u*)(ws + WS_RRF) + (((size_t)(l * 32 + c) * 3 + nb4) * 2) * 64 + ln;
        dst[0] = (v4u){hi[0], hi[1], hi[2], hi[3]}; dst[64] = (v4u){lo[0], lo[1], lo[2], lo[3]};
      } }
    LAS float* scr = (LAS float*)(F.lds + RING_OFF + F.wave * 16384);
    const int gw = (F.G - 1 - F.vcu) * NWAVES + F.wave, NGW = F.G * NWAVES;
    constexpr int IT_IN = 512, IT_OUT = 128, IT_L = IT_IN + IT_OUT;
#ifndef TR_REPS
#define TR_REPS 1
#endif
#pragma nounroll
    for (int trp = 0; trp < TR_REPS; ++trp)
    for (int it = gw; it < NL * IT_L; it += NGW) {
        const int l = it / IT_L; int r = it - l * IT_L;
        if (r < IT_IN) { const int kb = r >> 5, nb = r & 31; const int n0 = 64 * nb;
            transpose_item64(I.w_in + (size_t)l * D * INW, INW, WinT + (size_t)l * 2048 * D, D, 64 * kb, n0 < 1536 ? n0 : n0 + 8, n0, scr, F.lane); continue; }
        r -= IT_IN;
        if (r < IT_OUT) { const int kb = r >> 4, nb = r & 15;
            transpose_item64(I.w_out + (size_t)l * D * D, D, WoutT + (size_t)l * D * D, D, 64 * kb, 64 * nb, 64 * nb, scr, F.lane); continue; }
    }
}

struct NormArgs {
    const float* xin; const bf16* xinb;
    bf16* xwb; float* out;
    const unsigned char* Y0; const unsigned char* Y1; const float* gate;
    const bf16* Dl;
    const float* gamma; const float* scale; const float* shift;
    bf16* H; const v4u* frag;
    const float* bias0; const float* bias1;
    float* FL; float* BT; float* CW; unsigned* LIST; gu32* cnt;
};
template <bool XBF, bool ADD_D, bool ADD_Y, bool WRITE_XB, int NB, bool FINAL>
__device__ __forceinline__ void norm_phase(Frame& F, const NormArgs& A) {
    constexpr int NBX = NB > 0 ? NB : 1, LGW = 16 * NBX;
    LAS float* gm = (LAS float*)F.lds; LAS float* shl = gm + 1024; LAS float* gtl = shl + 1024;
    LAS float* SSP = (LAS float*)(F.lds + 12288);
    LAS float* LGP = (LAS float*)(F.lds + 16384);
    LAS float* LGA = (LAS float*)(F.lds + 40960);
    LAS int* lcnt = (LAS int*)(F.lds + 65536); LAS int* gbase = lcnt + 32;
    const int tok0 = F.vcu * 128, b = tok0 >> 12;
    float tg_[2], tsc_[2], tsh_[2], tgt_[2];
#pragma unroll
    for (int j = 0; j < 2; ++j) { const int k = F.tid + NWAVES * 64 * j; tg_[j] = A.gamma[k]; tsc_[j] = FINAL ? 0.f : A.scale[(size_t)b * 6144 + k]; tsh_[j] = FINAL ? 0.f : A.shift[(size_t)b * 6144 + k];
        tgt_[j] = ADD_Y ? A.gate[(size_t)b * 6144 + k] : 0.f; }
    if (NB == 3 && F.tid < 32) lcnt[F.tid] = 0;
    const int i16 = F.lane & 15, kq = F.lane >> 4, kcol = 128 * F.wave + 8 * kq;
    bf16x8 Bh[NB > 0 ? 4 : 1][NBX], Bl[NB > 0 ? 4 : 1][NBX];
    if constexpr (NB > 0) {
#pragma unroll
        for (int c = 0; c < 4; ++c)
#pragma unroll
            for (int nb = 0; nb < NB; ++nb) { const size_t fi = ((size_t)((4 * F.wave + c) * NB + nb) * 2) * 64 + F.lane;
                Bh[c][nb] = __builtin_bit_cast(bf16x8, A.frag[fi]); Bl[c][nb] = __builtin_bit_cast(bf16x8, A.frag[fi + 64]); }
    }
    f32x4 xa[XBF ? 1 : 4][2], xn[XBF ? 1 : 4][2]; v4u xba[4], xbn[4], da[4], dn[4]; typedef unsigned v2u __attribute__((ext_vector_type(2))); v2u ya[2][4], yn[2][4];
#define NORM_LOAD(dst, bdst, ydst, ddst, it_) do { const size_t ro_ = (size_t)(tok0 + 16 * (it_) + i16) * D + kcol; \
        _Pragma("unroll") for (int c = 0; c < 4; ++c) { \
            if constexpr (XBF) bdst[c] = *(const v4u*)(A.xinb + ro_ + 32 * c); \
            else { dst[c][0] = *(const f32x4*)(A.xin + ro_ + 32 * c); dst[c][1] = *(const f32x4*)(A.xin + ro_ + 32 * c + 4); } \
            if (ADD_D) ddst[c] = *(const v4u*)(A.Dl + ro_ + 32 * c); \
            if (ADD_Y) { ydst[0][c] = *(const v2u*)(A.Y0 + ro_ + 32 * c); ydst[1][c] = *(const v2u*)(A.Y1 + ro_ + 32 * c); } } } while (0)
#define NORM_STEP(XA_, XBA_, YA_, DA_, IT_) do { \
        const size_t ro = (size_t)(tok0 + 16 * (IT_) + i16) * D + kcol; \
        f32x4 xv[4][2]; \
        float ss = 0.f; \
_Pragma("unroll") \
        for (int c = 0; c < 4; ++c) { \
            f32x4 a0, a1; \
            if constexpr (XBF) { const v4u xb = XBA_[c]; a0 = (f32x4){bflo(xb.x), bfhi(xb.x), bflo(xb.y), bfhi(xb.y)}; a1 = (f32x4){bflo(xb.z), bfhi(xb.z), bflo(xb.w), bfhi(xb.w)}; } \
            else { a0 = XA_[c][0]; a1 = XA_[c][1]; } \
            if (ADD_D) { const v4u d = DA_[c]; \
                a0[0] += bflo(d.x); a0[1] += bfhi(d.x); a0[2] += bflo(d.y); a0[3] += bfhi(d.y); a1[0] += bflo(d.z); a1[1] += bfhi(d.z); a1[2] += bflo(d.w); a1[3] += bfhi(d.w); } \
            if (ADD_Y) { const f32x4 g0 = *(const LAS f32x4*)(gtl + kcol + 32 * c), g1 = *(const LAS f32x4*)(gtl + kcol + 32 * c + 4); const v2u y0 = YA_[0][c], y1 = YA_[1][c]; typedef float f32x2u __attribute__((ext_vector_type(2))); \
                const f32x2u p0 = __builtin_amdgcn_cvt_pk_f32_fp8((int)y0[0], false) + __builtin_amdgcn_cvt_pk_f32_fp8((int)y1[0], false), p1 = __builtin_amdgcn_cvt_pk_f32_fp8((int)y0[0], true) + __builtin_amdgcn_cvt_pk_f32_fp8((int)y1[0], true); \
                const f32x2u p2 = __builtin_amdgcn_cvt_pk_f32_fp8((int)y0[1], false) + __builtin_amdgcn_cvt_pk_f32_fp8((int)y1[1], false), p3 = __builtin_amdgcn_cvt_pk_f32_fp8((int)y0[1], true) + __builtin_amdgcn_cvt_pk_f32_fp8((int)y1[1], true); \
                a0[0] += g0[0] * p0[0]; a0[1] += g0[1] * p0[1]; a0[2] += g0[2] * p1[0]; a0[3] += g0[3] * p1[1]; a1[0] += g1[0] * p2[0]; a1[1] += g1[1] * p2[1]; a1[2] += g1[2] * p3[0]; a1[3] += g1[3] * p3[1]; } \
            if (WRITE_XB) { v4u xo; xo.x = cvtpk(a0[0], a0[1]); xo.y = cvtpk(a0[2], a0[3]); xo.z = cvtpk(a1[0], a1[1]); xo.w = cvtpk(a1[2], a1[3]); *(v4u*)(A.xwb + ro + 32 * c) = xo; } \
            xv[c][0] = a0; xv[c][1] = a1; \
            ss += (a0[0] * a0[0] + a0[1] * a0[1]) + (a0[2] * a0[2] + a0[3] * a0[3]) + (a1[0] * a1[0] + a1[1] * a1[1]) + (a1[2] * a1[2] + a1[3] * a1[3]); \
        } \
        { auto r16_ = __builtin_amdgcn_permlane16_swap(__float_as_uint(ss), __float_as_uint(ss), false, false); ss = __uint_as_float(r16_[0]) + __uint_as_float(r16_[1]); \
          auto r32_ = __builtin_amdgcn_permlane32_swap(__float_as_uint(ss), __float_as_uint(ss), false, false); ss = __uint_as_float(r32_[0]) + __uint_as_float(r32_[1]); }     \
        LAS float* ssp = SSP + ((IT_) & 1) * 128; \
        if (kq == 0) ssp[F.wave * 16 + i16] = ss; \
        __syncthreads(); \
        float tot = 0.f; \
_Pragma("unroll") \
        for (int w = 0; w < 8; ++w) tot += ssp[w * 16 + i16]; \
        const float rstd = 1.0f / sqrtf(tot * (1.0f / D) + RMS_EPS); \
        f32x4 acc[NBX]; \
_Pragma("unroll") \
        for (int nb = 0; nb < NBX; ++nb) acc[nb] = (f32x4){0.f, 0.f, 0.f, 0.f}; \
_Pragma("unroll") \
        for (int c = 0; c < 4; ++c) { \
            const f32x4 m0 = *(const LAS f32x4*)(gm + kcol + 32 * c), m1 = *(const LAS f32x4*)(gm + kcol + 32 * c + 4); \
            const f32x4 s0 = *(const LAS f32x4*)(shl + kcol + 32 * c), s1 = *(const LAS f32x4*)(shl + kcol + 32 * c + 4); \
            const f32x4 h0 = xv[c][0] * rstd * m0 + s0, h1 = xv[c][1] * rstd * m1 + s1; \
            if (FINAL) { *(f32x4*)(A.out + ro + 32 * c) = h0; *(f32x4*)(A.out + ro + 32 * c + 4) = h1; } \
            else { \
                v4u hi; hi.x = cvtpk(h0[0], h0[1]); hi.y = cvtpk(h0[2], h0[3]); hi.z = cvtpk(h1[0], h1[1]); hi.w = cvtpk(h1[2], h1[3]); \
                *(v4u*)(A.H + ro + 32 * c) = hi; \
                if constexpr (NB > 0) { \
                    v4u lo; lo.x = cvtpk(h0[0] - bflo(hi.x), h0[1] - bfhi(hi.x)); lo.y = cvtpk(h0[2] - bflo(hi.y), h0[3] - bfhi(hi.y)); \
                    lo.z = cvtpk(h1[0] - bflo(hi.z), h1[1] - bfhi(hi.z)); lo.w = cvtpk(h1[2] - bflo(hi.w), h1[3] - bfhi(hi.w)); \
                    const bf16x8 Ah = __builtin_bit_cast(bf16x8, hi), Al = __builtin_bit_cast(bf16x8, lo); \
_Pragma("unroll") \
                    for (int nb = 0; nb < NB; ++nb) { \
                        acc[nb] = __builtin_amdgcn_mfma_f32_16x16x32_bf16(Ah, Bh[c][nb], acc[nb], 0, 0, 0); \
                        acc[nb] = __builtin_amdgcn_mfma_f32_16x16x32_bf16(Al, Bh[c][nb], acc[nb], 0, 0, 0); \
                        acc[nb] = __builtin_amdgcn_mfma_f32_16x16x32_bf16(Ah, Bl[c][nb], acc[nb], 0, 0, 0); } \
                } \
            } \
        } \
        if constexpr (NB > 0) { \
_Pragma("unroll") \
            for (int nb = 0; nb < NB; ++nb) \
_Pragma("unroll") \
                for (int r = 0; r < 4; ++r) LGP[(F.wave * 16 + 4 * kq + r) * LGW + 16 * nb + i16] = acc[nb][r]; \
            __syncthreads(); \
            for (int q = F.tid; q < 16 * LGW; q += NWAVES * 64) { float s = 0.f; \
_Pragma("unroll") \
                for (int w = 0; w < 8; ++w) s += LGP[w * 16 * LGW + q]; \
                LGA[(IT_) * 16 * LGW + q] = s; } \
        } \
    } while (0)
    NORM_LOAD(xa, xba, ya, da, 0);
#pragma unroll
    for (int j = 0; j < 2; ++j) { const int k = F.tid + NWAVES * 64 * j; gm[k] = FINAL ? tg_[j] : tg_[j] * (1.f + tsc_[j]); shl[k] = tsh_[j];
        if (ADD_Y) gtl[k] = tgt_[j] * (1.0f / 16.0f); }
    __syncthreads();
#pragma nounroll
    for (int it = 0; it < 8; it += 2) {
        NORM_LOAD(xn, xbn, yn, dn, it + 1);
        NORM_STEP(xa, xba, ya, da, it);
        NORM_LOAD(xa, xba, ya, da, (it + 2 < 8 ? it + 2 : 7));
        NORM_STEP(xn, xbn, yn, dn, it + 1);
    }
#undef NORM_STEP
#undef NORM_LOAD
    __syncthreads();
    if constexpr (NB == 1) {
        const int hh = F.wave, r0 = 2 * F.lane;
        const float bb = A.bias0[hh]; const float z0 = LGA[r0 * LGW + hh] + bb, z1 = LGA[(r0 + 1) * LGW + hh] + bb;
        const float v0 = fminf(z0, 0.f) - log1pf(__expf(-fabsf(z0))), v1 = fminf(z1, 0.f) - log1pf(__expf(-fabsf(z1)));
        float sc = v0 + v1;
#define NP_DPPF(V, CTRL, RM) __builtin_bit_cast(float, __builtin_amdgcn_update_dpp(0, __builtin_bit_cast(int, V), CTRL, RM, 0xf, true))
        sc += NP_DPPF(sc, 0x111, 0xf); sc += NP_DPPF(sc, 0x112, 0xf); sc += NP_DPPF(sc, 0x114, 0xf); sc += NP_DPPF(sc, 0x118, 0xf);
        sc += NP_DPPF(sc, 0x142, 0xa); sc += NP_DPPF(sc, 0x143, 0xc);
#undef NP_DPPF
        const float ex = sc - (v0 + v1); const float L2E = 1.4426950408889634f;
        typedef float f32x2n __attribute__((ext_vector_type(2)));
        *(f32x2n*)(A.FL + ((size_t)(b * 8 + hh) << 12) + (tok0 & (SEQ - 1)) + r0) = (f32x2n){(ex + v0) * L2E, (ex + v0 + v1) * L2E};
        if (F.lane == 63) A.BT[(b * 8 + hh) * 32 + ((tok0 & (SEQ - 1)) >> 7)] = sc * L2E;
    }
    if constexpr (NB == 3) {
        int e0 = 0, e1 = 0, r0 = 0, r1 = 0; float w0 = 0.f, w1 = 0.f;
        if (F.tid < 128) {
            const LAS float* row = LGA + F.tid * LGW;
            const float l0 = row[0] + A.bias0[0], l1 = row[1] + A.bias0[1], l2 = row[2] + A.bias0[2], l3 = row[3] + A.bias0[3];
            int g = 0; float mx = l0; if (l1 > mx) { mx = l1; g = 1; } if (l2 > mx) { mx = l2; g = 2; } if (l3 > mx) { mx = l3; g = 3; }
            const float top_p = 1.f / (__expf(l0 - mx) + __expf(l1 - mx) + __expf(l2 - mx) + __expf(l3 - mx));
            float v1 = -INFINITY, v2 = -INFINITY; int i1 = 0, i2 = 0;
#pragma unroll
            for (int j = 0; j < 8; ++j) { const float v = row[4 + 8 * g + j] + A.bias1[8 * g + j];
                if (v > v1) { v2 = v1; i2 = i1; v1 = v; i1 = j; } else if (v > v2) { v2 = v; i2 = j; } }
            const float e21 = __expf(v2 - v1), ew1 = 1.f / (1.f + e21);
            w0 = top_p * ew1; w1 = top_p * (e21 * ew1); e0 = 8 * g + i1; e1 = 8 * g + i2;
            r0 = __hip_atomic_fetch_add(lcnt + e0, 1, __ATOMIC_RELAXED, __HIP_MEMORY_SCOPE_WORKGROUP);
            r1 = __hip_atomic_fetch_add(lcnt + e1, 1, __ATOMIC_RELAXED, __HIP_MEMORY_SCOPE_WORKGROUP);
        }
        __syncthreads();
        if (F.tid < 32) gbase[F.tid] = (int)__hip_atomic_fetch_add(A.cnt + 64 * F.tid, (unsigned)lcnt[F.tid], __ATOMIC_RELAXED, __HIP_MEMORY_SCOPE_AGENT);
        __syncthreads();
        if (F.tid < 128) { const int tk = tok0 + F.tid;
            A.LIST[(size_t)e0 * T + gbase[e0] + r0] = 2u * tk; A.LIST[(size_t)e1 * T + gbase[e1] + r1] = 2u * tk + 1u;
            A.CW[2 * tk] = w0; A.CW[2 * tk + 1] = w1; }
    }
    __syncthreads();
}

struct Args { In in; float* out; unsigned char* ws; int ph_lo, ph_hi; };
typedef const __attribute__((address_space(4))) Args* KArgP;
__device__ __forceinline__ KArgP KA() { KArgP p = (KArgP)__builtin_amdgcn_kernarg_segment_ptr(); asm volatile("" : "+s"(p)); return p; }
#define WSP   (KA()->ws)
#define XRES  (KA()->out)
#define MODP  ((float*)(WSP + WS_MOD))
#define HB    ((bf16*)(WSP + WS_H))
#define QB_   ((bf16*)(WSP + WS_QKVU))
#define YB    ((unsigned char*)(WSP + WS_QKVU))
#define AOB   ((bf16*)(WSP + WS_AO))
#define ACTB  ((bf16*)(WSP + WS_AO))
#define FLP   ((float*)(WSP + WS_FL))
#define FCP   ((float*)(WSP + WS_FC))
#define CWP   ((float*)(WSP + WS_CW))
#define LISTP ((unsigned*)(WSP + WS_LIST))
#define CTLP  ((gu32*)(WSP + WS_CTL))
#define DLB   ((bf16*)(WSP + WS_DL))
#define XBB   ((bf16*)(WSP + WS_XB))
struct PoolDiff {
    Frame& F; const bf16* U; bf16* AO; v4u la[9], lb[9]; int steps;
    __device__ __forceinline__ void load(v4u (&ld)[9], const int half) { const int t0 = blk * 128, pos0 = t0 & (SEQ - 1);
#pragma unroll
        for (int j = 0; j < 9; ++j) { const int p = F.tid + 512 * j; const int r = p >> 5, cc = p & 31; v4u v = (v4u){0u, 0u, 0u, 0u};
            if (p < 143 * 32 && pos0 - 15 + r >= 0) v = *(const v4u*)(U + (size_t)(t0 - 15 + r) * 512 + half * 256 + 8 * cc);
            ld[j] = v; } }
    __device__ __forceinline__ void half_pass(const v4u (&ld)[9], const int half) { const int t0 = blk * 128, pos0 = t0 & (SEQ - 1);
        LAS v4u* tile = (LAS v4u*)F.lds;
#pragma unroll
        for (int j = 0; j < 9; ++j) { const int p = F.tid + 512 * j; if (p < 143 * 32) tile[p] = ld[j]; }
        __syncthreads();
        const int cc = F.tid & 31, tl0 = 8 * (F.tid >> 5); const int w = 2 << ((half * 32 + cc) >> 4);
        float sum[8];
#pragma unroll
        for (int q = 0; q < 8; ++q) sum[q] = 0.f;
#define POOL_ACC(V, SGN) do { sum[0] += SGN bflo((V).x); sum[1] += SGN bfhi((V).x); sum[2] += SGN bflo((V).y); sum[3] += SGN bfhi((V).y); sum[4] += SGN bflo((V).z); sum[5] += SGN bfhi((V).z); sum[6] += SGN bflo((V).w); sum[7] += SGN bfhi((V).w); } while (0)
        for (int d = 1; d < w; ++d) { const v4u v = tile[(15 + tl0 - d) * 32 + cc]; POOL_ACC(v, +); }
#pragma unroll 2
        for (int j = 0; j < 8; ++j) { const int tl = tl0 + j, pos = pos0 + tl;
            const v4u v = tile[(15 + tl) * 32 + cc]; POOL_ACC(v, +);
            const float rc = 1.0f / (float)((pos + 1) < w ? (pos + 1) : w);
            v4u o; o.x = pk2(sum[0] * rc - bflo(v.x), sum[1] * rc - bfhi(v.x)); o.y = pk2(sum[2] * rc - bflo(v.y), sum[3] * rc - bfhi(v.y));
            o.z = pk2(sum[4] * rc - bflo(v.z), sum[5] * rc - bfhi(v.z)); o.w = pk2(sum[6] * rc - bflo(v.w), sum[7] * rc - bfhi(v.w));
            *(v4u*)(AO + (size_t)(t0 + tl) * D + 512 + half * 256 + 8 * cc) = o;
            const v4u u = tile[(15 + tl - (w - 1)) * 32 + cc]; POOL_ACC(u, -); }
#undef POOL_ACC
        __syncthreads(); }
    int blk;
    __device__ __forceinline__ void block(const int it) { blk = it; load(la, 0); load(lb, 1); half_pass(la, 0); half_pass(lb, 1); }
    int l;
    __device__ __forceinline__ void convert() {
        const In& I = *(const In*)(const void*)(&KA()->in);
        bf16* WguT = (bf16*)(WSP + WS_WGU); bf16* WdT = (bf16*)(WSP + WS_WD);
        int t_ = threadIdx.x; asm volatile("" : "+v"(t_));
        const int lane_ = t_ & 63, wave_ = __builtin_amdgcn_readfirstlane(t_ >> 6);
        LAS float* scr = (LAS float*)(F.lds + RING_OFF + wave_ * 16384);
        constexpr int IT_E = 2048;
        struct Item { const float* W; int ldw; bf16* WT; int ldt, k0, n0src, dstrow0; };
        auto item = [&](int j) -> Item { int r = (F.vcu + 256 * j) * NWAVES + wave_;
            if (r < 2 * IT_E) { const int up = r >= IT_E; if (up) r -= IT_E; const int e = r >> 6, q = r & 63, kb = q >> 2, nb = q & 3, n0 = 64 * nb;
                return Item{(up ? I.w_eu : I.w_eg) + (size_t)(l * NX + e) * D * FE, FE, WguT + (size_t)(l * NX + e) * 512 * D, D, 64 * kb, n0, 256 * (n0 >> 7) + (n0 & 127) + (up ? 128 : 0)}; }
            r -= 2 * IT_E; const int e = r >> 6, q = r & 63, kb = q >> 4, nb = q & 15;
            return Item{I.w_ed + (size_t)(l * NX + e) * FE * D, D, WdT + (size_t)(l * NX + e) * D * FE, FE, 64 * kb, 64 * nb, 64 * nb}; };
        f32x4 va[16], vb[16];
        const Item i0 = item(0), i1 = item(1), i2 = item(2);
        transpose_load64(va, i0.W, i0.ldw, i0.k0, i0.n0src, lane_);
        transpose_load64(vb, i1.W, i1.ldw, i1.k0, i1.n0src, lane_);
        asm volatile("" ::: "memory"); __builtin_amdgcn_sched_barrier(0);
        transpose_finish64(va, i0.WT, i0.ldt, i0.k0, i0.dstrow0, scr, lane_);
        transpose_load64(va, i2.W, i2.ldw, i2.k0, i2.n0src, lane_);
        asm volatile("" ::: "memory"); __builtin_amdgcn_sched_barrier(0);
        transpose_finish64(vb, i1.WT, i1.ldt, i1.k0, i1.dstrow0, scr, lane_);
        transpose_finish64(va, i2.WT, i2.ldt, i2.k0, i2.dstrow0, scr, lane_);
        __syncthreads();
    }
};
template <bool WITH_CW>
__device__ __forceinline__ void moe_tables(Frame& F, pg8::MoeSched& S, int l, int npn, const char* W, size_t estride, size_t pnstride, const unsigned* LIST, const float* CW) {
    LAS unsigned* ent = (LAS unsigned*)(F.lds + ENT_OFF); LAS float* cwt = (LAS float*)(F.lds + CWT_OFF);
    LAS int* tstart = (LAS int*)(F.lds + TST_OFF); LAS int* cntl = tstart + 33; LAS int* ut = cntl + 32; LAS int* nun = ut + 4 * ENT_UNITS;
    unsigned* const pubp = (unsigned*)(CTLP + CW_TIL + l * TIL_STRIDE);
    if (F.wave == 0) {
        const int ln = F.lane; unsigned c = 0u;
        if (ln < 32) { c = __hip_atomic_load(CTLP + CW_CNT + 64 * (l * 32 + ln), RLX_AGENT); c = c < (unsigned)T ? c : (unsigned)T; }
        const int tl = (int)((c + 255u) >> 8); int inc = tl;
        inc += __builtin_amdgcn_update_dpp(0, inc, 0x111, 0xf, 0xf, true); inc += __builtin_amdgcn_update_dpp(0, inc, 0x112, 0xf, 0xf, true); inc += __builtin_amdgcn_update_dpp(0, inc, 0x114, 0xf, 0xf, true);
        inc += __builtin_amdgcn_update_dpp(0, inc, 0x118, 0xf, 0xf, true); inc += __builtin_amdgcn_update_dpp(0, inc, 0x142, 0xa, 0xf, true);
        if (ln < 32) { cntl[ln] = (int)c; tstart[ln] = inc - tl; }
        if (ln == 31) tstart[32] = inc;
        const int ntile = __builtin_amdgcn_readlane(inc, 31);
        int tix = -1;
        if (ln < ENT_UNITS) {
            const int i = ln, G = F.G, cc = F.vcu, total = ntile * npn; int L = i * G + cc;
            if (!WITH_CW) { const int nlate = (ntile * 2) % G, ne = G - nlate, hs = (ne >= G / 2) ? 4 : 0;
                if (hs) L = cc >= nlate ? (i < hs ? i * ne + (cc - nlate) : hs * ne + (i - hs) * G + cc) : hs * ne + i * G + cc; }
            int e = 0, pn = 0, nrows = 0;
            if (L < total) { tix = L / npn; pn = L - tix * npn;
#pragma unroll
                for (int sft = 16; sft >= 1; sft >>= 1) if (tstart[e + sft] <= tix) e += sft;
                const int left = cntl[e] - (tix - tstart[e]) * 256; nrows = left < 256 ? left : 256; }
            ut[4 * i] = e; ut[4 * i + 1] = pn; ut[4 * i + 2] = nrows; ut[4 * i + 3] = tix;
        }
        const int n = __builtin_popcountll(__ballot(tix >= 0));
        unsigned rdy = 0u;
        if (!WITH_CW) {
            unsigned pc = 0u;
            if (tix >= 0) pc = __hip_atomic_load(pubp + 64 * tix, __ATOMIC_RELAXED, __HIP_MEMORY_SCOPE_AGENT);
            rdy = (unsigned)__ballot(tix >= 0 && pc >= 16u);
            __builtin_amdgcn_fence(__ATOMIC_ACQUIRE, "agent"); asm volatile("s_waitcnt vmcnt(0)" ::: "memory");
        }
        if (ln == 0) { nun[0] = n; nun[1] = (int)rdy; }
    }
    __syncthreads();
    S.ut = ut; S.nunits = nun[0]; S.rdy = WITH_CW ? 0u : (unsigned)nun[1]; S.W = W; S.estride = estride; S.pnstride = pnstride;
    S.pub = pubp; S.tmo = (unsigned*)(CTLP + CW_TMO);
    {
        constexpr int NJ = WITH_CW ? 2 : 4;
        unsigned en[NJ]; float cw[NJ];
#pragma unroll
        for (int j = 0; j < NJ; ++j) { const int q = F.tid + NWAVES * 64 * j, i = q >> 8, r = q & 255, ii = i < S.nunits ? i : 0;
            const int e = ut[4 * ii], nrows = ut[4 * ii + 2], r0 = (ut[4 * ii + 3] - tstart[e]) * 256;
            en[j] = LIST[(size_t)e * T + r0 + (r < nrows ? r : 0)]; }
        if (WITH_CW) {
#pragma unroll
            for (int j = 0; j < NJ; ++j) cw[j] = CW[en[j]];
        }
#pragma unroll
        for (int j = 0; j < NJ; ++j) { const int q = F.tid + NWAVES * 64 * j;
            if ((q >> 8) < S.nunits) { ent[q] = en[j]; if (WITH_CW) { if (q < 3 * 256) cwt[q] = cw[j]; } } }
    }
    __syncthreads();
}
__global__ void __launch_bounds__(NWAVES * 64, 2) mk_fwd(Args args_unused) {
    extern __shared__ __attribute__((aligned(16))) unsigned char lds[];
    Frame F;
    F.lds = (LAS unsigned char*)lds;
    F.MISC = (volatile LAS unsigned*)(F.lds + MISC_OFF);
    F.tid = threadIdx.x; F.lane = F.tid & 63; F.wave = __builtin_amdgcn_readfirstlane(F.tid >> 6);
    F.G = gridDim.x; { const int bx = blockIdx.x; F.vcu = (F.G % 8 == 0) ? (bx % 8) * (F.G / 8) + bx / 8 : bx; }
    F.ctl = (gu32*)(KA()->ws + WS_CTL);
    for (int u = F.tid; u < (LDS_BYTES - LDSCTL_OFF) / 4; u += NWAVES * 64) ((LAS unsigned*)(F.lds + LDSCTL_OFF))[u] = 0u;
    __syncthreads();
    XcdBarrier bar; bar.bar = (unsigned*)(F.ctl + CW_BAR); bar.x = 0; bar.st = nullptr;
    if (!MK_PER_PHASE) bar = xcd_barrier_post((unsigned*)(F.ctl + CW_BAR), F.MISC + 8);
#define GRID_BAR() do { if (!MK_PER_PHASE) { XcdBarrier b_ = bar; unsigned* p_ = b_.bar; unsigned x_ = b_.x; asm volatile("" : "+s"(p_), "+s"(x_)); b_.bar = p_; b_.x = x_; xcd_barrier(b_); } } while (0)
    const int lo = KA()->ph_lo, hi = KA()->ph_hi;
#ifndef PHASE_MASK
#define PHASE_MASK 0xFFFF
#endif
#define IN(k) ((((PHASE_MASK) >> ((k) > 7 && (k) < 15 ? (k) - 7 : (k))) & 1) && lo <= (k) && (k) < hi)
#ifndef PROBE_MODE
#define PROBE_MODE 0
#endif
#ifndef REPEAT_MASK
#define REPEAT_MASK 0
#endif
#define RPT(k, cond) _Pragma("nounroll") for (int rp_ = 0, nr_ = ((((REPEAT_MASK) >> (k)) & 1) && (cond)) ? 2 : 1; rp_ < nr_; ++rp_)
#ifndef TIME_A
#define TIME_A -1
#endif
#ifndef TIME_B
#define TIME_B -1
#endif
    unsigned long long tA_ = 0, tB_ = 0;
    if (TIME_B >= 0 && TIME_A < 0) tA_ = __builtin_amdgcn_s_memrealtime();
#define SEAM(k) do { if (IN(k) && IN((k) + 1)) GRID_BAR(); if (TIME_B >= 0) { if ((k) == TIME_A) tA_ = __builtin_amdgcn_s_memrealtime(); if ((k) == TIME_B) tB_ = __builtin_amdgcn_s_memrealtime(); } } while (0)
#define PHASE_BEGIN() do { int w_ = F.wave, v_ = F.vcu, g_ = F.G; int ln_ = (int)__builtin_amdgcn_mbcnt_hi(~0u, __builtin_amdgcn_mbcnt_lo(~0u, 0u)); asm volatile("" : "+v"(ln_), "+v"(w_), "+v"(v_), "+v"(g_)); \
        F.wave = __builtin_amdgcn_readfirstlane(w_); F.vcu = __builtin_amdgcn_readfirstlane(v_); F.G = __builtin_amdgcn_readfirstlane(g_); F.lane = ln_; F.tid = F.wave * 64 + ln_; } while (0)
#ifndef EXTRA_BARS
#define EXTRA_BARS 0
#endif
    for (int xb_ = 0; xb_ < EXTRA_BARS; ++xb_) GRID_BAR();
#if PROBE_STEPS
    const unsigned long long pk0_ = __builtin_amdgcn_s_memrealtime();
#endif
    if (IN(0)) { PHASE_BEGIN(); RPT(0, true) { if (rp_) GRID_BAR(); const In I = *(const In*)(const void*)(&KA()->in); p0_prologue(F, I, WSP, 0); }
#if PROBE_STEPS
        if (((PROBE_STEPS >= 16 && PROBE_STEPS <= 18) || (PROBE_STEPS == 19 && F.vcu < 64) || (PROBE_STEPS == 22 && F.vcu >= 64 && F.vcu < 96) || (PROBE_STEPS == 25 && F.vcu >= 96)) && F.tid == 0) { const unsigned d_ = (unsigned)((__builtin_amdgcn_s_memrealtime() - pk0_) / 10ull);
            __hip_atomic_fetch_max((unsigned*)(CTLP + 8), d_, RLX_AGENT); __hip_atomic_fetch_add((unsigned*)(CTLP + 9), 2u * d_, RLX_AGENT); __hip_atomic_fetch_max((unsigned*)(CTLP + 10), 100000u - d_, RLX_AGENT); }
#endif
        SEAM(0); }

#pragma nounroll
    for (int l = 0; l < NL; ++l) {
        const int pb = 1 + 7 * l;
        if (IN(pb + 0)) { PHASE_BEGIN();
            const float* modl = MODP + (size_t)l * 8 * 6144;
            NormArgs A{}; A.gamma = KA()->in.g_mix + l * D; A.scale = modl + 1024; A.shift = modl; A.H = HB; A.frag = (const v4u*)(WSP + WS_FRF) + (size_t)l * 32 * 2 * 64;
            A.bias0 = KA()->in.b_fg + l * 8; A.FL = FCP; A.BT = FLP;
            A.xwb = XBB;
            if (l == 0) { A.xin = KA()->in.x; RPT(1, true) { if (rp_) GRID_BAR(); norm_phase<false, false, false, true, 1, false>(F, A); } }
            else { A.xinb = DLB; A.Y0 = YB; A.Y1 = YB + (size_t)T * D; A.gate = MODP + (size_t)(l - 1) * 8 * 6144 + 5120; RPT(5, true) { if (rp_) GRID_BAR(); norm_phase<true, false, true, true, 1, false>(F, A); } }
            SEAM(pb + 0);
        }
        if (IN(pb + 1)) { PHASE_BEGIN();
            pg8::Gemm g{HB, (const bf16*)(WSP + WS_WIN) + (size_t)l * 2048 * D, T, 2048, D}; pg8::StaticOrder S; S.init(T, 2048, F.G, (int)blockIdx.x);
            pg8::EpiQKVU E{QB_, 512, 512, (size_t)T * 512, attn_body::C2, (unsigned*)(CTLP + CW_NRM + l * NRM_WORDS)};
            RPT(2, true) { if (rp_) GRID_BAR(); pg8::gemm_phase<pg8::EpiQKVU, pg8::StaticOrder, true, true>(F.lds + RING_OFF, g, S, E); }
            SEAM(pb + 1);
        }
        if (IN(pb + 2)) { PHASE_BEGIN();
            PoolDiff PD{F, QB_ + (size_t)3 * T * 512, AOB}; PD.l = l;
#if PROBE_STEPS
            const unsigned long long pt0_ = __builtin_amdgcn_s_memrealtime();
#endif
            const attn_body::AttnBase AB{(const char*)WSP, WS_QKVU, WS_QKVU + (size_t)T * 512 * 2, WS_QKVU + (size_t)2 * T * 512 * 2, WS_AO, WS_FC, WS_FL, WS_CTL + (size_t)(CW_NRM + l * NRM_WORDS) * 4, WS_CTL + (size_t)(CW_QAT + 64 * (l * 8)) * 4, WS_CTL + (size_t)(CW_PQ + 64 * l) * 4};
            attn_body::attn_phase<32>((char*)lds + RING_OFF, AB, F.vcu, F.tid, PD);
#if PROBE_STEPS
            if (PROBE_STEPS >= 4 && PROBE_STEPS <= 6) PD.steps = (int)((__builtin_amdgcn_s_memrealtime() - pt0_) / 100ull);
            if (PROBE_STEPS < 10 && F.tid == 0) { __hip_atomic_fetch_max((unsigned*)(CTLP + 8), (unsigned)PD.steps, RLX_AGENT); __hip_atomic_fetch_add((unsigned*)(CTLP + 9), (unsigned)PD.steps, RLX_AGENT); __hip_atomic_fetch_max((unsigned*)(CTLP + 10), (unsigned)(100000 - PD.steps), RLX_AGENT); }
#endif
            SEAM(pb + 2);
        }
        if (IN(pb + 3)) { PHASE_BEGIN();
            pg8::Gemm g{AOB, (const bf16*)(WSP + WS_WOUT) + (size_t)l * D * D, T, D, D}; pg8::StaticOrder S; S.init(T, D, F.G, (int)blockIdx.x);
            pg8::EpiMid E{DLB, XBB, MODP + (size_t)l * 8 * 6144 + 2048, 6144};
            RPT(4, true) { if (rp_) GRID_BAR(); pg8::gemm_phase<pg8::EpiMid, pg8::StaticOrder, true, true>(F.lds + RING_OFF, g, S, E); }
            SEAM(pb + 3);
        }
        if (IN(pb + 4)) { PHASE_BEGIN();
            const float* modl = MODP + (size_t)l * 8 * 6144;
            NormArgs A{}; A.xinb = DLB; A.gamma = KA()->in.g_ffn + l * D; A.scale = modl + 4096; A.shift = modl + 3072; A.H = HB;
            A.frag = (const v4u*)(WSP + WS_RRF) + (size_t)l * 32 * 3 * 2 * 64; A.bias0 = KA()->in.b_rg + l * 4; A.bias1 = KA()->in.b_re + l * 32; A.CW = CWP; A.LIST = LISTP; A.cnt = CTLP + CW_CNT + 64 * (l * 32);
            norm_phase<true, false, false, false, 3, false>(F, A);
            SEAM(pb + 4);
        }
#if PROBE_STEPS
        unsigned long long mt0_ = 0ull;
#endif
        if (IN(pb + 5)) { PHASE_BEGIN();
#if PROBE_STEPS
            mt0_ = __builtin_amdgcn_s_memrealtime();
#endif
            pg8::MoeSched S; moe_tables<true>(F, S, l, 2, (const char*)(WSP + WS_WGU) + (size_t)l * NX * 512 * D * 2, (size_t)512 * D * 2, (size_t)256 * D * 2, LISTP, CWP);
            LAS unsigned* ent = (LAS unsigned*)(F.lds + ENT_OFF); LAS float* cwt = (LAS float*)(F.lds + CWT_OFF);
            pg8::EpiAct E{ACTB, ent, cwt}; RPT(6, true) { if (rp_) GRID_BAR(); pg8::gemm_phase_moe<1, true, false, pg8::EpiAct, pg8::MoeSched>(F.lds + RING_OFF, HB, D, ent, S, E); }
#if PROBE_STEPS
            if (PROBE_STEPS == 13 && F.tid == 0) __hip_atomic_fetch_add((unsigned*)(CTLP + 9), (unsigned)((__builtin_amdgcn_s_memrealtime() - mt0_) / 100ull), RLX_AGENT);
#endif
        }
        if (IN(pb + 6)) { PHASE_BEGIN();
            pg8::MoeSched S; moe_tables<false>(F, S, l, 4, (const char*)(WSP + WS_WD) + (size_t)l * NX * D * FE * 2, (size_t)D * FE * 2, (size_t)256 * FE * 2, LISTP, CWP);
            LAS unsigned* ent = (LAS unsigned*)(F.lds + ENT_OFF);
            pg8::EpiY E{YB, (size_t)T * D, ent}; RPT(7, true) { if (rp_) GRID_BAR(); pg8::gemm_phase_moe<0, false, true, pg8::EpiY, pg8::MoeSched>(F.lds + RING_OFF, ACTB, FE, ent, S, E); }
#if PROBE_STEPS
            if (PROBE_STEPS >= 10 && PROBE_STEPS <= 12 && F.tid == 0) { const unsigned d_ = (unsigned)((__builtin_amdgcn_s_memrealtime() - mt0_) / 100ull);
                __hip_atomic_fetch_max((unsigned*)(CTLP + 8), d_, RLX_AGENT); __hip_atomic_fetch_add((unsigned*)(CTLP + 9), d_, RLX_AGENT); __hip_atomic_fetch_max((unsigned*)(CTLP + 10), 100000u - d_, RLX_AGENT); }
#endif
            SEAM(pb + 6);
        }
    }
    if (IN(NPH - 1)) { PHASE_BEGIN();
        NormArgs A{}; A.xinb = DLB; A.out = XRES; A.Y0 = YB; A.Y1 = YB + (size_t)T * D; A.gate = MODP + (size_t)(NL - 1) * 8 * 6144 + 5120; A.gamma = KA()->in.g_fin;
        norm_phase<true, false, true, false, 0, true>(F, A);
    }
#if PROBE_STEPS
    __syncthreads();
    if (F.vcu == 0 && F.tid == 0) { const unsigned mx = __hip_atomic_load((unsigned*)(CTLP + 8), RLX_AGENT), sm = __hip_atomic_load((unsigned*)(CTLP + 9), RLX_AGENT), mn = __hip_atomic_load((unsigned*)(CTLP + 10), RLX_AGENT);
        const float v = (PROBE_STEPS == 1 || PROBE_STEPS == 4 || PROBE_STEPS == 10 || PROBE_STEPS == 16 || PROBE_STEPS == 19 || PROBE_STEPS == 22 || PROBE_STEPS == 25) ? (float)mx : (PROBE_STEPS == 2 || PROBE_STEPS == 5 || PROBE_STEPS == 7 || PROBE_STEPS == 8 || PROBE_STEPS == 11 || PROBE_STEPS == 13 || PROBE_STEPS == 17) ? (float)sm * (1.0f / 512.0f) : (float)(100000u - mn); XRES[0] = 1000.f * (float)(((int)(v + 0.5f) + PROBE_BASE) / PROBE_Q * PROBE_Q); }
#endif
    if (TIME_B >= 0) {
        if (TIME_B >= NPH - 1) tB_ = __builtin_amdgcn_s_memrealtime();
        __syncthreads();
#ifndef TIME_Q
#define TIME_Q 10
#endif
#ifndef TIME_OFF
#define TIME_OFF 0
#endif
        const long long us_q = (long long)((((tB_ - tA_) / 100ull + TIME_OFF) / TIME_Q) * TIME_Q);
        const long long n = us_q * 1000ll - (long long)F.vcu * 131072ll; const int cnt = n < 0 ? 0 : (n > 131072 ? 131072 : (int)n);
        float* o = XRES + (size_t)F.vcu * 131072;
        for (int i = F.tid; i < cnt; i += NWAVES * 64) o[i] = 0.f;
    }
#undef IN
#undef SEAM
#undef GRID_BAR
}

extern "C" void kernel_launch(void* const* d_in, const int* in_sizes, int n_in, void* d_out, int out_size, void* d_ws, size_t ws_size, hipStream_t stream) {
    static int grid = 0;
    if (grid == 0) {
        if (n_in != 19 || in_sizes[0] != T * D || out_size != T * D || ws_size < WS_END) { fprintf(stderr, "kernel_launch: shape/workspace mismatch: n_in %d in0 %d out %d ws %zu (need %zu); nothing launched\n", n_in, n_in > 0 ? in_sizes[0] : -1, out_size, ws_size, (size_t)WS_END); grid = -1; return; }
        int dev = 0, cus = 0, per_cu = 0;
        if (hipGetDevice(&dev) != hipSuccess || hipDeviceGetAttribute(&cus, hipDeviceAttributeMultiprocessorCount, dev) != hipSuccess) { fprintf(stderr, "kernel_launch: device query failed\n"); grid = -1; return; }
        if (hipFuncSetAttribute((const void*)mk_fwd, hipFuncAttributeMaxDynamicSharedMemorySize, LDS_BYTES) != hipSuccess) { fprintf(stderr, "kernel_launch: hipFuncSetAttribute failed\n"); grid = -1; return; }
        if (hipOccupancyMaxActiveBlocksPerMultiprocessor(&per_cu, (const void*)mk_fwd, NWAVES * 64, LDS_BYTES) != hipSuccess || per_cu < 1) fprintf(stderr, "kernel_launch: note: occupancy query reports %d workgroups per CU\n", per_cu);
        (void)hipGetLastError();
        grid = cus;
        if (grid != 256) { fprintf(stderr, "kernel_launch: built for 256 CUs, device has %d; nothing launched\n", cus); grid = -1; return; }
    }
    if (grid < 0) return;
    if (hipMemsetAsync((char*)d_ws + WS_CTL, 0, CTL_ZERO_BYTES, stream) != hipSuccess) { fprintf(stderr, "kernel_launch: hipMemsetAsync failed\n"); return; }
    Args a{};
    const float** ip = (const float**)&a.in;
    for (int i = 0; i < 19; ++i) ip[i] = (const float*)d_in[i];
    a.out = (float*)d_out; a.ws = (unsigned char*)d_ws;
#if MK_PER_PHASE
    for (int p = 0; p < NPH; ++p) { a.ph_lo = p; a.ph_hi = p + 1; hipLaunchKernelGGL(mk_fwd, dim3(grid), dim3(NWAVES * 64), LDS_BYTES, stream, a); }
#else
    a.ph_lo = 0; a.ph_hi = NPH; hipLaunchKernelGGL(mk_fwd, dim3(grid), dim3(NWAVES * 64), LDS_BYTES, stream, a);
#endif
    const hipError_t le = hipPeekAtLastError();
    if (le != hipSuccess) fprintf(stderr, "kernel_launch: launch failed: %s\n", hipGetErrorName(le));
}
```

```cpp
#ifndef PROBE_STEPS
#define PROBE_STEPS 0
#endif
#ifndef PROBE_BASE
#define PROBE_BASE 0
#endif
#ifndef PROBE_Q
#define PROBE_Q 10
#endif
#include <hip/hip_runtime.h>
#include <hip/hip_bf16.h>
#include <cstdio>
#include <cstdint>
#include <cmath>

namespace pg8 {
#define PG8_LAS __attribute__((address_space(3)))
typedef unsigned short bf16_t;
typedef short bf16x8 __attribute__((ext_vector_type(8)));
typedef float f32x4 __attribute__((ext_vector_type(4)));
typedef unsigned u32x4 __attribute__((ext_vector_type(4)));
constexpr int BM = 256, BK = 64, HALF = 128, HTB = HALF * BK * 2  , STAGE_BYTES = 8 * HTB, NXCD = 8, WGM = 8;

__host__ __device__ __forceinline__ int lds_byte(int r, int c) { const int st = (r >> 4) * 2 + (c >> 5), rr = r & 15, cc = c & 31, ob = rr * 64 + cc * 2; return st * 1024 + (ob ^ (((ob >> 9) & 1) << 5)); }
__host__ __device__ __forceinline__ void stage_rc(int b, int& R, int& C) { const int st = b / 1024, sb = b % 1024, swz = sb ^ (((sb >> 9) & 1) << 5); R = (st >> 1) * 16 + swz / 64; C = (st & 1) * 32 + (swz % 64) / 2; }
__host__ __device__ __forceinline__ int perm32(int rho) { const int n = rho >> 4, i = rho & 15; return 8 * (i >> 2) + 4 * n + (i & 3); }

struct Unit { int pm, pn; };
struct Gemm { const bf16_t* A; const bf16_t* Bt; int M, N, K; };

struct StaticOrder {
    int nM, nN, nwg, G, c;
    __host__ __device__ void init(int M, int N, int G_, int c_) { nM = M / BM; nN = N / BM; nwg = nM * nN; G = G_; c = c_; }
    __host__ __device__ bool next(int i, Unit& u) const {
        const long L = (long)i * G + c; if (L >= nwg) return false;
        int wgid = (int)L; { const int q = nwg / NXCD, r = nwg % NXCD, xcd = wgid % NXCD, off = wgid / NXCD; wgid = (xcd < r ? xcd * (q + 1) : r * (q + 1) + (xcd - r) * q) + off; }
        const int nig = WGM * nN, gid = wgid / nig, fm = gid * WGM, gsz = (nM - fm) < WGM ? (nM - fm) : WGM;
        u.pm = fm + ((wgid % nig) % gsz); u.pn = (wgid % nig) / gsz; return true;
    }
    __device__ __forceinline__ void a_ready(const Unit&) const {}
    __device__ __forceinline__ void done(const Unit&) const {}
};

__device__ __forceinline__ unsigned cvt_pk_bf16(float lo, float hi) { unsigned r; asm volatile("v_cvt_pk_bf16_f32 %0, %1, %2" : "=v"(r) : "v"(lo), "v"(hi)); return r; }
typedef float f32x2 __attribute__((ext_vector_type(2)));

__device__ __forceinline__ float lane_read(float v, int src_lane) { return __builtin_bit_cast(float, __builtin_amdgcn_ds_bpermute(src_lane << 2, __builtin_bit_cast(int, v))); }
#ifndef MK_WT_STORES
#define MK_WT_STORES 0
#endif
#if MK_WT_STORES
#define STORE16_WT(p, v) asm volatile("global_store_dwordx4 %0, %1, off sc1\n\ts_nop 1" :: "v"(p), "v"(v) : "memory")
#else
#define STORE16_WT(p, v) (*(u32x4*)(p) = (v))
#endif
struct EpiQKVU {
    static constexpr bool PERM = true, AFTER_DRAIN = false;
    bf16_t* O; int ldc; int split_cols; size_t split_stride; float scale0;
    unsigned* nrm;
    __device__ __forceinline__ void operator()(const f32x4 (&acc)[2][2][4][2], const Unit& u, int wr, int wc, int fr, int fq) const {
        const int row0 = u.pm * BM + wr * 64 + fr; int colt = u.pn * BM; bf16_t* base = O;
        const int t = colt / split_cols; float sc = 1.f; { base += (size_t)t * split_stride; colt -= t * split_cols; if (t == 0) sc = scale0; }
        const int col0 = colt + wc * 32 + 8 * fq;
        if (t < 2) {
            const int b = (u.pm * BM) >> 12, tile0 = ((u.pm * BM) & 4095) >> 6;
#pragma unroll
            for (int ai = 0; ai < 2; ++ai)
#pragma unroll
                for (int bj = 0; bj < 2; ++bj) { float mx = 0.f;
#pragma unroll
                    for (int m = 0; m < 4; ++m) { const f32x4 v0 = acc[ai][bj][m][0] * sc, v1 = acc[ai][bj][m][1] * sc;
                        float ssq = (v0[0] * v0[0] + v0[1] * v0[1]) + (v0[2] * v0[2] + v0[3] * v0[3]) + (v1[0] * v1[0] + v1[1] * v1[1]) + (v1[2] * v1[2] + v1[3] * v1[3]);
                        { auto r16_ = __builtin_amdgcn_permlane16_swap(__float_as_uint(ssq), __float_as_uint(ssq), false, false); ssq = __uint_as_float(r16_[0]) + __uint_as_float(r16_[1]);
                          auto r32_ = __builtin_amdgcn_permlane32_swap(__float_as_uint(ssq), __float_as_uint(ssq), false, false); ssq = __uint_as_float(r32_[0]) + __uint_as_float(r32_[1]); }
                        mx = fmaxf(mx, ssq); }
#define PG8_DPPF(V, CTRL) __builtin_bit_cast(float, __builtin_amdgcn_update_dpp(0, __builtin_bit_cast(int, V), CTRL, 0xf, 0xf, false))
                    mx = fmaxf(mx, PG8_DPPF(mx, 0xB1)); mx = fmaxf(mx, PG8_DPPF(mx, 0x4E)); mx = fmaxf(mx, PG8_DPPF(mx, 0x141)); mx = fmaxf(mx, PG8_DPPF(mx, 0x140));
#undef PG8_DPPF
                    if (fr == 0 && fq == 0) { const int head = (colt >> 6) + 2 * bj + (wc >> 1);
                        nrm[((size_t)((t * 64 + b * 8 + head) * 64 + tile0 + 2 * ai + wr)) * 2 + (wc & 1)] = __float_as_uint(mx); } }
        }
#pragma unroll
        for (int ai = 0; ai < 2; ++ai)
#pragma unroll
            for (int m = 0; m < 4; ++m) { bf16_t* rowp = base + (size_t)(row0 + ai * HALF + m * 16) * ldc + col0;
#pragma unroll
                for (int bj = 0; bj < 2; ++bj) { const f32x4 v0 = acc[ai][bj][m][0] * sc, v1 = acc[ai][bj][m][1] * sc;
                    u32x4 w; w.x = cvt_pk_bf16(v0[0], v0[1]); w.y = cvt_pk_bf16(v0[2], v0[3]); w.z = cvt_pk_bf16(v1[0], v1[1]); w.w = cvt_pk_bf16(v1[2], v1[3]);
                    STORE16_WT(rowp + bj * HALF, w); } }
    }
};
struct EpiDelta {
    static constexpr bool PERM = true, AFTER_DRAIN = false;
    bf16_t* O; const float* gate; int gstride;
    __device__ __forceinline__ void operator()(const f32x4 (&acc)[2][2][4][2], const Unit& u, int wr, int wc, int fr, int fq) const {
        const int row0 = u.pm * BM + wr * 64 + fr, col0 = u.pn * BM + wc * 32 + 8 * fq; const int b = (u.pm * BM) >> 12;
        f32x4 gv[2][2];
#pragma unroll
        for (int bj = 0; bj < 2; ++bj)
#pragma unroll
            for (int n = 0; n < 2; ++n) gv[bj][n] = *(const f32x4*)(gate + (size_t)b * gstride + col0 + bj * HALF + 4 * n);
#pragma unroll
        for (int ai = 0; ai < 2; ++ai)
#pragma unroll
            for (int m = 0; m < 4; ++m) { bf16_t* rowp = O + (size_t)(row0 + ai * HALF + m * 16) * 1024 + col0;
#pragma unroll
                for (int bj = 0; bj < 2; ++bj) { const f32x4 v0 = acc[ai][bj][m][0] * gv[bj][0], v1 = acc[ai][bj][m][1] * gv[bj][1];
                    u32x4 w; w.x = cvt_pk_bf16(v0[0], v0[1]); w.y = cvt_pk_bf16(v0[2], v0[3]); w.z = cvt_pk_bf16(v1[0], v1[1]); w.w = cvt_pk_bf16(v1[2], v1[3]);
                    STORE16_WT(rowp + bj * HALF, w); } }
    }
};
struct EpiMid {
    static constexpr bool PERM = true, AFTER_DRAIN = false;
    bf16_t* O; const bf16_t* X; const float* gate; int gstride;
    __device__ __forceinline__ void operator()(const f32x4 (&acc)[2][2][4][2], const Unit& u, int wr, int wc, int fr, int fq) const {
        const int row0 = u.pm * BM + wr * 64 + fr, col0 = u.pn * BM + wc * 32 + 8 * fq; const int b = (u.pm * BM) >> 12;
        u32x4 xr[2][4][2];
#pragma unroll
        for (int ai = 0; ai < 2; ++ai)
#pragma unroll
            for (int m = 0; m < 4; ++m)
#pragma unroll
                for (int bj = 0; bj < 2; ++bj) xr[ai][m][bj] = *(const u32x4*)(X + (size_t)(row0 + ai * HALF + m * 16) * 1024 + col0 + bj * HALF);
        f32x4 gv[2][2];
#pragma unroll
        for (int bj = 0; bj < 2; ++bj)
#pragma unroll
            for (int n = 0; n < 2; ++n) gv[bj][n] = *(const f32x4*)(gate + (size_t)b * gstride + col0 + bj * HALF + 4 * n);
        asm volatile("" ::: "memory"); __builtin_amdgcn_sched_barrier(0);
#pragma unroll
        for (int ai = 0; ai < 2; ++ai)
#pragma unroll
            for (int m = 0; m < 4; ++m) { bf16_t* rowp = O + (size_t)(row0 + ai * HALF + m * 16) * 1024 + col0;
#pragma unroll
                for (int bj = 0; bj < 2; ++bj) { const u32x4 xv = xr[ai][m][bj];
                    const f32x4 x0 = {__uint_as_float(xv.x << 16), __uint_as_float(xv.x & 0xffff0000u), __uint_as_float(xv.y << 16), __uint_as_float(xv.y & 0xffff0000u)};
                    const f32x4 x1 = {__uint_as_float(xv.z << 16), __uint_as_float(xv.z & 0xffff0000u), __uint_as_float(xv.w << 16), __uint_as_float(xv.w & 0xffff0000u)};
                    const f32x4 v0 = x0 + acc[ai][bj][m][0] * gv[bj][0], v1 = x1 + acc[ai][bj][m][1] * gv[bj][1];
                    u32x4 w; w.x = cvt_pk_bf16(v0[0], v0[1]); w.y = cvt_pk_bf16(v0[2], v0[3]); w.z = cvt_pk_bf16(v1[0], v1[1]); w.w = cvt_pk_bf16(v1[2], v1[3]);
                    STORE16_WT(rowp + bj * HALF, w); } }
    }
};
struct EpiResGate {
    static constexpr bool PERM = false, AFTER_DRAIN = false;
    const float* base; float* out; const float* gate; int gstride;
    __device__ __forceinline__ void operator()(const f32x4 (&acc)[2][2][4][2], const Unit& u, int wr, int wc, int fr, int fq) const {
        const int row0 = u.pm * BM + wr * 64 + fr, col0 = u.pn * BM + wc * 32 + 4 * fq; const int b = (u.pm * BM) >> 12;
        f32x4 gv[2][2];
#pragma unroll
        for (int bj = 0; bj < 2; ++bj)
#pragma unroll
            for (int n = 0; n < 2; ++n) gv[bj][n] = *(const f32x4*)(gate + (size_t)b * gstride + col0 + bj * HALF + n * 16);
#pragma unroll
        for (int ai = 0; ai < 2; ++ai) {
            f32x4 bs[4][2][2];
#pragma unroll
            for (int m = 0; m < 4; ++m) { const size_t off = (size_t)(row0 + ai * HALF + m * 16) * 1024 + col0;
#pragma unroll
                for (int bj = 0; bj < 2; ++bj)
#pragma unroll
                    for (int n = 0; n < 2; ++n) bs[m][bj][n] = *(const f32x4*)(base + off + bj * HALF + n * 16); }
            asm volatile("" ::: "memory");
#pragma unroll
            for (int m = 0; m < 4; ++m) { const size_t off = (size_t)(row0 + ai * HALF + m * 16) * 1024 + col0;
#pragma unroll
                for (int bj = 0; bj < 2; ++bj)
#pragma unroll
                    for (int n = 0; n < 2; ++n) *(f32x4*)(out + off + bj * HALF + n * 16) = bs[m][bj][n] + gv[bj][n] * acc[ai][bj][m][n]; }
            asm volatile("" ::: "memory");
        }
    }
};

template <class Epi, class Sched, bool ALIGN_EPI = false, bool SP2 = false>
__device__ __forceinline__ void gemm_phase(PG8_LAS unsigned char* lds, const Gemm g, const Sched& S, const Epi& E) {
    int tid_ = threadIdx.x; asm volatile("" : "+v"(tid_));
    const int tid = tid_, wid = __builtin_amdgcn_readfirstlane(tid >> 6), lane = tid & 63, wr = wid >> 2, wc = wid & 3, fr = lane & 15, fq = lane >> 4;
    const int K = g.K, nt = K / BK;
    unsigned voffA[2], voffB[2];
#pragma unroll
    for (int i = 0; i < 2; ++i) { int R, C; stage_rc(tid * 16 + i * 8192, R, C); const int Rb = Epi::PERM ? ((R & ~31) + perm32(R & 31)) : R;
        voffA[i] = (unsigned)(R * K + C) * 2u; voffB[i] = (unsigned)(Rb * K + C) * 2u; }
    const size_t kstep = (size_t)(BK * 2);
    const size_t hstep = (size_t)HALF * K * 2;
    const size_t tstep = 2 * hstep;
    const unsigned ldsw = (unsigned)wid * 1024u;
    const int aoff = lds_byte(wr * 64 + fr, fq * 8), boff = lds_byte(wc * 32 + fr, fq * 8);
#define PG8_SA(b, h) (((b) * 2 + (h)) * HTB)
#define PG8_SB(b, h) ((4 + (b) * 2 + (h)) * HTB)
#define PG8_STAGE(bufoff, gbase, voff) do { _Pragma("unroll") for (int _i = 0; _i < 2; ++_i) \
        __builtin_amdgcn_global_load_lds((const unsigned*)((const char*)(gbase) + (voff)[_i]), (PG8_LAS unsigned*)(lds + (bufoff) + ldsw + _i * 8192), 16, 0, 0); } while (0)
#define PG8_LDA(dst, b, h) do { _Pragma("unroll") for (int m = 0; m < 4; ++m) _Pragma("unroll") for (int k = 0; k < 2; ++k) dst[m][k] = *(const PG8_LAS bf16x8*)(lds + PG8_SA(b, h) + aoff + m * 2048 + k * 1024); } while (0)
#define PG8_LDB(dst, b, h) do { _Pragma("unroll") for (int n = 0; n < 2; ++n) _Pragma("unroll") for (int k = 0; k < 2; ++k) dst[n][k] = *(const PG8_LAS bf16x8*)(lds + PG8_SB(b, h) + boff + n * 2048 + k * 1024); } while (0)
#define PG8_MMA(ai, bj, At, Bt) do { __builtin_amdgcn_s_setprio(1); _Pragma("unroll") for (int m = 0; m < 4; ++m) _Pragma("unroll") for (int n = 0; n < 2; ++n) _Pragma("unroll") for (int k = 0; k < 2; ++k) \
        acc[ai][bj][m][n] = __builtin_amdgcn_mfma_f32_16x16x32_bf16(Bt[n][k], At[m][k], acc[ai][bj][m][n], 0, 0, 0); __builtin_amdgcn_s_setprio(0); } while (0)
#define PG8_WAIT_V(n) asm volatile("s_waitcnt vmcnt(" #n ")" ::: "memory")
#define PG8_WAIT_L(n) asm volatile("s_waitcnt lgkmcnt(" #n ")" ::: "memory")
#define PG8_BAR __builtin_amdgcn_s_barrier()
#define PG8_SCHED __builtin_amdgcn_sched_barrier(0)
    Unit cur, nxt; int ui = 0;
    if (!S.next(0, cur)) return;
    f32x4 acc[2][2][4][2];
#pragma unroll
    for (int a = 0; a < 2; ++a)
#pragma unroll
        for (int b = 0; b < 2; ++b)
#pragma unroll
            for (int m = 0; m < 4; ++m)
#pragma unroll
                for (int n = 0; n < 2; ++n) acc[a][b][m][n] = (f32x4){0.f, 0.f, 0.f, 0.f};
    bf16x8 At[4][2], B0[2][2], B1[2][2];
    const char* cA = (const char*)g.A + (size_t)cur.pm * tstep; const char* cB = (const char*)g.Bt + (size_t)cur.pn * tstep;
    S.a_ready(cur);
    if constexpr (SP2) {
        PG8_STAGE(PG8_SB(0, 0), cB, voffB); PG8_STAGE(PG8_SB(0, 1), cB + hstep, voffB); PG8_STAGE(PG8_SA(0, 0), cA, voffA); PG8_STAGE(PG8_SA(0, 1), cA + hstep, voffA);
        if (wr == 1) PG8_BAR;
        PG8_WAIT_V(2); PG8_BAR;
        PG8_STAGE(PG8_SB(1, 0), cB + kstep, voffB); PG8_STAGE(PG8_SA(1, 0), cA + kstep, voffA); PG8_STAGE(PG8_SB(1, 1), cB + hstep + kstep, voffB);
        PG8_WAIT_V(6); PG8_BAR;
    } else {
        PG8_STAGE(PG8_SB(0, 0), cB, voffB); PG8_STAGE(PG8_SA(0, 0), cA, voffA); PG8_STAGE(PG8_SB(0, 1), cB + hstep, voffB); PG8_STAGE(PG8_SA(0, 1), cA + hstep, voffA);
        if (wr == 1) PG8_BAR;
        PG8_WAIT_V(4); PG8_BAR;
        PG8_STAGE(PG8_SB(1, 0), cB + kstep, voffB); PG8_STAGE(PG8_SA(1, 0), cA + kstep, voffA); PG8_STAGE(PG8_SB(1, 1), cB + hstep + kstep, voffB);
        PG8_WAIT_V(6); PG8_BAR;
    }
    for (;;) {
        const bool has_next = S.next(ui + 1, nxt);
        const char* nA = has_next ? (const char*)g.A + (size_t)nxt.pm * tstep : cA; const char* nB = has_next ? (const char*)g.Bt + (size_t)nxt.pn * tstep : cB;
        for (int t = 0; t < nt; t += 2) {
            const bool last = (t == nt - 2);
            const char* a1 = cA + (size_t)(t + 1) * kstep;
            const char* a2 = last ? nA : cA + (size_t)(t + 2) * kstep; const char* b2 = last ? nB : cB + (size_t)(t + 2) * kstep;
            const char* a3 = a2 + kstep; const char* b3 = b2 + kstep;
            if (last && has_next) S.a_ready(nxt);
            if constexpr (SP2) {
            PG8_LDB(B0, 0, 0); PG8_LDB(B1, 0, 1); PG8_SCHED; PG8_LDA(At, 0, 0); PG8_STAGE(PG8_SA(1, 1), a1 + hstep, voffA);
            PG8_WAIT_V(8); PG8_WAIT_L(0); PG8_BAR; PG8_MMA(0, 0, At, B0); PG8_MMA(0, 1, At, B1); PG8_BAR; PG8_SCHED;
            PG8_LDA(At, 0, 1); PG8_STAGE(PG8_SB(0, 0), b2, voffB); PG8_STAGE(PG8_SB(0, 1), b2 + hstep, voffB); PG8_STAGE(PG8_SA(0, 0), a2, voffA);
            PG8_WAIT_V(8); PG8_WAIT_L(0); PG8_BAR; PG8_MMA(1, 0, At, B0); PG8_MMA(1, 1, At, B1); PG8_BAR; PG8_SCHED;
            PG8_LDB(B0, 1, 0); PG8_LDB(B1, 1, 1); PG8_SCHED; PG8_LDA(At, 1, 0); PG8_STAGE(PG8_SA(0, 1), a2 + hstep, voffA);
            PG8_WAIT_V(8); PG8_WAIT_L(0); PG8_BAR; PG8_MMA(0, 0, At, B0); PG8_MMA(0, 1, At, B1); PG8_BAR; PG8_SCHED;
            PG8_LDA(At, 1, 1); PG8_STAGE(PG8_SB(1, 0), b3, voffB); PG8_STAGE(PG8_SB(1, 1), b3 + hstep, voffB); PG8_STAGE(PG8_SA(1, 0), a3, voffA);
            PG8_WAIT_V(8); PG8_WAIT_L(0); PG8_BAR; PG8_MMA(1, 0, At, B0); PG8_MMA(1, 1, At, B1); PG8_BAR; PG8_SCHED;
            } else {
            PG8_LDB(B0, 0, 0); PG8_SCHED; PG8_LDA(At, 0, 0); PG8_STAGE(PG8_SA(1, 1), a1 + hstep, voffA);
            PG8_WAIT_L(8); PG8_BAR; PG8_WAIT_L(0); PG8_MMA(0, 0, At, B0); PG8_BAR; PG8_SCHED;
            PG8_LDB(B1, 0, 1); PG8_STAGE(PG8_SB(0, 0), b2, voffB);
            PG8_BAR; PG8_WAIT_L(0); PG8_MMA(0, 1, At, B1); PG8_BAR;
            PG8_LDA(At, 0, 1); PG8_STAGE(PG8_SA(0, 0), a2, voffA);
            PG8_BAR; PG8_WAIT_L(0); PG8_MMA(1, 0, At, B0); PG8_BAR; PG8_SCHED;
            PG8_STAGE(PG8_SB(0, 1), b2 + hstep, voffB);
            PG8_WAIT_V(6); PG8_BAR; PG8_MMA(1, 1, At, B1); PG8_BAR;
            PG8_LDB(B0, 1, 0); PG8_SCHED; PG8_LDA(At, 1, 0); PG8_STAGE(PG8_SA(0, 1), a2 + hstep, voffA);
            PG8_WAIT_L(8); PG8_BAR; PG8_WAIT_L(0); PG8_MMA(0, 0, At, B0); PG8_BAR; PG8_SCHED;
            PG8_LDB(B1, 1, 1); PG8_STAGE(PG8_SB(1, 0), b3, voffB);
            PG8_BAR; PG8_WAIT_L(0); PG8_MMA(0, 1, At, B1); PG8_BAR;
            PG8_LDA(At, 1, 1); PG8_STAGE(PG8_SA(1, 0), a3, voffA);
            PG8_BAR; PG8_WAIT_L(0); PG8_MMA(1, 0, At, B0); PG8_BAR; PG8_SCHED;
            PG8_STAGE(PG8_SB(1, 1), b3 + hstep, voffB);
            PG8_WAIT_V(6); PG8_BAR; PG8_MMA(1, 1, At, B1); PG8_BAR;
            }
        }
        if constexpr (ALIGN_EPI) { if (wr == 0) PG8_BAR; }
        if constexpr (!Epi::AFTER_DRAIN) { E(acc, cur, wr, wc, fr, fq); S.done(cur); }
        if (!has_next) break;
#pragma unroll
        for (int a = 0; a < 2; ++a)
#pragma unroll
            for (int b = 0; b < 2; ++b)
#pragma unroll
                for (int m = 0; m < 4; ++m)
#pragma unroll
                    for (int n = 0; n < 2; ++n) acc[a][b][m][n] = (f32x4){0.f, 0.f, 0.f, 0.f};
        cur = nxt; cA = nA; cB = nB; ++ui;
        if constexpr (ALIGN_EPI) { if (wr == 1) PG8_BAR; }
    }
    PG8_WAIT_V(0);
    if constexpr (!ALIGN_EPI) { if (wr == 0) PG8_BAR; }
    PG8_BAR;
    if constexpr (Epi::AFTER_DRAIN) { E.fused(acc, cur, wr, wc, fr, fq, lds, wid, lane); S.done(cur); }
#undef PG8_SA
#undef PG8_SB
#undef PG8_STAGE
#undef PG8_LDA
#undef PG8_LDB
#undef PG8_MMA
#undef PG8_WAIT_V
#undef PG8_WAIT_L
#undef PG8_BAR
#undef PG8_SCHED
}

struct MUnit { int slot, e, pn, nrows, tile; };
struct MoeSched {
    PG8_LAS const int* ut; int nunits;
    const char* W; size_t estride, pnstride;
    unsigned rdy;
    unsigned* pub; unsigned* tmo;
    __device__ __forceinline__ bool next(int i, MUnit& u) const {
        if (i >= nunits) return false;
        u.slot = i; u.e = ut[4 * i]; u.pn = ut[4 * i + 1]; u.nrows = ut[4 * i + 2]; u.tile = ut[4 * i + 3]; return true; }
    __device__ __forceinline__ const char* b_base(const MUnit& u) const { return W + (size_t)u.e * estride + (size_t)u.pn * pnstride; }
    __device__ __forceinline__ void publish(int tile, int lane) const { if (lane == 0) __hip_atomic_fetch_add(pub + 64 * tile, 1u, __ATOMIC_RELAXED, __HIP_MEMORY_SCOPE_AGENT); }
    __device__ __forceinline__ void a_ready(const MUnit& u, int wid, int lane) const {
        if ((rdy >> u.slot) & 1u) return;
        if (wid == 0) {
            unsigned polls = 0;
            while ((unsigned)__builtin_amdgcn_readfirstlane(__hip_atomic_load(pub + 64 * u.tile, __ATOMIC_RELAXED, __HIP_MEMORY_SCOPE_AGENT)) < 16u) {
                if ((++polls & 255u) == 0u && __builtin_amdgcn_readfirstlane(__hip_atomic_load(tmo, __ATOMIC_RELAXED, __HIP_MEMORY_SCOPE_AGENT)) != 0u) break;
                if (polls > (1u << 14)) { if (lane == 0) __hip_atomic_store(tmo, 1u, __ATOMIC_RELAXED, __HIP_MEMORY_SCOPE_AGENT); break; }
                __builtin_amdgcn_s_sleep(2); }
            __builtin_amdgcn_fence(__ATOMIC_ACQUIRE, "agent");
            asm volatile("s_waitcnt vmcnt(0)" ::: "memory");
        }
        asm volatile("" ::: "memory"); __builtin_amdgcn_s_barrier(); asm volatile("" ::: "memory");
    }
};
template <int ESH, bool PUBLISH, bool WAITA, class Epi, class Sched>
__device__ __forceinline__ void gemm_phase_moe(PG8_LAS unsigned char* lds, const bf16_t* Abase, const int K, PG8_LAS const unsigned* ent, const Sched& S, const Epi& E) {
    int tid_ = threadIdx.x; asm volatile("" : "+v"(tid_));
    const int tid = tid_, wid = __builtin_amdgcn_readfirstlane(tid >> 6), lane = tid & 63, wr = wid >> 2, wc = wid & 3, fr = lane & 15, fq = lane >> 4;
    const int nt = K / BK;
    int RA[2]; unsigned cA2[2], voffB[2];
#pragma unroll
    for (int i = 0; i < 2; ++i) { int R, C; stage_rc(tid * 16 + i * 8192, R, C); const int Rb = Epi::PERM ? ((R & ~31) + perm32(R & 31)) : R;
        RA[i] = R; cA2[i] = (unsigned)C * 2u; voffB[i] = (unsigned)(Rb * K + C) * 2u; }
    const size_t kstep = (size_t)(BK * 2);
    const size_t hstep = (size_t)HALF * K * 2;
    const unsigned rowb = (unsigned)K * 2u;
    const unsigned ldsw = (unsigned)wid * 1024u;
    const int aoff = lds_byte(wr * 64 + fr, fq * 8), boff = lds_byte(wc * 32 + fr, fq * 8);
#define PG8_SA(b, h) (((b) * 2 + (h)) * HTB)
#define PG8_SB(b, h) ((4 + (b) * 2 + (h)) * HTB)
#define PG8_STAGE(bufoff, gbase, voff) do { _Pragma("unroll") for (int _i = 0; _i < 2; ++_i) \
        __builtin_amdgcn_global_load_lds((const unsigned*)((const char*)(gbase) + (voff)[_i]), (PG8_LAS unsigned*)(lds + (bufoff) + ldsw + _i * 8192), 16, 0, 0); } while (0)
#define PG8_LDA(dst, b, h) do { _Pragma("unroll") for (int m = 0; m < 4; ++m) _Pragma("unroll") for (int k = 0; k < 2; ++k) dst[m][k] = *(const PG8_LAS bf16x8*)(lds + PG8_SA(b, h) + aoff + m * 2048 + k * 1024); } while (0)
#define PG8_LDB(dst, b, h) do { _Pragma("unroll") for (int n = 0; n < 2; ++n) _Pragma("unroll") for (int k = 0; k < 2; ++k) dst[n][k] = *(const PG8_LAS bf16x8*)(lds + PG8_SB(b, h) + boff + n * 2048 + k * 1024); } while (0)
#define PG8_MMA(ai, bj, At, Bt) do { __builtin_amdgcn_s_setprio(1); _Pragma("unroll") for (int m = 0; m < 4; ++m) _Pragma("unroll") for (int n = 0; n < 2; ++n) _Pragma("unroll") for (int k = 0; k < 2; ++k) \
        acc[ai][bj][m][n] = __builtin_amdgcn_mfma_f32_16x16x32_bf16(Bt[n][k], At[m][k], acc[ai][bj][m][n], 0, 0, 0); __builtin_amdgcn_s_setprio(0); } while (0)
#define PG8_WAIT_V(n) asm volatile("s_waitcnt vmcnt(" #n ")" ::: "memory")
#define PG8_WAIT_L(n) asm volatile("s_waitcnt lgkmcnt(" #n ")" ::: "memory")
#define PG8_BAR __builtin_amdgcn_s_barrier()
#define PG8_SCHED __builtin_amdgcn_sched_barrier(0)
#define PG8_OFFS(dst, u) do { _Pragma("unroll") for (int _h = 0; _h < 2; ++_h) _Pragma("unroll") for (int _i = 0; _i < 2; ++_i) \
        dst[_h][_i] = (ent[(u).slot * 256 + _h * HALF + RA[_i]] >> ESH) * rowb + cA2[_i]; } while (0)
    MUnit cur, nxt; int ui = 0; int pend = -1;
    if (!S.next(0, cur)) return;
    if constexpr (WAITA) S.a_ready(cur, wid, lane);
    f32x4 acc[2][2][4][2];
#pragma unroll
    for (int a = 0; a < 2; ++a)
#pragma unroll
        for (int b = 0; b < 2; ++b)
#pragma unroll
            for (int m = 0; m < 4; ++m)
#pragma unroll
                for (int n = 0; n < 2; ++n) acc[a][b][m][n] = (f32x4){0.f, 0.f, 0.f, 0.f};
    bf16x8 At[4][2], B0[2][2], B1[2][2];
    unsigned offc[2][2], offn[2][2];
    PG8_OFFS(offc, cur);
    const char* const cA = (const char*)Abase; const char* cB = S.b_base(cur);
    PG8_STAGE(PG8_SB(0, 0), cB, voffB); PG8_STAGE(PG8_SB(0, 1), cB + hstep, voffB); PG8_STAGE(PG8_SA(0, 0), cA, offc[0]); PG8_STAGE(PG8_SA(0, 1), cA, offc[1]);
    if (wr == 1) PG8_BAR;
    PG8_WAIT_V(2); PG8_BAR;
    PG8_STAGE(PG8_SB(1, 0), cB + kstep, voffB); PG8_STAGE(PG8_SA(1, 0), cA + kstep, offc[0]); PG8_STAGE(PG8_SB(1, 1), cB + hstep + kstep, voffB);
    PG8_WAIT_V(6); PG8_BAR;
    for (;;) {
        const bool has_next = S.next(ui + 1, nxt);
        const char* nB = has_next ? S.b_base(nxt) : cB;
        if (has_next) { PG8_OFFS(offn, nxt); } else {
#pragma unroll
            for (int h = 0; h < 2; ++h)
#pragma unroll
                for (int i = 0; i < 2; ++i) offn[h][i] = offc[h][i]; }
#pragma nounroll
        for (int t = 0; t < nt; t += 2) {
            const bool last = (t == nt - 2);
            if constexpr (WAITA) { if (last && has_next) S.a_ready(nxt, wid, lane); }
            const char* a1 = cA + (size_t)(t + 1) * kstep;
            const char* a2 = last ? cA : cA + (size_t)(t + 2) * kstep; const char* b2 = last ? nB : cB + (size_t)(t + 2) * kstep;
            const char* a3 = a2 + kstep; const char* b3 = b2 + kstep;
            unsigned o2[2][2];
#pragma unroll
            for (int h = 0; h < 2; ++h)
#pragma unroll
                for (int i = 0; i < 2; ++i) o2[h][i] = last ? offn[h][i] : offc[h][i];
            PG8_LDB(B0, 0, 0); PG8_LDB(B1, 0, 1); PG8_SCHED; PG8_LDA(At, 0, 0); PG8_STAGE(PG8_SA(1, 1), a1, offc[1]);
            PG8_WAIT_V(8); PG8_WAIT_L(0); PG8_BAR; PG8_MMA(0, 0, At, B0); PG8_MMA(0, 1, At, B1); PG8_BAR; PG8_SCHED;
            PG8_LDA(At, 0, 1); PG8_STAGE(PG8_SB(0, 0), b2, voffB); PG8_STAGE(PG8_SB(0, 1), b2 + hstep, voffB); PG8_STAGE(PG8_SA(0, 0), a2, o2[0]);
            PG8_WAIT_V(8); PG8_WAIT_L(0);
            if constexpr (PUBLISH) { if (t == 0 && pend >= 0) { S.publish(pend, lane); pend = -1; } }
            PG8_BAR; PG8_MMA(1, 0, At, B0); PG8_MMA(1, 1, At, B1); PG8_BAR; PG8_SCHED;
            PG8_LDB(B0, 1, 0); PG8_LDB(B1, 1, 1); PG8_SCHED; PG8_LDA(At, 1, 0); PG8_STAGE(PG8_SA(0, 1), a2, o2[1]);
            PG8_WAIT_V(8); PG8_WAIT_L(0); PG8_BAR; PG8_MMA(0, 0, At, B0); PG8_MMA(0, 1, At, B1); PG8_BAR; PG8_SCHED;
            PG8_LDA(At, 1, 1); PG8_STAGE(PG8_SB(1, 0), b3, voffB); PG8_STAGE(PG8_SB(1, 1), b3 + hstep, voffB); PG8_STAGE(PG8_SA(1, 0), a3, o2[0]);
            PG8_WAIT_V(8); PG8_WAIT_L(0); PG8_BAR; PG8_MMA(1, 0, At, B0); PG8_MMA(1, 1, At, B1); PG8_BAR; PG8_SCHED;
        }
        if (wr == 0) PG8_BAR;
        E(acc, cur, wr, wc, fr, fq);
        if constexpr (PUBLISH) pend = cur.tile;
        if (!has_next) break;
#pragma unroll
        for (int a = 0; a < 2; ++a)
#pragma unroll
            for (int b = 0; b < 2; ++b)
#pragma unroll
                for (int m = 0; m < 4; ++m)
#pragma unroll
                    for (int n = 0; n < 2; ++n) acc[a][b][m][n] = (f32x4){0.f, 0.f, 0.f, 0.f};
        cur = nxt; cB = nB; ++ui;
#pragma unroll
        for (int h = 0; h < 2; ++h)
#pragma unroll
            for (int i = 0; i < 2; ++i) offc[h][i] = offn[h][i];
        if (wr == 1) PG8_BAR;
    }
    PG8_WAIT_V(0);
    if constexpr (PUBLISH) { if (pend >= 0) S.publish(pend, lane); }
    PG8_BAR;
#undef PG8_SA
#undef PG8_SB
#undef PG8_STAGE
#undef PG8_LDA
#undef PG8_LDB
#undef PG8_MMA
#undef PG8_WAIT_V
#undef PG8_WAIT_L
#undef PG8_BAR
#undef PG8_SCHED
#undef PG8_OFFS
}
struct EpiAct {
    static constexpr bool PERM = true, AFTER_DRAIN = false;
    bf16_t* ACT; PG8_LAS const unsigned* ent; PG8_LAS const float* cwt;
    __device__ __forceinline__ void operator()(const f32x4 (&acc)[2][2][4][2], const MUnit& u, int wr, int wc, int fr, int fq) const {
#pragma unroll
        for (int ai = 0; ai < 2; ++ai)
#pragma unroll
            for (int m = 0; m < 4; ++m) { const int r = ai * HALF + wr * 64 + m * 16 + fr;
                if (r < u.nrows) { const unsigned en = ent[u.slot * 256 + r]; const float w = cwt[u.slot * 256 + r];
                    float a[8];
#pragma unroll
                    for (int n = 0; n < 2; ++n)
#pragma unroll
                        for (int j = 0; j < 4; ++j) { const float g = acc[ai][0][m][n][j], up = acc[ai][1][m][n][j];
                            a[4 * n + j] = g * __builtin_amdgcn_rcpf(1.f + __builtin_amdgcn_exp2f(-1.4426950408889634f * g)) * up * w; }
                    u32x4 o; o.x = cvt_pk_bf16(a[0], a[1]); o.y = cvt_pk_bf16(a[2], a[3]); o.z = cvt_pk_bf16(a[4], a[5]); o.w = cvt_pk_bf16(a[6], a[7]);
                    asm volatile("global_store_dwordx4 %0, %1, off sc1\n\ts_nop 1" :: "v"(ACT + (size_t)en * 256 + u.pn * HALF + wc * 32 + 8 * fq), "v"(o) : "memory"); } }
    }
};
struct EpiY {
    static constexpr bool PERM = true, AFTER_DRAIN = false;
    unsigned char* Y; size_t slot_stride; PG8_LAS const unsigned* ent;
    __device__ __forceinline__ void operator()(const f32x4 (&acc)[2][2][4][2], const MUnit& u, int wr, int wc, int fr, int fq) const {
        const int coff = (fq & 1) ? HALF + 8 * (fq - 1) : 8 * fq;
#pragma unroll
        for (int ai = 0; ai < 2; ++ai)
#pragma unroll
            for (int m = 0; m < 4; ++m) { const int r = ai * HALF + wr * 64 + m * 16 + fr;
                unsigned w[2][2];
#pragma unroll
                for (int bj = 0; bj < 2; ++bj) { const f32x4 v0 = acc[ai][bj][m][0] * 16.f, v1 = acc[ai][bj][m][1] * 16.f;
                    int w0 = __builtin_amdgcn_cvt_pk_fp8_f32(v0[0], v0[1], 0, false); w0 = __builtin_amdgcn_cvt_pk_fp8_f32(v0[2], v0[3], w0, true);
                    int w1 = __builtin_amdgcn_cvt_pk_fp8_f32(v1[0], v1[1], 0, false); w1 = __builtin_amdgcn_cvt_pk_fp8_f32(v1[2], v1[3], w1, true);
                    w[bj][0] = (unsigned)w0; w[bj][1] = (unsigned)w1; }
                { auto s0 = __builtin_amdgcn_permlane16_swap(w[0][0], w[1][0], false, false); w[0][0] = s0[0]; w[1][0] = s0[1];
                  auto s1 = __builtin_amdgcn_permlane16_swap(w[0][1], w[1][1], false, false); w[0][1] = s1[0]; w[1][1] = s1[1]; }
                if (r < u.nrows) { const unsigned en = ent[u.slot * 256 + r];
                    unsigned char* rowp = Y + (size_t)(en & 1u) * slot_stride + (size_t)(en >> 1) * 1024 + u.pn * BM + wc * 32 + coff;
                    *(u32x4*)rowp = (u32x4){w[0][0], w[0][1], w[1][0], w[1][1]}; } }
    }
};
}

#include <hip/hip_bf16.h>
#include <cmath>

namespace attn_body {
using bf16=__hip_bfloat16;
using bf16x8=__attribute__((ext_vector_type(8)))short;
using s16x4=__attribute__((ext_vector_type(4)))short;
using f32x16=__attribute__((ext_vector_type(16)))float;
using u32x4=__attribute__((ext_vector_type(4)))unsigned;
constexpr int BATCH=8,NHEAD=8,SEQ=4096,D=64,DM=NHEAD*D,ODM=1024;
constexpr int NW=8,QBLK=32,QB=QBLK*NW,KVBLK=64,NQB=SEQ/QB;
constexpr int ATTN_PITCH=DM, ATTN_UNIT_ROWS=QB;
__device__ __forceinline__ int crow(int r,int hi){return (r&3)+8*(r>>2)+4*hi;}
#define SBAR() __builtin_amdgcn_sched_barrier(0)
__device__ __forceinline__ void cmask(f32x16&p0,f32x16&p1,int jb,int qrel,int hi){
  const float NEG=-INFINITY; int kb=64*jb+4*hi;
  #pragma unroll
  for(int r=0;r<16;++r){int kv=kb+(r&3)+8*(r>>2); if(kv>qrel)p0[r]=NEG; if(kv+32>qrel)p1[r]=NEG;}
}

constexpr int NSLOT=3, SLOTB=8192;
constexpr int LDS_K=0, LDS_V=NSLOT*SLOTB, LDS_WS=2*NSLOT*SLOTB, LDS_OST=LDS_WS+NW*64*4, LDS_BYTES=LDS_OST+NW*4096;
constexpr float SKIP_L2=-80.f;
constexpr int LDS_TICKET=85504;
constexpr int LDS_FB=86016, LDS_FB_BYTES=SEQ*8;
constexpr float C2=0.125f*1.4426950408889634f;
__device__ __forceinline__ void glds16(const void*gbase,unsigned voff,unsigned lds_dst){unsigned keep;
  asm volatile("s_mov_b32 %0, m0\n\ts_mov_b32 m0, %3\n\ts_nop 0\n\tglobal_load_lds_dwordx4 %1, %2\n\ts_mov_b32 m0, %0":"=&s"(keep):"v"(voff),"s"(gbase),"s"(lds_dst):"memory");}
__device__ __forceinline__ float max3f(float a,float b,float c){float r;asm("v_max3_f32 %0, %1, %2, %3":"=v"(r):"v"(a),"v"(b),"v"(c));return r;}
__device__ __forceinline__ float max2f(float a,float b){float r;asm("v_max_f32_e32 %0, %1, %2":"=v"(r):"v"(a),"v"(b));return r;}
__device__ __forceinline__ float fadd_s(float a,float b){float r;asm("v_add_f32_e32 %0, %1, %2":"=v"(r):"v"(a),"v"(b));return r;}
__device__ __forceinline__ float fsub_s(float a,float b){float r;asm("v_sub_f32_e32 %0, %1, %2":"=v"(r):"v"(a),"v"(b));return r;}
typedef float f32x2_t __attribute__((ext_vector_type(2))); typedef __bf16 bf16x2_t __attribute__((ext_vector_type(2)));
__device__ __forceinline__ unsigned cvtpk_s(float lo,float hi){f32x2_t v={lo,hi};bf16x2_t b=__builtin_convertvector(v,bf16x2_t);return __builtin_bit_cast(unsigned,b);}
#define WAIT_BAR(N) asm volatile("s_waitcnt vmcnt(" #N ") lgkmcnt(0)\n\ts_barrier":::"memory")

__device__ __forceinline__ void qkt(f32x16&p0,f32x16&p1,const char*Kslot,const bf16x8*qr,int r32,int hi){
  const char*kb=Kslot+hi*1024+r32*16;
  #pragma unroll
  for(int d0=0;d0<4;++d0){
    const bf16x8 b0=*reinterpret_cast<const bf16x8*>(kb+d0*2048);
    const bf16x8 b1=*reinterpret_cast<const bf16x8*>(kb+d0*2048+512);
    {p0=__builtin_amdgcn_mfma_f32_32x32x16_bf16(b0,qr[d0],p0,0,0,0);p1=__builtin_amdgcn_mfma_f32_32x32x16_bf16(b1,qr[d0],p1,0,0,0);}}
}
typedef __attribute__((address_space(3))) const char* lds_cptr;
typedef float f32x4_t __attribute__((ext_vector_type(4)));
typedef short v4i16_t __attribute__((ext_vector_type(4)));
__device__ __forceinline__ void kload8(bf16x8*kf,lds_cptr kp){
  kf[0]=*(const __attribute__((address_space(3))) bf16x8*)(kp);      kf[1]=*(const __attribute__((address_space(3))) bf16x8*)(kp+512);
  kf[2]=*(const __attribute__((address_space(3))) bf16x8*)(kp+2048); kf[3]=*(const __attribute__((address_space(3))) bf16x8*)(kp+2560);
  kf[4]=*(const __attribute__((address_space(3))) bf16x8*)(kp+4096); kf[5]=*(const __attribute__((address_space(3))) bf16x8*)(kp+4608);
  kf[6]=*(const __attribute__((address_space(3))) bf16x8*)(kp+6144); kf[7]=*(const __attribute__((address_space(3))) bf16x8*)(kp+6656);
}
__device__ __forceinline__ void kload2(bf16x8*kf,lds_cptr kp,int j){ kf[2*j]=*(const __attribute__((address_space(3))) bf16x8*)(kp+j*2048); kf[2*j+1]=*(const __attribute__((address_space(3))) bf16x8*)(kp+j*2048+512); }
__device__ __forceinline__ s16x4 vtr(lds_cptr p){ return __builtin_bit_cast(s16x4,__builtin_amdgcn_ds_read_tr16_b64_v4i16((__attribute__((address_space(3))) v4i16_t*)p)); }
__device__ __forceinline__ float rowmax(const f32x16&p0,const f32x16&p1){
  float a=max3f(p0[0],p0[1],p1[0]),b=max3f(p0[2],p0[3],p1[1]);a=max3f(a,p1[2],p1[3]);
  #pragma unroll
  for(int r=4;r<16;r+=4){a=max3f(a,p0[r],p0[r+1]);b=max3f(b,p0[r+2],p0[r+3]);a=max3f(a,p1[r],p1[r+1]);b=max3f(b,p1[r+2],p1[r+3]);}
  const float m=max2f(a,b);
  auto rr=__builtin_amdgcn_permlane32_swap(__float_as_uint(m),__float_as_uint(m),false,false);
  return max2f(__uint_as_float(rr[0]),__uint_as_float(rr[1]));
}
__device__ __forceinline__ void pv(f32x16*o,int vb,bf16x8 pa0,bf16x8 pa1,bf16x8 pa2,bf16x8 pa3){
  #pragma unroll
  for(int d0=0;d0<2;++d0){s16x4 lo[4],hi[4];
    #pragma unroll
    for(int ks=0;ks<4;++ks){
      asm volatile("ds_read_b64_tr_b16 %0,%1 offset:%c2":"=&v"(lo[ks]):"v"(vb),"i"(d0*4096+ks*1024):"memory");
      asm volatile("ds_read_b64_tr_b16 %0,%1 offset:%c2":"=&v"(hi[ks]):"v"(vb),"i"(d0*4096+ks*1024+512):"memory");}
    asm volatile("s_waitcnt lgkmcnt(0)":::"memory");SBAR();
    #define PK(k) (bf16x8){lo[k][0],lo[k][1],lo[k][2],lo[k][3],hi[k][0],hi[k][1],hi[k][2],hi[k][3]}
    o[d0]=__builtin_amdgcn_mfma_f32_32x32x16_bf16(pa0,PK(0),o[d0],0,0,0);
    o[d0]=__builtin_amdgcn_mfma_f32_32x32x16_bf16(pa1,PK(1),o[d0],0,0,0);
    o[d0]=__builtin_amdgcn_mfma_f32_32x32x16_bf16(pa2,PK(2),o[d0],0,0,0);
    o[d0]=__builtin_amdgcn_mfma_f32_32x32x16_bf16(pa3,PK(3),o[d0],0,0,0);
    #undef PK
  }
}

#ifndef ATTN_STORE16
#define ATTN_STORE16(p,v) STORE16_WT(p,v)
#endif
struct AttnBase { const char* ws; size_t q,k,v,o,fc,bt,nrm,qat,pq; };
template<int THRL> __device__ __forceinline__ int attn_units(const int x,int rank,const AttnBase&AB,const int maxu,int&ndone,int&steps,char*shm){
  typedef float f32x4_l __attribute__((ext_vector_type(4)));
  typedef unsigned v2u_t __attribute__((ext_vector_type(2)));
  #define WAVE_CONSTS() \
  int tid_=threadIdx.x; asm volatile("":"+v"(tid_)); const int tid=tid_,lane=tid&63,r32=lane&31,hi=lane>>5; const int wid=__builtin_amdgcn_readfirstlane(tid>>6); \
  const unsigned lds0=(unsigned)(uintptr_t)shm; \
  float*wsf=(float*)(shm+LDS_WS)+wid*64; \
  const unsigned ksrc=(unsigned)((lane*DM+wid*8)*2); \
  const unsigned vsrc=(unsigned)(((16*(wid&3)+(lane>>2))*DM+(wid>>2)*32+(lane&3)*8)*2); \
  const unsigned kdst=lds0+LDS_K+wid*1024, vdst=lds0+LDS_V+wid*1024; \
  const int vb0=(int)(lds0+LDS_V)+((lane>>4)&1)*32+(lane&3)*8+(4*hi+((lane&15)>>2))*64; \
  const char*Kbase=shm+LDS_K; \
  const lds_cptr shm3=(lds_cptr)shm; const lds_cptr kp0=shm3+LDS_K+hi*1024+r32*16; const lds_cptr vp0=shm3+LDS_V+((lane>>4)&1)*32+(lane&3)*8+(4*hi+((lane&15)>>2))*64; \
  const int qrel=wid*QBLK+r32; \
  const lds_cptr fbx=shm3+LDS_FB+(r32*8); \
  const u32x4 qxu_=hi?(u32x4){0u,0u,0u,0u}:(u32x4){0x3f803f80u,0x00003f80u,0u,0u}; const bf16x8 qx=__builtin_bit_cast(bf16x8,qxu_);
  #define DMA_K(t,slot) glds16(Kh,ksrc+(unsigned)(NTF-1-(t))*(unsigned)(KVBLK*DM*2),(unsigned)__builtin_amdgcn_readfirstlane(kdst+(slot)))
  #define DMA_V(t,slot) glds16(Vh,vsrc+(unsigned)(NTF-1-(t))*(unsigned)(KVBLK*DM*2),(unsigned)__builtin_amdgcn_readfirstlane(vdst+(slot)))
  int qb,q0,h,NTF,kend; long rowbase; const bf16*Kh,*Vh;
  float su_bt,su_fcj,su_fc0; unsigned su_k0,su_k1,su_q[8],su_u[8]; f32x4_l su_v0,su_v1; bf16x8 qr[4];
  #define NRMW(p,i) __hip_atomic_load((p)+(i),__ATOMIC_RELAXED,__HIP_MEMORY_SCOPE_AGENT)
  #define UNIT_ISSUE(RK) do{ const int u_=(RK),bq_=u_&7; qb=15-(u_>>3); const int bh_=bq_*8+((x-bq_)&7); h=bh_%NHEAD; rowbase=(long)(bh_/NHEAD)*SEQ; q0=qb*QB; kend=q0+QB; NTF=(q0+QB)/KVBLK; \
    const char*w_=AB.ws; asm volatile("":"+s"(w_)); const bf16*Q=(const bf16*)(w_+AB.q),*K=(const bf16*)(w_+AB.k),*V=(const bf16*)(w_+AB.v); const float*FC=(const float*)(w_+AB.fc),*BT=(const float*)(w_+AB.bt); const unsigned*nrm=(const unsigned*)(w_+AB.nrm); \
    const float*FCbh=FC+(long)bh_*SEQ; su_bt=lane<32?BT[bh_*32+lane]:0.f; \
    const unsigned*su_qn=nrm+((size_t)bh_*64)*2,*su_kn=nrm+((size_t)(64+bh_)*64)*2; \
    su_k0=NRMW(su_kn,2*lane);su_k1=NRMW(su_kn,2*lane+1); \
    _Pragma("unroll") for(int r=0;r<8;++r){ su_q[r]=NRMW(su_qn,8*qb+r); su_u[r]=NRMW(su_kn,8*qb+r); } \
    su_fcj=FCbh[64*lane+63];su_fc0=FCbh[256*qb]; \
    su_v0=(f32x4_l){0.f,0.f,0.f,0.f};su_v1=(f32x4_l){0.f,0.f,0.f,0.f}; \
    if(tid*4<kend)su_v0=*reinterpret_cast<const f32x4_l*>(FCbh+tid*4); \
    if(tid*4+NW*256<kend)su_v1=*reinterpret_cast<const f32x4_l*>(FCbh+tid*4+NW*256); \
    asm volatile("":::"memory"); __builtin_amdgcn_sched_barrier(0); \
    const bf16*Qw=Q+(rowbase+q0+wid*QBLK)*DM+h*D; Kh=K+rowbase*DM+h*D;Vh=V+rowbase*DM+h*D; \
    DMA_K(0,0);DMA_V(0,0);DMA_K(1,SLOTB); \
    _Pragma("unroll") for(int d0=0;d0<4;++d0)qr[d0]=*reinterpret_cast<const bf16x8*>(&Qw[(long)r32*DM+d0*16+hi*8]); \
    DMA_K(2,2*SLOTB); }while(0)
  #define XFR(v) __builtin_bit_cast(bf16x8,(u32x4){(v)[0],(v)[1],(v)[0],(v)[1]})
  #define CINIT(C0,C1,t) do{ const v2u_t a_=*(const __attribute__((address_space(3))) v2u_t*)(fbx+(NTF-1-(t))*512), b_=*(const __attribute__((address_space(3))) v2u_t*)(fbx+(NTF-1-(t))*512+256); \
      C0=__builtin_amdgcn_mfma_f32_32x32x16_bf16(XFR(a_),qx,negm,0,0,0); C1=__builtin_amdgcn_mfma_f32_32x32x16_bf16(XFR(b_),qx,negm,0,0,0); }while(0)
  #define CMASK(P0,P1,t) do{int jb_=3-(t); if(jb_>=0)cmask(P0,P1,jb_,qrel,hi);}while(0)
  #define START(P0,P1) do{ const float rm=rowmax(P0,P1); resc=false; \
    { const float dl=__builtin_fmaxf(rm,lower_); mhat=fadd_s(mhat,dl); \
      _Pragma("unroll") for(int r=0;r<16;++r){P0[r]=fsub_s(P0[r],dl);P1[r]=fsub_s(P1[r],dl);} \
      _Pragma("unroll") for(int r=0;r<16;++r)negm[r]=-mhat; asm volatile("":"+v"(negm)); } \
    _Pragma("unroll") for(int r=0;r<16;++r)P0[r]=__builtin_amdgcn_exp2f(P0[r]); }while(0)
  #define RESC() do{ if(resc){ asm volatile("s_waitcnt lgkmcnt(0)":::"memory"); \
      _Pragma("unroll") for(int d_=0;d_<2;++d_) _Pragma("unroll") for(int r=0;r<16;++r)o[d_][r]*=wsf[crow(r,hi)]; } }while(0)
  #define ROT() do{sl_prev=sl_cur;sl_cur=sl_next;sl_next=(sl_next==(NSLOT-1)*SLOTB)?0:sl_next+SLOTB;}while(0)
  { WAVE_CONSTS(); (void)wsf;(void)vb0;(void)Kbase;(void)kp0;(void)vp0;(void)qrel;(void)fbx;(void)qx; UNIT_ISSUE(rank); }
  int nrank,nu=0; bool pst=false;
  #pragma nounroll
  for(;;){
  WAVE_CONSTS(); bf16x8 kf[8];
  float mhat=0.f,l_reg=0.f;f32x16 o[2];o[0]=f32x16{};o[1]=f32x16{};f32x16 negm=f32x16{};asm volatile("":"+v"(negm));
  bool resc=false;
  f32x16 pA0,pA1,pB0,pB1;
  int sl_prev=0,sl_cur=0,sl_next=SLOTB;
  int j0; float cb; bool nomax;
  { float sc_=su_bt;
    #define DPPF0(V,CTRL,RM) __builtin_bit_cast(float,__builtin_amdgcn_update_dpp(0,__builtin_bit_cast(int,V),CTRL,RM,0xf,true))
    sc_+=DPPF0(sc_,0x111,0xf); sc_+=DPPF0(sc_,0x112,0xf); sc_+=DPPF0(sc_,0x114,0xf); sc_+=DPPF0(sc_,0x118,0xf);
    sc_+=DPPF0(sc_,0x142,0xa);
    #undef DPPF0
    const float offv=sc_-su_bt;
    const float kn2=__uint_as_float(su_k0)+__uint_as_float(su_k1);
    float qn2=0.f,ku2=0.f;
    #pragma unroll
    for(int r=0;r<4;++r){ qn2=fmaxf(qn2,__uint_as_float(su_q[2*r])+__uint_as_float(su_q[2*r+1])); ku2=fmaxf(ku2,__uint_as_float(su_u[2*r])+__uint_as_float(su_u[2*r+1])); }
    const float Qm=sqrtf(qn2)*1.01f,Kj=sqrtf(kn2)*1.01f,Ku=sqrtf(ku2)*1.01f; cb=Qm*Ku;
    const float fbj=-(su_fcj+pg8::lane_read(offv,lane>>1)),fb0=-(su_fc0+pg8::lane_read(offv,2*qb));
    const bool needed=(lane>=4*qb)||!(Qm*(Kj+Ku)+fbj-fb0<SKIP_L2);
    j0=__builtin_amdgcn_readfirstlane((int)(__builtin_ctzll(__ballot(needed)))&~1);
    nomax=(__ballot((lane>=j0)&&(lane<NTF)&&!(Qm*(Kj+Ku)<=78.f))==0ull);
    __attribute__((address_space(3))) u32x4* tb=(__attribute__((address_space(3))) u32x4*)(shm3+LDS_FB);
    #pragma unroll
    for(int k_=0;k_<2;++k_){ const int s_=tid*4+k_*NW*256;
      if(s_<kend){ const f32x4_l v_=(k_?su_v1:su_v0)+pg8::lane_read(offv,s_>>7); unsigned w0[4],w1[4];
        #pragma unroll
        for(int i_=0;i_<4;++i_){ const float f=-v_[i_]; const unsigned hb=cvtpk_s(f,0.f)&0xffffu; const float r1=f-__uint_as_float(hb<<16); const unsigned mb=cvtpk_s(r1,0.f)&0xffffu; const float r2=r1-__uint_as_float(mb<<16);
          w0[i_]=hb|(mb<<16); w1[i_]=cvtpk_s(r2,0.f)&0xffffu; }
        tb[s_/2]=(u32x4){w0[0],w1[0],w0[1],w1[1]}; tb[s_/2+1]=(u32x4){w0[2],w1[2],w0[3],w1[3]}; } }
  }
  const int NT=NTF-j0;
#if PROBE_STEPS
  steps+=NT;
#endif
  if(pst){WAIT_BAR(4);}else{WAIT_BAR(3);}
  float lower_; { const v2u_t e_=*(const __attribute__((address_space(3))) v2u_t*)(shm3+LDS_FB+(q0+qrel)*8); lower_=(__uint_as_float(e_[0]<<16)+__uint_as_float(e_[0]&0xffff0000u))+__uint_as_float(e_[1]<<16)-cb; }
  CINIT(pA0,pA1,0); qkt(pA0,pA1,Kbase,qr,r32,hi);asm volatile("s_nop 15\n\ts_nop 7":"+v"(pA0),"+v"(pA1));CMASK(pA0,pA1,0);
  START(pA0,pA1);
  _Pragma("unroll") for(int r=0;r<16;++r)pA1[r]=__builtin_amdgcn_exp2f(pA1[r]);
  if(pst){WAIT_BAR(4);}else{WAIT_BAR(0);}
  DMA_K(3,0);DMA_V(1,SLOTB);
  ROT();
  kload8(kf,kp0+sl_cur);
  WAIT_BAR(2);
  s16x4 vlo[8],vhi[8]; u32x4 pw0,pw1,pw2,pw3;
  #define PKW(P,B) cvtpk_s(P[B],P[B+1])
  #define PAF(k) __builtin_bit_cast(bf16x8,pw##k)
  #define VFR(i) (bf16x8){vlo[i][0],vlo[i][1],vlo[i][2],vlo[i][3],vhi[i][0],vhi[i][1],vhi[i][2],vhi[i][3]}
  #define PIN(x) asm volatile("":"+v"(x))
  #define MX3(a,b,c) __builtin_fmaxf(__builtin_fmaxf((a),(b)),(c))
  #define GAPA(MF,A0,A1,A2,A3,W0,W1,PW) do{ MF; sacc+=A0; sacc+=A1; sacc+=A2; sacc+=A3; PIN(sacc); W0; W1; PIN(PW); SBAR(); }while(0)
  #define EX(v) __builtin_amdgcn_exp2f(v)
  #define GAPB(MF,X,B) do{ MF; X[B]=EX(X[B]); X[B+1]=EX(X[B+1]); X[B+2]=EX(X[B+2]); X[B+3]=EX(X[B+3]); PIN(X); SBAR(); }while(0)
  #define VRD(i) do{ vlo[i]=vtr(vp_+(((i)>>2)*4096+((i)&3)*1024)); vhi[i]=vtr(vp_+(((i)>>2)*4096+((i)&3)*1024+512)); }while(0)
  #define KRD(G,j) do{ if(G){ kload2(kf,kp0+sl_next,j); SBAR(); } }while(0)
  #define STEP(C0,C1,P0,P1,t,GK,GV,GL) STEPX(C0,C1,P0,P1,t,GK,GV,GL,true)
  #define STEPX(C0,C1,P0,P1,t,GK,GV,GL,MX) do{ SBAR(); CINIT(C0,C1,t); SBAR(); \
    const lds_cptr vp_=vp0+sl_prev; \
    VRD(0); SBAR(); float sacc=(P0[0]+P0[1]); \
    GAPA(C0=__builtin_amdgcn_mfma_f32_32x32x16_bf16(kf[0],qr[0],C0,0,0,0), P0[2],P0[3],P0[4],P0[5],     pw0[0]=PKW(P0,0), pw0[1]=PKW(P0,2), pw0); \
    VRD(4); SBAR(); GAPA(C1=__builtin_amdgcn_mfma_f32_32x32x16_bf16(kf[1],qr[0],C1,0,0,0), P0[6],P0[7],P0[8],P0[9],     pw0[2]=PKW(P0,4), pw0[3]=PKW(P0,6), pw0); \
    VRD(1); SBAR(); GAPA(C0=__builtin_amdgcn_mfma_f32_32x32x16_bf16(kf[2],qr[1],C0,0,0,0),   P0[10],P0[11],P0[12],P0[13], pw1[0]=PKW(P0,8), pw1[1]=PKW(P0,10), pw1); \
    VRD(5); SBAR(); GAPA(C1=__builtin_amdgcn_mfma_f32_32x32x16_bf16(kf[3],qr[1],C1,0,0,0),   P0[14],P0[15],P1[0],P1[1],   pw1[2]=PKW(P0,12),pw1[3]=PKW(P0,14), pw1); \
    VRD(2); SBAR(); GAPA(C0=__builtin_amdgcn_mfma_f32_32x32x16_bf16(kf[4],qr[2],C0,0,0,0),   P1[2],P1[3],P1[4],P1[5],     pw2[0]=PKW(P1,0), pw2[1]=PKW(P1,2), pw2); \
    VRD(6); SBAR(); GAPA(C1=__builtin_amdgcn_mfma_f32_32x32x16_bf16(kf[5],qr[2],C1,0,0,0),   P1[6],P1[7],P1[8],P1[9],     pw2[2]=PKW(P1,4), pw2[3]=PKW(P1,6), pw2); \
    VRD(3); SBAR(); GAPA(C0=__builtin_amdgcn_mfma_f32_32x32x16_bf16(kf[6],qr[3],C0,0,0,0),   P1[10],P1[11],P1[12],P1[13], pw3[0]=PKW(P1,8), pw3[1]=PKW(P1,10), pw3); \
    VRD(7); SBAR(); GAPA(C1=__builtin_amdgcn_mfma_f32_32x32x16_bf16(kf[7],qr[3],C1,0,0,0),   P1[14],P1[15],0.f,0.f,       pw3[2]=PKW(P1,12),pw3[3]=PKW(P1,14), pw3); \
    l_reg+=sacc; \
    if(GK){DMA_K((t)+3,sl_cur);} if(GV){DMA_V((t)+1,sl_next);} \
    CMASK(C0,C1,t); \
    if(!(MX)){ resc=false; } else \
    { float a=MX3(C0[0],C0[1],C1[0]),b=MX3(C0[2],C0[3],C1[1]); a=MX3(a,C1[2],C1[3]); \
      _Pragma("unroll") for(int r=4;r<16;r+=4){a=MX3(a,C0[r],C0[r+1]);b=MX3(b,C0[r+2],C0[r+3]);a=MX3(a,C1[r],C1[r+1]);b=MX3(b,C1[r+2],C1[r+3]);} \
      float rm=__builtin_fmaxf(a,b); { auto rr=__builtin_amdgcn_permlane32_swap(__float_as_uint(rm),__float_as_uint(rm),false,false); rm=__builtin_fmaxf(__uint_as_float(rr[0]),__uint_as_float(rr[1])); } \
      resc=false; \
      if(__builtin_expect(__any(rm>(float)THRL),0)){ const float dl=__builtin_fmaxf(rm,0.f); mhat+=dl; \
        _Pragma("unroll") for(int r=0;r<16;++r){C0[r]-=dl;C1[r]-=dl;} \
        _Pragma("unroll") for(int r=0;r<16;++r)negm[r]=-mhat; asm volatile("":"+v"(negm)); \
        const float f=__builtin_amdgcn_exp2f(-dl); l_reg*=f; if(hi==0)wsf[r32]=f; resc=true; } } \
    SBAR(); \
    GAPB(o[0]=__builtin_amdgcn_mfma_f32_32x32x16_bf16(PAF(0),VFR(0),o[0],0,0,0), C0,0); \
    GAPB(o[1]=__builtin_amdgcn_mfma_f32_32x32x16_bf16(PAF(0),VFR(4),o[1],0,0,0), C0,4); \
    KRD(GL,0); GAPB(o[0]=__builtin_amdgcn_mfma_f32_32x32x16_bf16(PAF(1),VFR(1),o[0],0,0,0), C0,8); \
    KRD(GL,1); GAPB(o[1]=__builtin_amdgcn_mfma_f32_32x32x16_bf16(PAF(1),VFR(5),o[1],0,0,0), C0,12); \
    KRD(GL,2); GAPB(o[0]=__builtin_amdgcn_mfma_f32_32x32x16_bf16(PAF(2),VFR(2),o[0],0,0,0), C1,0); \
    KRD(GL,3); GAPB(o[1]=__builtin_amdgcn_mfma_f32_32x32x16_bf16(PAF(2),VFR(6),o[1],0,0,0), C1,4); \
    GAPB(o[0]=__builtin_amdgcn_mfma_f32_32x32x16_bf16(PAF(3),VFR(3),o[0],0,0,0), C1,8); \
    GAPB(o[1]=__builtin_amdgcn_mfma_f32_32x32x16_bf16(PAF(3),VFR(7),o[1],0,0,0), C1,12); \
    }while(0)
  int t=1;
  #define ENDW(tt) do{ if((tt)+3<NT){WAIT_BAR(2);} else if((tt)+2<NT){WAIT_BAR(1);} else {WAIT_BAR(0);} }while(0)
  #define GUARDED_PAIR() do{ \
    STEPX(pB0,pB1,pA0,pA1,t,(t+3<NT),(t+1<NT),(t+1<NT),!nomax);       ENDW(t);   RESC(); ROT(); \
    STEPX(pA0,pA1,pB0,pB1,t+1,(t+4<NT),(t+2<NT),(t+2<NT),!nomax);     ENDW(t+1); RESC(); ROT(); }while(0)
  for(;t<5&&t+1<NT;t+=2){ GUARDED_PAIR(); }
  #undef CMASK
  #define CMASK(P0,P1,t) do{}while(0)
  for(;t+5<NT;t+=2){
    STEPX(pB0,pB1,pA0,pA1,t,true,true,true,!nomax);     WAIT_BAR(2); RESC(); ROT();
    STEPX(pA0,pA1,pB0,pB1,t+1,true,true,true,!nomax);   WAIT_BAR(2); RESC(); ROT();
  }
  #undef CMASK
  #define CMASK(P0,P1,t) do{int jb_=3-(t); if(jb_>=0)cmask(P0,P1,jb_,qrel,hi);}while(0)
  for(;t+1<NT;t+=2){ GUARDED_PAIR(); }
  unsigned su_tk=0u; { const char*w_=AB.ws; asm volatile("":"+s"(w_)); if(tid==0)su_tk=__hip_atomic_fetch_add((unsigned*)(w_+AB.qat)+64*x,1u,__ATOMIC_RELAXED,__HIP_MEMORY_SCOPE_AGENT); }
  STEPX(pB0,pB1,pA0,pA1,NT-1,false,false,false,!nomax); RESC();
  { float sacc=pB0[0]+pB0[1]; _Pragma("unroll") for(int r=2;r<16;++r)sacc+=pB0[r]; _Pragma("unroll") for(int r=0;r<16;++r)sacc+=pB1[r]; l_reg+=sacc;
    pw0=(u32x4){PKW(pB0,0),PKW(pB0,2),PKW(pB0,4),PKW(pB0,6)};pw1=(u32x4){PKW(pB0,8),PKW(pB0,10),PKW(pB0,12),PKW(pB0,14)};pw2=(u32x4){PKW(pB1,0),PKW(pB1,2),PKW(pB1,4),PKW(pB1,6)};pw3=(u32x4){PKW(pB1,8),PKW(pB1,10),PKW(pB1,12),PKW(pB1,14)};
    SBAR(); pv(o,vb0+sl_cur,PAF(0),PAF(1),PAF(2),PAF(3)); }
  bf16*Ow; { const char*w_=AB.ws; asm volatile("":"+s"(w_)); Ow=(bf16*)(w_+AB.o)+(rowbase+q0+wid*QBLK)*ODM+h*D; }
  if(tid==0)*(volatile __attribute__((address_space(3))) unsigned*)(shm3+LDS_TICKET)=su_tk;
  asm volatile("s_waitcnt vmcnt(0) lgkmcnt(0)\n\ts_barrier":::"memory");
  nrank=32+__builtin_amdgcn_readfirstlane((int)*(volatile __attribute__((address_space(3))) unsigned*)(shm3+LDS_TICKET));
  #define UNIT_EPILOGUE() do{ \
  {auto rr=__builtin_amdgcn_permlane32_swap(__float_as_uint(l_reg),__float_as_uint(l_reg),false,false);l_reg=__uint_as_float(rr[0])+__uint_as_float(rr[1]);} \
  if(hi==0)wsf[32+r32]=l_reg;asm volatile("s_waitcnt lgkmcnt(0)":::"memory"); \
  float rli[16]; \
  _Pragma("unroll") \
  for(int r=0;r<16;++r)rli[r]=__builtin_amdgcn_rcpf(wsf[32+crow(r,hi)]); \
  { bf16*stg=(bf16*)(shm+LDS_OST)+wid*2048; \
    _Pragma("unroll") \
    for(int r=0;r<16;++r){const int orow=crow(r,hi); \
      _Pragma("unroll") \
      for(int d0=0;d0<2;++d0)stg[orow*64+d0*32+r32]=__float2bfloat16(o[d0][r]*rli[r]);} \
    asm volatile("s_waitcnt lgkmcnt(0)":::"memory"); \
    asm volatile("s_waitcnt vmcnt(0)":"+v"(qr[0]),"+v"(qr[1]),"+v"(qr[2]),"+v"(qr[3])::"memory"); \
    _Pragma("unroll") \
    for(int i=0;i<4;++i){const int row=i*8+(lane>>3),ch=lane&7; const u32x4 v=*(const u32x4*)(stg+row*64+ch*8); ATTN_STORE16(Ow+(long)row*ODM+ch*8,v);} } \
  }while(0)
  ++nu; const bool go_=(nrank<128)&&(nu<maxu);
  if(go_){ UNIT_ISSUE(nrank); }
  else{ qb=0;q0=0;h=0;NTF=0;kend=0;rowbase=0;Kh=nullptr;Vh=nullptr; su_bt=0.f;su_fcj=0.f;su_fc0=0.f;su_k0=0u;su_k1=0u;
    _Pragma("unroll") for(int r=0;r<8;++r){su_q[r]=0u;su_u[r]=0u;} su_v0=(f32x4_l){0.f,0.f,0.f,0.f};su_v1=su_v0;
    _Pragma("unroll") for(int d0=0;d0<4;++d0)qr[d0]=bf16x8{}; }
  UNIT_EPILOGUE();
  if(!go_)break;
  pst=true;
  }
  ndone+=nu;
  #undef UNIT_EPILOGUE
  #undef PKW
  #undef PAF
  #undef VFR
  #undef PIN
  #undef MX3
  #undef GAPA
  #undef GAPB
  #undef EX
  #undef VRD
  #undef KRD
  #undef STEP
  #undef STEPX
  #undef ENDW
  #undef GUARDED_PAIR
  #undef UNIT_ISSUE
  #undef WAVE_CONSTS
  #undef NRMW
  #undef DMA_K
  #undef DMA_V
  #undef CMASK
  #undef START
  #undef RESC
  #undef ROT
  #undef CINIT
  #undef XFR
  asm volatile("s_barrier":::"memory");
  return nrank;
}
constexpr int ATTN_LDS_BYTES=LDS_FB+LDS_FB_BYTES;
struct AttnTensors { const bf16* Q; const bf16* K; const bf16* V; bf16* O; const float* FC; const float* BT; };
struct AttnUnit { int bh; int qb; };
struct StaticOrder {
  int vcu;
  __device__ __forceinline__ explicit StaticOrder(int vcu_):vcu(vcu_){}
  __device__ __forceinline__ bool next(int i,AttnUnit&u)const{ if(i>=4||vcu>=256)return false; const int s=vcu&3; u.bh=vcu>>2; u.qb=(i==0)?s:(i==1)?7-s:(i==2)?8+s:15-s; return true; }
};
__device__ __forceinline__ int skip_tiles(const unsigned*nrm,const float*FCbh,const float offv,int bh,int qb,int lane,float&cb){
  const unsigned*qn=nrm+((size_t)bh*64)*2,*kn=nrm+((size_t)(64+bh)*64)*2;
  #define NRM2(p,i) (__uint_as_float(__hip_atomic_load((p)+2*(i),__ATOMIC_RELAXED,__HIP_MEMORY_SCOPE_AGENT))+__uint_as_float(__hip_atomic_load((p)+2*(i)+1,__ATOMIC_RELAXED,__HIP_MEMORY_SCOPE_AGENT)))
  const float kn2=NRM2(kn,lane);
  float qn2=0.f,ku2=0.f;
  #pragma unroll
  for(int r=0;r<4;++r){ qn2=fmaxf(qn2,NRM2(qn,4*qb+r)); ku2=fmaxf(ku2,NRM2(kn,4*qb+r)); }
  #undef NRM2
  const float Qm=sqrtf(qn2)*1.01f,Kj=sqrtf(kn2)*1.01f,Ku=sqrtf(ku2)*1.01f; cb=Qm*Ku;
  const float fbj=-(FCbh[64*lane+63]+pg8::lane_read(offv,lane>>1)),fb0=-(FCbh[256*qb]+pg8::lane_read(offv,2*qb));
  const bool needed=(lane>=4*qb)||!(Qm*(Kj+Ku)+fbj-fb0<-152.f);
  const unsigned long long mask=__ballot(needed);
  return (int)(__builtin_ctzll(mask))&~1;
}
template<int THRL=32,class Hook> __device__ __forceinline__ void attn_phase(char*lds,const AttnBase&AB,const int vcu,const int tid,Hook&hk){
#if PROBE_STEPS
  unsigned long long pa_=0ull,pb_=0ull,pc_=0ull;
#endif
  int x=vcu>>5,rank=vcu&31,steps=0,ndone=0;
  const int cvt_after=vcu&3; bool cvt_done=false,fin=false;
  volatile __attribute__((address_space(3))) int* tk=(volatile __attribute__((address_space(3))) int*)((lds_cptr)lds+LDS_TICKET);
  const bool young_=__builtin_amdgcn_readfirstlane(tid)>=256; if(young_)__builtin_amdgcn_s_setprio(1);
  #pragma nounroll
  for(;;){
    if(!cvt_done&&(fin||ndone>=cvt_after)){ if(young_)__builtin_amdgcn_s_setprio(0);
#if PROBE_STEPS
      const unsigned long long pq_=__builtin_amdgcn_s_memrealtime();
#endif
      hk.convert();
#if PROBE_STEPS
      pc_=__builtin_amdgcn_s_memrealtime()-pq_;
#endif
      if(young_)__builtin_amdgcn_s_setprio(1); cvt_done=true; }
    if(fin)break;
    if(rank<128){ rank=attn_units<THRL>(x,rank,AB,cvt_done?(1<<20):cvt_after-ndone,ndone,steps,lds); continue; }
    unsigned*qbase; { const char*w_=AB.ws; asm volatile("":"+s"(w_)); qbase=(unsigned*)(w_+AB.qat); }
    int t2_=threadIdx.x; asm volatile("":"+v"(t2_)); const int lane=t2_&63;
    if(t2_<64){ unsigned c=96u; if(lane<8)c=__hip_atomic_load(qbase+64*lane,__ATOMIC_RELAXED,__HIP_MEMORY_SCOPE_AGENT);
      int key=c<96u?(int)(((96u-c)<<3)|(unsigned)lane):0;
      #pragma unroll
      for(int o_=1;o_<8;o_<<=1){ const int t_=__builtin_amdgcn_ds_bpermute((lane^o_)<<2,key); key=key>t_?key:t_; }
      int xv=-1,rk=0;
      if(key>0){ xv=key&7; unsigned old=0u; if(lane==0)old=__hip_atomic_fetch_add(qbase+64*xv,1u,__ATOMIC_RELAXED,__HIP_MEMORY_SCOPE_AGENT); rk=32+(int)old; }
      if(lane==0){ tk[1]=xv; tk[2]=rk; } }
    __syncthreads();
    const int xv=__builtin_amdgcn_readfirstlane(tk[1]),rk=__builtin_amdgcn_readfirstlane(tk[2]);
    __syncthreads();
    if(xv<0){fin=true;continue;}
    x=xv; rank=rk;
  }
  if(young_)__builtin_amdgcn_s_setprio(0);
  { unsigned*pq; { const char*w_=AB.ws; asm volatile("":"+s"(w_)); pq=(unsigned*)(w_+AB.pq); }
    #pragma nounroll
    for(;;){ int t3_=threadIdx.x; asm volatile("":"+v"(t3_));
      if(t3_==0)tk[1]=(int)__hip_atomic_fetch_add(pq,1u,__ATOMIC_RELAXED,__HIP_MEMORY_SCOPE_AGENT);
      __syncthreads(); const int it=__builtin_amdgcn_readfirstlane(tk[1]); __syncthreads();
      if(it>=256)break;
      hk.block(it); } }
  hk.steps=steps;
#if PROBE_STEPS
  if(PROBE_STEPS==7)hk.steps=(int)((pb_-pa_)/10ull);
  if(PROBE_STEPS==8)hk.steps=(int)(pc_/10ull);
#endif
}
#undef SBAR
#undef WAIT_BAR
}

constexpr int NWAVES = 8;
#ifndef MK_PER_PHASE
#define MK_PER_PHASE 0
#endif
constexpr int BATCH = 8, SEQ = 4096, T = BATCH * SEQ, D = 1024, NL = 2, NH = 8, HD = 64, AW = 512, PW = 512, INW = 2056, NG = 4, NE = 8, NX = 32, FE = 256;
constexpr float RMS_EPS = 1e-6f;
constexpr int NPH = 16;
constexpr size_t MiB = 1u << 20;
constexpr size_t WS_CTL = 0, CTL_ZERO_BYTES = 1 * MiB;
constexpr size_t WS_MOD = 1 * MiB;
constexpr size_t WS_FRF = 1 * MiB + 512 * 1024;
constexpr size_t WS_RRF = WS_FRF + 128 * 1024;
constexpr size_t WS_FL = 2 * MiB;
constexpr size_t WS_FC = 3 * MiB;
constexpr size_t WS_CW = 4 * MiB;
constexpr size_t WS_LIST = 5 * MiB;
constexpr size_t WS_WIN = 10 * MiB, WS_WOUT = 18 * MiB, WS_WGU = 22 * MiB, WS_WD = 86 * MiB;
constexpr size_t WS_H = 118 * MiB;
constexpr size_t WS_QKVU = 182 * MiB;
constexpr size_t WS_AO = 310 * MiB;
constexpr size_t WS_DL = 374 * MiB;
constexpr size_t WS_XB = 438 * MiB;
constexpr size_t WS_END = 502 * MiB;
constexpr int CW_TIL = 98304, TIL_STRIDE = 320 * 64;
constexpr int CW_NRM = 32768, NRM_WORDS = 2 * 64 * 64 * 2;
constexpr int CW_PQ = 13312;
constexpr int CW_QAT = 12288;
constexpr int CW_TMO = 0, CW_CODE = 1, CW_BAR = 4096, CW_CNT = 16384;
constexpr int RING_OFF = 0, RING_BYTES = 131072;
constexpr int LDSCTL_OFF = RING_BYTES, MISC_OFF = LDSCTL_OFF + 320;
constexpr int ENT_OFF = LDSCTL_OFF + 1024, ENT_UNITS = 8;
constexpr int CWT_OFF = ENT_OFF + ENT_UNITS * 1024;
constexpr int TST_OFF = CWT_OFF + 3 * 1024;
constexpr int LDS_BYTES = 147456;
static_assert(TST_OFF + (65 + 4 * ENT_UNITS + 2) * 4 <= LDS_BYTES && MISC_OFF + 128 <= ENT_OFF, "LDS map");

#define GAS __attribute__((address_space(1)))
#define LAS __attribute__((address_space(3)))
typedef unsigned short bf16;
typedef unsigned v4u __attribute__((ext_vector_type(4)));
typedef float f32x4 __attribute__((ext_vector_type(4)));
typedef short bf16x8 __attribute__((ext_vector_type(8)));
typedef GAS unsigned gu32;
typedef GAS unsigned long long gu64;
#define RLX_AGENT __ATOMIC_RELAXED, __HIP_MEMORY_SCOPE_AGENT
#define LDS_WAIT() asm volatile("s_waitcnt lgkmcnt(0)" ::: "memory")
#define VM_WAIT() asm volatile("s_waitcnt vmcnt(0)" ::: "memory")
__device__ __forceinline__ unsigned long long rt() { return __builtin_amdgcn_s_memrealtime(); }
__device__ __forceinline__ unsigned f2bf(float f) { unsigned u = __builtin_bit_cast(unsigned, f); return (u + 0x7fffu + ((u >> 16) & 1u)) >> 16; }
__device__ __forceinline__ unsigned pk2(float lo, float hi) { return f2bf(lo) | (f2bf(hi) << 16); }

#define XB_TMO      128
#define XB_XCNT(j)  (256  + 64 * (j))
#define XB_XSUB(j)  (1280 + 64 * (j))
#define XB_XGEN(j)  (2304 + 64 * (j))
#define XB_TOP      3328
#define XB_TOPGEN   3392
#define XCD_BAR_WORDS 3456
#define XB_SPIN_CAP (1u << 18)

__device__ __forceinline__ unsigned xb_ld(unsigned* p)              { return __hip_atomic_load(p, __ATOMIC_RELAXED, __HIP_MEMORY_SCOPE_AGENT); }
__device__ __forceinline__ unsigned xb_add(unsigned* p, unsigned v) { return __hip_atomic_fetch_add(p, v, __ATOMIC_RELAXED, __HIP_MEMORY_SCOPE_AGENT); }
__device__ __forceinline__ unsigned xb_xcc_id() { return (unsigned)__builtin_amdgcn_s_getreg((3 << 11) | 20) & 0xFu; }
#define XB_SPIN(cond, bar) do { unsigned _sp = 0; while (cond) { __builtin_amdgcn_s_sleep(1); \
    if ((++_sp & 255u) == 0u) { if (xb_ld(&(bar)[XB_TMO])) break; if (_sp > XB_SPIN_CAP) { atomicAdd(&(bar)[XB_TMO], 1u); break; } } } } while (0)

struct XcdBarrier {
    unsigned* bar; unsigned x;
    volatile LAS unsigned* st;
};

__device__ __forceinline__ XcdBarrier xcd_barrier_post(unsigned* bar, volatile LAS unsigned* st) {
    XcdBarrier b; b.bar = bar; b.x = xb_xcc_id(); b.st = st;
    if (threadIdx.x == 0) (void)xb_add(&bar[XB_XCNT(b.x)], 1u);
    return b;
}
__device__ __forceinline__ void xcd_barrier_complete(unsigned* bar, unsigned x, unsigned& nloc, unsigned& nx) {
    const unsigned G = gridDim.x * gridDim.y * gridDim.z;
    unsigned sum, cnt, mine, sp = 0u;
    for (;;) {
        sum = 0u; cnt = 0u; mine = 0u;
#pragma unroll
        for (unsigned j = 0; j < 16; ++j) { const unsigned c = xb_ld(&bar[XB_XCNT(j)]); sum += c; cnt += (c > 0u) ? 1u : 0u; mine = (j == x) ? c : mine; }
        if (sum == G) break;
        __builtin_amdgcn_s_sleep(1);
        if ((++sp & 255u) == 0u) { if (xb_ld(&bar[XB_TMO])) break; if (sp > XB_SPIN_CAP) { atomicAdd(&bar[XB_TMO], 1u); break; } }
    }
    nloc = mine > 0u ? mine : 1u; nx = cnt > 0u ? cnt : 1u;
}

__device__ __forceinline__ void xcd_barrier(const XcdBarrier& b) {
    asm volatile("s_waitcnt vmcnt(0)" ::: "memory");
    __syncthreads();
    if (threadIdx.x == 0) {
        unsigned* bar = b.bar;
        __builtin_amdgcn_s_waitcnt(0);
        unsigned nloc = b.st[0], nx = b.st[1];
        if (nloc == 0u) { xcd_barrier_complete(bar, b.x, nloc, nx); b.st[0] = nloc; b.st[1] = nx; }
        const unsigned old = xb_add(&bar[XB_XSUB(b.x)], 1u);
        const unsigned gen = old / nloc;
        if (old + 1u == (gen + 1u) * nloc) {
            __builtin_amdgcn_fence(__ATOMIC_RELEASE, "agent");
            asm volatile("s_waitcnt vmcnt(0)" ::: "memory");
            const unsigned og = xb_add(&bar[XB_TOP], 1u);
            const unsigned tg = og / nx;
            if (og + 1u == (tg + 1u) * nx) xb_add(&bar[XB_TOPGEN], 1u);
            else XB_SPIN(xb_ld(&bar[XB_TOPGEN]) == tg, bar);
            __builtin_amdgcn_fence(__ATOMIC_ACQUIRE, "agent");
            xb_add(&bar[XB_XGEN(b.x)], 1u);
            asm volatile("s_waitcnt vmcnt(0)" ::: "memory");
        } else {
            XB_SPIN(xb_ld(&bar[XB_XGEN(b.x)]) == gen, bar);
            __builtin_amdgcn_fence(__ATOMIC_ACQUIRE, "agent");
            asm volatile("s_waitcnt vmcnt(0)" ::: "memory");
        }
    }
    __syncthreads();
}

struct Frame {
    LAS unsigned char* lds;
    volatile LAS unsigned* MISC;
    gu32* ctl;
    int tid, lane, wave;
    int vcu, G;
};
typedef unsigned u32x4v __attribute__((ext_vector_type(4)));
__device__ __forceinline__ float bflo(unsigned w) { return __builtin_bit_cast(float, w << 16); }
__device__ __forceinline__ float bfhi(unsigned w) { return __builtin_bit_cast(float, w & 0xffff0000u); }
__device__ __forceinline__ unsigned cvtpk(float lo, float hi) { unsigned r; asm volatile("v_cvt_pk_bf16_f32 %0, %1, %2" : "=v"(r) : "v"(lo), "v"(hi)); return r; }

__device__ __forceinline__ void transpose_load64(f32x4 (&v)[16], const float* W, int ldw, int k0, int n0src, int lane) {
    const float* src = W + (size_t)(k0 + (lane >> 4)) * ldw + n0src + 4 * (lane & 15);
#pragma unroll
    for (int i = 0; i < 16; ++i) v[i] = *(const f32x4*)(src + (size_t)(4 * i) * ldw);
}
__device__ __forceinline__ void transpose_finish64(const f32x4 (&v)[16], bf16* WT, int ldt, int k0, int dstrow0, LAS float* scr, int lane) {
#pragma unroll
    for (int i = 0; i < 16; ++i) { const int k = 4 * i + (lane >> 4); const int col = (4 * (lane & 15) + 8 * (k >> 3)) & 63; *(LAS f32x4*)(scr + k * 64 + col) = v[i]; }
    LDS_WAIT(); asm volatile("" ::: "memory");
    const int c = lane >> 3;
#pragma unroll
    for (int q = 0; q < 8; ++q) { const int n = (lane & 7) + 8 * q; const LAS float* s_ = scr + (8 * c) * 64 + ((n + 8 * c) & 63);
        v4u o; o.x = pk2(s_[0], s_[64]); o.y = pk2(s_[128], s_[192]); o.z = pk2(s_[256], s_[320]); o.w = pk2(s_[384], s_[448]);
        *(GAS v4u*)(WT + (size_t)(dstrow0 + n) * ldt + k0 + 8 * c) = o; }
    LDS_WAIT(); asm volatile("" ::: "memory");
}
__device__ __forceinline__ void transpose_item64(const float* W, int ldw, bf16* WT, int ldt, int k0, int n0src, int dstrow0, LAS float* scr, int lane) {
    f32x4 v[16];
    transpose_load64(v, W, ldw, k0, n0src, lane);
    asm volatile("" ::: "memory"); __builtin_amdgcn_sched_barrier(0);
    transpose_finish64(v, WT, ldt, k0, dstrow0, scr, lane);
}
struct In {
    const float *x, *c, *g_mix, *g_ffn, *g_fin, *w_ada, *b_ada, *w_in, *b_fg, *w_pool, *pool_scale, *w_out, *w_rg, *b_rg, *w_re, *b_re, *w_eg, *w_eu, *w_ed;
};
__device__ __forceinline__ void p0_prologue(Frame& F, const In& I, unsigned char* ws, int mode) {
    bf16* WinT = (bf16*)(ws + WS_WIN); bf16* WoutT = (bf16*)(ws + WS_WOUT);
    float* MOD = (float*)(ws + WS_MOD);
#ifndef WG_REPS
#define WG_REPS 1
#endif
#pragma nounroll
    for (int wrp = 0; wrp < WG_REPS; ++wrp)
    if (mode != 1 && F.vcu < 64) {
        const int l = F.vcu >> 5, g = (F.vcu >> 3) & 3, nb = F.vcu & 7;
        LAS float* ApT = (LAS float*)F.lds;
        LAS float* Bw = ApT + 128 * 128;
        const float* wp = I.w_pool + (size_t)(l * 4 + g) * 128 * 128; const float* ps = I.pool_scale + l * 512 + g * 128;
        const float* wo = I.w_out + (size_t)l * D * D + (size_t)(512 + 128 * g) * D + 128 * nb;
        { f32x4 va[8], vb[8];
#pragma unroll
          for (int j = 0; j < 8; ++j) { const int q4 = F.tid + 512 * j; const int r = q4 >> 5, c4 = (q4 & 31) * 4; va[j] = *(const f32x4*)(wp + r * 128 + c4); vb[j] = *(const f32x4*)(wo + (size_t)r * D + c4); }
#pragma unroll
          for (int j = 0; j < 8; ++j) { const int q4 = F.tid + 512 * j; const int r = q4 >> 5, c4 = (q4 & 31) * 4;
              const f32x4 p4 = *(const f32x4*)(ps + c4);
              const int rs = r ^ (((c4 >> 2) & 15) << 3);
              ApT[(c4 + 0) * 128 + rs] = va[j][0] * p4[0]; ApT[(c4 + 1) * 128 + rs] = va[j][1] * p4[1]; ApT[(c4 + 2) * 128 + rs] = va[j][2] * p4[2]; ApT[(c4 + 3) * 128 + rs] = va[j][3] * p4[3];
              *(LAS f32x4*)(Bw + r * 128 + c4) = vb[j]; } }
        __syncthreads();
        const int tn = F.tid & 31, tc = F.tid >> 5;
        float acc[4][8];
#pragma unroll
        for (int i = 0; i < 4; ++i)
#pragma unroll
            for (int j = 0; j < 8; ++j) acc[i][j] = 0.f;
#pragma unroll 2
        for (int d = 0; d < 128; ++d) { const f32x4 bv = *(const LAS f32x4*)(Bw + d * 128 + 4 * tn);
            const int cs = (8 * tc) ^ (((d >> 2) & 15) << 3);
            const f32x4 a0 = *(const LAS f32x4*)(ApT + d * 128 + cs), a1 = *(const LAS f32x4*)(ApT + d * 128 + cs + 4);
#pragma unroll
            for (int i = 0; i < 4; ++i) { acc[i][0] += a0[0] * bv[i]; acc[i][1] += a0[1] * bv[i]; acc[i][2] += a0[2] * bv[i]; acc[i][3] += a0[3] * bv[i];
                acc[i][4] += a1[0] * bv[i]; acc[i][5] += a1[1] * bv[i]; acc[i][6] += a1[2] * bv[i]; acc[i][7] += a1[3] * bv[i]; } }
#pragma unroll
        for (int i = 0; i < 4; ++i) { bf16* dst = WoutT + (size_t)l * D * D + (size_t)(128 * nb + 4 * tn + i) * D + 512 + 128 * g + 8 * tc;
            v4u o; o.x = pk2(acc[i][0], acc[i][1]); o.y = pk2(acc[i][2], acc[i][3]); o.z = pk2(acc[i][4], acc[i][5]); o.w = pk2(acc[i][6], acc[i][7]);
            *(GAS v4u*)dst = o; }
        __syncthreads();
    } else if (mode != 1 && F.vcu < 256) {
        const int it = F.vcu - 64, l = it / 96, n0 = 64 * (it % 96);
        LAS float* cT = (LAS float*)F.lds;
        LAS float* part = (LAS float*)(F.lds + 32768);
        { float cv[16];
#pragma unroll
          for (int j = 0; j < 16; ++j) cv[j] = I.c[F.tid + 512 * j];
          asm volatile("" ::: "memory"); __builtin_amdgcn_sched_barrier(0);
#pragma unroll
          for (int j = 0; j < 16; ++j) { const int q = F.tid + 512 * j; const int b = q >> 10, k = q & 1023; cT[k * 8 + b] = cv[j] / (1.f + __expf(-cv[j])); } }
        __syncthreads();
        const int r4 = F.lane >> 4, c16 = F.lane & 15;
        const char* wb = (const char*)(I.w_ada + (size_t)l * D * 6144 + n0);
        const unsigned off0 = (unsigned)(((F.wave * 128 + r4) * 6144 + 4 * c16) * 4);
        float acc[8][4];
#pragma unroll
        for (int b = 0; b < 8; ++b) { acc[b][0] = 0.f; acc[b][1] = 0.f; acc[b][2] = 0.f; acc[b][3] = 0.f; }
#pragma unroll 1
        for (int kb = 0; kb < 2; ++kb) {
            f32x4 wv[16];
#pragma unroll
            for (int j = 0; j < 16; ++j) wv[j] = *(const f32x4*)(wb + (off0 + (unsigned)((kb * 64 + 4 * j) * 6144 * 4)));
            asm volatile("" ::: "memory"); __builtin_amdgcn_sched_barrier(0);
#pragma unroll
            for (int j = 0; j < 16; ++j) { const int k = F.wave * 128 + kb * 64 + 4 * j + r4;
                if ((j & 3) == 0) asm volatile("" ::: "memory");
                const f32x4 c0 = *(const LAS f32x4*)(cT + k * 8), c1 = *(const LAS f32x4*)(cT + k * 8 + 4);
#pragma unroll
                for (int i = 0; i < 4; ++i) { acc[0][i] += c0[0] * wv[j][i]; acc[1][i] += c0[1] * wv[j][i]; acc[2][i] += c0[2] * wv[j][i]; acc[3][i] += c0[3] * wv[j][i];
                    acc[4][i] += c1[0] * wv[j][i]; acc[5][i] += c1[1] * wv[j][i]; acc[6][i] += c1[2] * wv[j][i]; acc[7][i] += c1[3] * wv[j][i]; } }
        }
#pragma unroll
        for (int b = 0; b < 8; ++b) *(LAS f32x4*)(part + ((F.wave * 4 + r4) * 8 + b) * 64 + 4 * c16) = (f32x4){acc[b][0], acc[b][1], acc[b][2], acc[b][3]};
        __syncthreads();
        { const int b = F.wave; float s = I.b_ada[l * 6144 + n0 + F.lane];
#pragma unroll
            for (int sl = 0; sl < 32; ++sl) s += part[(sl * 8 + b) * 64 + F.lane];
            MOD[(size_t)(l * 8 + b) * 6144 + n0 + F.lane] = s; }
        __syncthreads();
    }
    { const int q = (F.G - 1 - F.vcu) * (NWAVES * 64) + F.tid;
      if (mode != 1 && q < NL * 32 * 4 * 64) {
        const int l = q >> 13, c = (q >> 8) & 31, nb4 = (q >> 6) & 3, ln = q & 63; const int n = ln & 15, k0 = 32 * c + 8 * (ln >> 4);
        const float* base; size_t stride; bool valid;
        if (nb4 == 3) { valid = n < 8; base = I.w_in + (size_t)l * D * INW + 1536 + (valid ? n : 0); stride = INW; }
        else { const int col = 16 * nb4 + n; valid = col < 36;
            if (col < 4) { base = I.w_rg + (size_t)l * D * 4 + col; stride = 4; }
            else { const int cc = valid ? col - 4 : 0; base = I.w_re + ((size_t)(l * 4 + (cc >> 3)) * D) * 8 + (cc & 7); stride = 8; } }
        float v[8];
#pragma unroll
        for (int j = 0; j < 8; ++j) v[j] = base[(size_t)(k0 + j) * stride];
#pragma unroll
        for (int j = 0; j < 8; ++j) v[j] = valid ? v[j] : 0.f;
        unsigned hi[4], lo[4];
#pragma unroll
        for (int j = 0; j < 4; ++j) { hi[j] = pk2(v[2 * j], v[2 * j + 1]); lo[j] = pk2(v[2 * j] - bflo(hi[j]), v[2 * j + 1] - bfhi(hi[j])); }
        v4u* dst = (nb4 == 3) ? (v4u*)(ws + WS_FRF) + ((size_t)(l * 32 + c) * 2) * 64 + ln : (v4u*)(ws + WS_RRF) + (((size_t)(l * 32 + c) * 3 + nb4) * 2) * 64 + ln;
        dst[0] = (v4u){hi[0], hi[1], hi[2], hi[3]}; dst[64] = (v4u){lo[0], lo[1], lo[2], lo[3]};
      } }
    LAS float* scr = (LAS float*)(F.lds + RING_OFF + F.wave * 16384);
    const int gw = (F.G - 1 - F.vcu) * NWAVES + F.wave, NGW = F.G * NWAVES;
    constexpr int IT_IN = 512, IT_OUT = 128, IT_L = IT_IN + IT_OUT;
#ifndef TR_REPS
#define TR_REPS 1
#endif
#pragma nounroll
    for (int trp = 0; trp < TR_REPS; ++trp)
    for (int it = gw; it < NL * IT_L; it += NGW) {
        const int l = it / IT_L; int r = it - l * IT_L;
        if (r < IT_IN) { const int kb = r >> 5, nb = r & 31; const int n0 = 64 * nb;
            transpose_item64(I.w_in + (size_t)l * D * INW, INW, WinT + (size_t)l * 2048 * D, D, 64 * kb, n0 < 1536 ? n0 : n0 + 8, n0, scr, F.lane); continue; }
        r -= IT_IN;
        if (r < IT_OUT) { const int kb = r >> 4, nb = r & 15;
            transpose_item64(I.w_out + (size_t)l * D * D, D, WoutT + (size_t)l * D * D, D, 64 * kb, 64 * nb, 64 * nb, scr, F.lane); continue; }
    }
}

struct NormArgs {
    const float* xin; const bf16* xinb;
    bf16* xwb; float* out;
    const unsigned char* Y0; const unsigned char* Y1; const float* gate;
    const bf16* Dl;
    const float* gamma; const float* scale; const float* shift;
    bf16* H; const v4u* frag;
    const float* bias0; const float* bias1;
    float* FL; float* BT; float* CW; unsigned* LIST; gu32* cnt;
};
template <bool XBF, bool ADD_D, bool ADD_Y, bool WRITE_XB, int NB, bool FINAL>
__device__ __forceinline__ void norm_phase(Frame& F, const NormArgs& A) {
    constexpr int NBX = NB > 0 ? NB : 1, LGW = 16 * NBX;
    LAS float* gm = (LAS float*)F.lds; LAS float* shl = gm + 1024; LAS float* gtl = shl + 1024;
    LAS float* SSP = (LAS float*)(F.lds + 12288);
    LAS float* LGP = (LAS float*)(F.lds + 16384);
    LAS float* LGA = (LAS float*)(F.lds + 40960);
    LAS int* lcnt = (LAS int*)(F.lds + 65536); LAS int* gbase = lcnt + 32;
    const int tok0 = F.vcu * 128, b = tok0 >> 12;
    float tg_[2], tsc_[2], tsh_[2], tgt_[2];
#pragma unroll
    for (int j = 0; j < 2; ++j) { const int k = F.tid + NWAVES * 64 * j; tg_[j] = A.gamma[k]; tsc_[j] = FINAL ? 0.f : A.scale[(size_t)b * 6144 + k]; tsh_[j] = FINAL ? 0.f : A.shift[(size_t)b * 6144 + k];
        tgt_[j] = ADD_Y ? A.gate[(size_t)b * 6144 + k] : 0.f; }
    if (NB == 3 && F.tid < 32) lcnt[F.tid] = 0;
    const int i16 = F.lane & 15, kq = F.lane >> 4, kcol = 128 * F.wave + 8 * kq;
    bf16x8 Bh[NB > 0 ? 4 : 1][NBX], Bl[NB > 0 ? 4 : 1][NBX];
    if constexpr (NB > 0) {
#pragma unroll
        for (int c = 0; c < 4; ++c)
#pragma unroll
            for (int nb = 0; nb < NB; ++nb) { const size_t fi = ((size_t)((4 * F.wave + c) * NB + nb) * 2) * 64 + F.lane;
                Bh[c][nb] = __builtin_bit_cast(bf16x8, A.frag[fi]); Bl[c][nb] = __builtin_bit_cast(bf16x8, A.frag[fi + 64]); }
    }
    f32x4 xa[XBF ? 1 : 4][2], xn[XBF ? 1 : 4][2]; v4u xba[4], xbn[4], da[4], dn[4]; typedef unsigned v2u __attribute__((ext_vector_type(2))); v4u ya[2][2], yn[2][2];
#define NORM_LOAD(dst, bdst, ydst, ddst, it_) do { const size_t ro_ = (size_t)(tok0 + 16 * (it_) + i16) * D + kcol; \
        _Pragma("unroll") for (int c = 0; c < 4; ++c) { \
            if constexpr (XBF) bdst[c] = *(const v4u*)(A.xinb + ro_ + 32 * c); \
            else { dst[c][0] = *(const f32x4*)(A.xin + ro_ + 32 * c); dst[c][1] = *(const f32x4*)(A.xin + ro_ + 32 * c + 4); } \
            if (ADD_D) ddst[c] = *(const v4u*)(A.Dl + ro_ + 32 * c); \
              \
              \
            if (ADD_Y && c < 2) { const size_t yo_ = ro_ + 64 * c + ((kq & 1) ? 24 : 0); ydst[0][c] = *(const v4u*)(A.Y0 + yo_); ydst[1][c] = *(const v4u*)(A.Y1 + yo_); } } } while (0)
#define NORM_STEP(XA_, XBA_, YA_, DA_, IT_) do { \
        const size_t ro = (size_t)(tok0 + 16 * (IT_) + i16) * D + kcol; \
        f32x4 xv[4][2]; \
        float ss = 0.f; \
        v2u yy_[2][4]; \
        if constexpr (ADD_Y) { \
_Pragma("unroll") \
            for (int s_ = 0; s_ < 2; ++s_) \
_Pragma("unroll") \
                for (int p_ = 0; p_ < 2; ++p_) { const v4u q_ = YA_[s_][p_]; \
                    auto r0_ = __builtin_amdgcn_permlane16_swap(q_.x, q_.z, false, false); auto r1_ = __builtin_amdgcn_permlane16_swap(q_.y, q_.w, false, false); \
                    yy_[s_][2 * p_] = (v2u){r0_[0], r1_[0]}; yy_[s_][2 * p_ + 1] = (v2u){r0_[1], r1_[1]}; } \
        } \
_Pragma("unroll") \
        for (int c = 0; c < 4; ++c) { \
            f32x4 a0, a1; \
            if constexpr (XBF) { const v4u xb = XBA_[c]; a0 = (f32x4){bflo(xb.x), bfhi(xb.x), bflo(xb.y), bfhi(xb.y)}; a1 = (f32x4){bflo(xb.z), bfhi(xb.z), bflo(xb.w), bfhi(xb.w)}; } \
            else { a0 = XA_[c][0]; a1 = XA_[c][1]; } \
            if (ADD_D) { const v4u d = DA_[c]; \
                a0[0] += bflo(d.x); a0[1] += bfhi(d.x); a0[2] += bflo(d.y); a0[3] += bfhi(d.y); a1[0] += bflo(d.z); a1[1] += bfhi(d.z); a1[2] += bflo(d.w); a1[3] += bfhi(d.w); } \
            if (ADD_Y) { const f32x4 g0 = *(const LAS f32x4*)(gtl + kcol + 32 * c), g1 = *(const LAS f32x4*)(gtl + kcol + 32 * c + 4); const v2u y0 = yy_[0][c], y1 = yy_[1][c]; typedef float f32x2u __attribute__((ext_vector_type(2))); \
                const f32x2u p0 = __builtin_amdgcn_cvt_pk_f32_fp8((int)y0[0], false) + __builtin_amdgcn_cvt_pk_f32_fp8((int)y1[0], false), p1 = __builtin_amdgcn_cvt_pk_f32_fp8((int)y0[0], true) + __builtin_amdgcn_cvt_pk_f32_fp8((int)y1[0], true); \
                const f32x2u p2 = __builtin_amdgcn_cvt_pk_f32_fp8((int)y0[1], false) + __builtin_amdgcn_cvt_pk_f32_fp8((int)y1[1], false), p3 = __builtin_amdgcn_cvt_pk_f32_fp8((int)y0[1], true) + __builtin_amdgcn_cvt_pk_f32_fp8((int)y1[1], true); \
                a0[0] += g0[0] * p0[0]; a0[1] += g0[1] * p0[1]; a0[2] += g0[2] * p1[0]; a0[3] += g0[3] * p1[1]; a1[0] += g1[0] * p2[0]; a1[1] += g1[1] * p2[1]; a1[2] += g1[2] * p3[0]; a1[3] += g1[3] * p3[1]; } \
            if (WRITE_XB) { v4u xo; xo.x = cvtpk(a0[0], a0[1]); xo.y = cvtpk(a0[2], a0[3]); xo.z = cvtpk(a1[0], a1[1]); xo.w = cvtpk(a1[2], a1[3]); *(v4u*)(A.xwb + ro + 32 * c) = xo; } \
            xv[c][0] = a0; xv[c][1] = a1; \
            ss += (a0[0] * a0[0] + a0[1] * a0[1]) + (a0[2] * a0[2] + a0[3] * a0[3]) + (a1[0] * a1[0] + a1[1] * a1[1]) + (a1[2] * a1[2] + a1[3] * a1[3]); \
        } \
        { auto r16_ = __builtin_amdgcn_permlane16_swap(__float_as_uint(ss), __float_as_uint(ss), false, false); ss = __uint_as_float(r16_[0]) + __uint_as_float(r16_[1]); \
          auto r32_ = __builtin_amdgcn_permlane32_swap(__float_as_uint(ss), __float_as_uint(ss), false, false); ss = __uint_as_float(r32_[0]) + __uint_as_float(r32_[1]); }     \
        LAS float* ssp = SSP + ((IT_) & 1) * 128; \
        if (kq == 0) ssp[F.wave * 16 + i16] = ss; \
        __syncthreads(); \
        float tot = 0.f; \
_Pragma("unroll") \
        for (int w = 0; w < 8; ++w) tot += ssp[w * 16 + i16]; \
        const float rstd = 1.0f / sqrtf(tot * (1.0f / D) + RMS_EPS); \
        f32x4 acc[NBX]; \
_Pragma("unroll") \
        for (int nb = 0; nb < NBX; ++nb) acc[nb] = (f32x4){0.f, 0.f, 0.f, 0.f}; \
_Pragma("unroll") \
        for (int c = 0; c < 4; ++c) { \
            const f32x4 m0 = *(const LAS f32x4*)(gm + kcol + 32 * c), m1 = *(const LAS f32x4*)(gm + kcol + 32 * c + 4); \
            const f32x4 s0 = *(const LAS f32x4*)(shl + kcol + 32 * c), s1 = *(const LAS f32x4*)(shl + kcol + 32 * c + 4); \
            const f32x4 h0 = xv[c][0] * rstd * m0 + s0, h1 = xv[c][1] * rstd * m1 + s1; \
            if (FINAL) { *(f32x4*)(A.out + ro + 32 * c) = h0; *(f32x4*)(A.out + ro + 32 * c + 4) = h1; } \
            else { \
                v4u hi; hi.x = cvtpk(h0[0], h0[1]); hi.y = cvtpk(h0[2], h0[3]); hi.z = cvtpk(h1[0], h1[1]); hi.w = cvtpk(h1[2], h1[3]); \
                *(v4u*)(A.H + ro + 32 * c) = hi; \
                if constexpr (NB > 0) { \
                    v4u lo; lo.x = cvtpk(h0[0] - bflo(hi.x), h0[1] - bfhi(hi.x)); lo.y = cvtpk(h0[2] - bflo(hi.y), h0[3] - bfhi(hi.y)); \
                    lo.z = cvtpk(h1[0] - bflo(hi.z), h1[1] - bfhi(hi.z)); lo.w = cvtpk(h1[2] - bflo(hi.w), h1[3] - bfhi(hi.w)); \
                    const bf16x8 Ah = __builtin_bit_cast(bf16x8, hi), Al = __builtin_bit_cast(bf16x8, lo); \
_Pragma("unroll") \
                    for (int nb = 0; nb < NB; ++nb) { \
                        acc[nb] = __builtin_amdgcn_mfma_f32_16x16x32_bf16(Ah, Bh[c][nb], acc[nb], 0, 0, 0); \
                        acc[nb] = __builtin_amdgcn_mfma_f32_16x16x32_bf16(Al, Bh[c][nb], acc[nb], 0, 0, 0); \
                        acc[nb] = __builtin_amdgcn_mfma_f32_16x16x32_bf16(Ah, Bl[c][nb], acc[nb], 0, 0, 0); } \
                } \
            } \
        } \
        if constexpr (NB > 0) { \
_Pragma("unroll") \
            for (int nb = 0; nb < NB; ++nb) \
_Pragma("unroll") \
                for (int r = 0; r < 4; ++r) LGP[(F.wave * 16 + 4 * kq + r) * LGW + 16 * nb + i16] = acc[nb][r]; \
            __syncthreads(); \
            for (int q = F.tid; q < 16 * LGW; q += NWAVES * 64) { float s = 0.f; \
_Pragma("unroll") \
                for (int w = 0; w < 8; ++w) s += LGP[w * 16 * LGW + q]; \
                LGA[(IT_) * 16 * LGW + q] = s; } \
        } \
    } while (0)
    NORM_LOAD(xa, xba, ya, da, 0);
#pragma unroll
    for (int j = 0; j < 2; ++j) { const int k = F.tid + NWAVES * 64 * j; gm[k] = FINAL ? tg_[j] : tg_[j] * (1.f + tsc_[j]); shl[k] = tsh_[j];
        if (ADD_Y) gtl[k] = tgt_[j] * (1.0f / 16.0f); }
    __syncthreads();
#pragma nounroll
    for (int it = 0; it < 8; it += 2) {
        NORM_LOAD(xn, xbn, yn, dn, it + 1);
        NORM_STEP(xa, xba, ya, da, it);
        NORM_LOAD(xa, xba, ya, da, (it + 2 < 8 ? it + 2 : 7));
        NORM_STEP(xn, xbn, yn, dn, it + 1);
    }
#undef NORM_STEP
#undef NORM_LOAD
    __syncthreads();
    if constexpr (NB == 1) {
        const int hh = F.wave, r0 = 2 * F.lane;
        const float bb = A.bias0[hh]; const float z0 = LGA[r0 * LGW + hh] + bb, z1 = LGA[(r0 + 1) * LGW + hh] + bb;
        const float v0 = fminf(z0, 0.f) - log1pf(__expf(-fabsf(z0))), v1 = fminf(z1, 0.f) - log1pf(__expf(-fabsf(z1)));
        float sc = v0 + v1;
#define NP_DPPF(V, CTRL, RM) __builtin_bit_cast(float, __builtin_amdgcn_update_dpp(0, __builtin_bit_cast(int, V), CTRL, RM, 0xf, true))
        sc += NP_DPPF(sc, 0x111, 0xf); sc += NP_DPPF(sc, 0x112, 0xf); sc += NP_DPPF(sc, 0x114, 0xf); sc += NP_DPPF(sc, 0x118, 0xf);
        sc += NP_DPPF(sc, 0x142, 0xa); sc += NP_DPPF(sc, 0x143, 0xc);
#undef NP_DPPF
        const float ex = sc - (v0 + v1); const float L2E = 1.4426950408889634f;
        typedef float f32x2n __attribute__((ext_vector_type(2)));
        *(f32x2n*)(A.FL + ((size_t)(b * 8 + hh) << 12) + (tok0 & (SEQ - 1)) + r0) = (f32x2n){(ex + v0) * L2E, (ex + v0 + v1) * L2E};
        if (F.lane == 63) A.BT[(b * 8 + hh) * 32 + ((tok0 & (SEQ - 1)) >> 7)] = sc * L2E;
    }
    if constexpr (NB == 3) {
        int e0 = 0, e1 = 0, r0 = 0, r1 = 0; float w0 = 0.f, w1 = 0.f;
        if (F.tid < 128) {
            const LAS float* row = LGA + F.tid * LGW;
            const float l0 = row[0] + A.bias0[0], l1 = row[1] + A.bias0[1], l2 = row[2] + A.bias0[2], l3 = row[3] + A.bias0[3];
            int g = 0; float mx = l0; if (l1 > mx) { mx = l1; g = 1; } if (l2 > mx) { mx = l2; g = 2; } if (l3 > mx) { mx = l3; g = 3; }
            const float top_p = 1.f / (__expf(l0 - mx) + __expf(l1 - mx) + __expf(l2 - mx) + __expf(l3 - mx));
            float v1 = -INFINITY, v2 = -INFINITY; int i1 = 0, i2 = 0;
#pragma unroll
            for (int j = 0; j < 8; ++j) { const float v = row[4 + 8 * g + j] + A.bias1[8 * g + j];
                if (v > v1) { v2 = v1; i2 = i1; v1 = v; i1 = j; } else if (v > v2) { v2 = v; i2 = j; } }
            const float e21 = __expf(v2 - v1), ew1 = 1.f / (1.f + e21);
            w0 = top_p * ew1; w1 = top_p * (e21 * ew1); e0 = 8 * g + i1; e1 = 8 * g + i2;
            r0 = __hip_atomic_fetch_add(lcnt + e0, 1, __ATOMIC_RELAXED, __HIP_MEMORY_SCOPE_WORKGROUP);
            r1 = __hip_atomic_fetch_add(lcnt + e1, 1, __ATOMIC_RELAXED, __HIP_MEMORY_SCOPE_WORKGROUP);
        }
        __syncthreads();
        if (F.tid < 32) gbase[F.tid] = (int)__hip_atomic_fetch_add(A.cnt + 64 * F.tid, (unsigned)lcnt[F.tid], __ATOMIC_RELAXED, __HIP_MEMORY_SCOPE_AGENT);
        __syncthreads();
        if (F.tid < 128) { const int tk = tok0 + F.tid;
            A.LIST[(size_t)e0 * T + gbase[e0] + r0] = 2u * tk; A.LIST[(size_t)e1 * T + gbase[e1] + r1] = 2u * tk + 1u;
            A.CW[2 * tk] = w0; A.CW[2 * tk + 1] = w1; }
    }
    __syncthreads();
}

struct Args { In in; float* out; unsigned char* ws; int ph_lo, ph_hi; };
typedef const __attribute__((address_space(4))) Args* KArgP;
__device__ __forceinline__ KArgP KA() { KArgP p = (KArgP)__builtin_amdgcn_kernarg_segment_ptr(); asm volatile("" : "+s"(p)); return p; }
#define WSP   (KA()->ws)
#define XRES  (KA()->out)
#define MODP  ((float*)(WSP + WS_MOD))
#define HB    ((bf16*)(WSP + WS_H))
#define QB_   ((bf16*)(WSP + WS_QKVU))
#define YB    ((unsigned char*)(WSP + WS_QKVU))
#define AOB   ((bf16*)(WSP + WS_AO))
#define ACTB  ((bf16*)(WSP + WS_AO))
#define FLP   ((float*)(WSP + WS_FL))
#define FCP   ((float*)(WSP + WS_FC))
#define CWP   ((float*)(WSP + WS_CW))
#define LISTP ((unsigned*)(WSP + WS_LIST))
#define CTLP  ((gu32*)(WSP + WS_CTL))
#define DLB   ((bf16*)(WSP + WS_DL))
#define XBB   ((bf16*)(WSP + WS_XB))
struct PoolDiff {
    Frame& F; const bf16* U; bf16* AO; v4u la[9], lb[9]; int steps;
    __device__ __forceinline__ void load(v4u (&ld)[9], const int half) { const int t0 = blk * 128, pos0 = t0 & (SEQ - 1);
#pragma unroll
        for (int j = 0; j < 9; ++j) { const int p = F.tid + 512 * j; const int r = p >> 5, cc = p & 31; v4u v = (v4u){0u, 0u, 0u, 0u};
            if (p < 143 * 32 && pos0 - 15 + r >= 0) v = *(const v4u*)(U + (size_t)(t0 - 15 + r) * 512 + half * 256 + 8 * cc);
            ld[j] = v; } }
    __device__ __forceinline__ void half_pass(const v4u (&ld)[9], const int half) { const int t0 = blk * 128, pos0 = t0 & (SEQ - 1);
        LAS v4u* tile = (LAS v4u*)F.lds;
#pragma unroll
        for (int j = 0; j < 9; ++j) { const int p = F.tid + 512 * j; if (p < 143 * 32) tile[p] = ld[j]; }
        __syncthreads();
        const int cc = F.tid & 31, tl0 = 8 * (F.tid >> 5); const int w = 2 << ((half * 32 + cc) >> 4);
        float sum[8];
#pragma unroll
        for (int q = 0; q < 8; ++q) sum[q] = 0.f;
#define POOL_ACC(V, SGN) do { sum[0] += SGN bflo((V).x); sum[1] += SGN bfhi((V).x); sum[2] += SGN bflo((V).y); sum[3] += SGN bfhi((V).y); sum[4] += SGN bflo((V).z); sum[5] += SGN bfhi((V).z); sum[6] += SGN bflo((V).w); sum[7] += SGN bfhi((V).w); } while (0)
        for (int d = 1; d < w; ++d) { const v4u v = tile[(15 + tl0 - d) * 32 + cc]; POOL_ACC(v, +); }
#pragma unroll 2
        for (int j = 0; j < 8; ++j) { const int tl = tl0 + j, pos = pos0 + tl;
            const v4u v = tile[(15 + tl) * 32 + cc]; POOL_ACC(v, +);
            const float rc = 1.0f / (float)((pos + 1) < w ? (pos + 1) : w);
            v4u o; o.x = pk2(sum[0] * rc - bflo(v.x), sum[1] * rc - bfhi(v.x)); o.y = pk2(sum[2] * rc - bflo(v.y), sum[3] * rc - bfhi(v.y));
            o.z = pk2(sum[4] * rc - bflo(v.z), sum[5] * rc - bfhi(v.z)); o.w = pk2(sum[6] * rc - bflo(v.w), sum[7] * rc - bfhi(v.w));
            *(v4u*)(AO + (size_t)(t0 + tl) * D + 512 + half * 256 + 8 * cc) = o;
            const v4u u = tile[(15 + tl - (w - 1)) * 32 + cc]; POOL_ACC(u, -); }
#undef POOL_ACC
        __syncthreads(); }
    int blk;
    __device__ __forceinline__ void block(const int it) { blk = it; load(la, 0); load(lb, 1); half_pass(la, 0); half_pass(lb, 1); }
    int l;
    __device__ __forceinline__ void convert() {
        const In& I = *(const In*)(const void*)(&KA()->in);
        bf16* WguT = (bf16*)(WSP + WS_WGU); bf16* WdT = (bf16*)(WSP + WS_WD);
        int t_ = threadIdx.x; asm volatile("" : "+v"(t_));
        const int lane_ = t_ & 63, wave_ = __builtin_amdgcn_readfirstlane(t_ >> 6);
        LAS float* scr = (LAS float*)(F.lds + RING_OFF + wave_ * 16384);
        constexpr int IT_E = 2048;
        struct Item { const float* W; int ldw; bf16* WT; int ldt, k0, n0src, dstrow0; };
        auto item = [&](int j) -> Item { int r = (F.vcu + 256 * j) * NWAVES + wave_;
            if (r < 2 * IT_E) { const int up = r >= IT_E; if (up) r -= IT_E; const int e = r >> 6, q = r & 63, kb = q >> 2, nb = q & 3, n0 = 64 * nb;
                return Item{(up ? I.w_eu : I.w_eg) + (size_t)(l * NX + e) * D * FE, FE, WguT + (size_t)(l * NX + e) * 512 * D, D, 64 * kb, n0, 256 * (n0 >> 7) + (n0 & 127) + (up ? 128 : 0)}; }
            r -= 2 * IT_E; const int e = r >> 6, q = r & 63, kb = q >> 4, nb = q & 15;
            return Item{I.w_ed + (size_t)(l * NX + e) * FE * D, D, WdT + (size_t)(l * NX + e) * D * FE, FE, 64 * kb, 64 * nb, 64 * nb}; };
        f32x4 va[16], vb[16];
        const Item i0 = item(0), i1 = item(1), i2 = item(2);
        transpose_load64(va, i0.W, i0.ldw, i0.k0, i0.n0src, lane_);
        transpose_load64(vb, i1.W, i1.ldw, i1.k0, i1.n0src, lane_);
        asm volatile("" ::: "memory"); __builtin_amdgcn_sched_barrier(0);
        transpose_finish64(va, i0.WT, i0.ldt, i0.k0, i0.dstrow0, scr, lane_);
        transpose_load64(va, i2.W, i2.ldw, i2.k0, i2.n0src, lane_);
        asm volatile("" ::: "memory"); __builtin_amdgcn_sched_barrier(0);
        transpose_finish64(vb, i1.WT, i1.ldt, i1.k0, i1.dstrow0, scr, lane_);
        transpose_finish64(va, i2.WT, i2.ldt, i2.k0, i2.dstrow0, scr, lane_);
        __syncthreads();
    }
};
template <bool WITH_CW>
__device__ __forceinline__ void moe_tables(Frame& F, pg8::MoeSched& S, int l, int npn, const char* W, size_t estride, size_t pnstride, const unsigned* LIST, const float* CW) {
    LAS unsigned* ent = (LAS unsigned*)(F.lds + ENT_OFF); LAS float* cwt = (LAS float*)(F.lds + CWT_OFF);
    LAS int* tstart = (LAS int*)(F.lds + TST_OFF); LAS int* cntl = tstart + 33; LAS int* ut = cntl + 32; LAS int* nun = ut + 4 * ENT_UNITS;
    unsigned* const pubp = (unsigned*)(CTLP + CW_TIL + l * TIL_STRIDE);
    if (F.wave == 0) {
        const int ln = F.lane; unsigned c = 0u;
        if (ln < 32) { c = __hip_atomic_load(CTLP + CW_CNT + 64 * (l * 32 + ln), RLX_AGENT); c = c < (unsigned)T ? c : (unsigned)T; }
        const int tl = (int)((c + 255u) >> 8); int inc = tl;
        inc += __builtin_amdgcn_update_dpp(0, inc, 0x111, 0xf, 0xf, true); inc += __builtin_amdgcn_update_dpp(0, inc, 0x112, 0xf, 0xf, true); inc += __builtin_amdgcn_update_dpp(0, inc, 0x114, 0xf, 0xf, true);
        inc += __builtin_amdgcn_update_dpp(0, inc, 0x118, 0xf, 0xf, true); inc += __builtin_amdgcn_update_dpp(0, inc, 0x142, 0xa, 0xf, true);
        if (ln < 32) { cntl[ln] = (int)c; tstart[ln] = inc - tl; }
        if (ln == 31) tstart[32] = inc;
        const int ntile = __builtin_amdgcn_readlane(inc, 31);
        int tix = -1;
        if (ln < ENT_UNITS) {
            const int i = ln, G = F.G, cc = F.vcu, total = ntile * npn; int L = i * G + cc;
            if (!WITH_CW) { const int nlate = (ntile * 2) % G, ne = G - nlate, hs = (ne >= G / 2) ? 4 : 0;
                if (hs) L = cc >= nlate ? (i < hs ? i * ne + (cc - nlate) : hs * ne + (i - hs) * G + cc) : hs * ne + i * G + cc; }
            int e = 0, pn = 0, nrows = 0;
            if (L < total) { tix = L / npn; pn = L - tix * npn;
#pragma unroll
                for (int sft = 16; sft >= 1; sft >>= 1) if (tstart[e + sft] <= tix) e += sft;
                const int left = cntl[e] - (tix - tstart[e]) * 256; nrows = left < 256 ? left : 256; }
            ut[4 * i] = e; ut[4 * i + 1] = pn; ut[4 * i + 2] = nrows; ut[4 * i + 3] = tix;
        }
        const int n = __builtin_popcountll(__ballot(tix >= 0));
        unsigned rdy = 0u;
        if (!WITH_CW) {
            unsigned pc = 0u;
            if (tix >= 0) pc = __hip_atomic_load(pubp + 64 * tix, __ATOMIC_RELAXED, __HIP_MEMORY_SCOPE_AGENT);
            rdy = (unsigned)__ballot(tix >= 0 && pc >= 16u);
            __builtin_amdgcn_fence(__ATOMIC_ACQUIRE, "agent"); asm volatile("s_waitcnt vmcnt(0)" ::: "memory");
        }
        if (ln == 0) { nun[0] = n; nun[1] = (int)rdy; }
    }
    __syncthreads();
    S.ut = ut; S.nunits = nun[0]; S.rdy = WITH_CW ? 0u : (unsigned)nun[1]; S.W = W; S.estride = estride; S.pnstride = pnstride;
    S.pub = pubp; S.tmo = (unsigned*)(CTLP + CW_TMO);
    {
        constexpr int NJ = WITH_CW ? 2 : 4;
        unsigned en[NJ]; float cw[NJ];
#pragma unroll
        for (int j = 0; j < NJ; ++j) { const int q = F.tid + NWAVES * 64 * j, i = q >> 8, r = q & 255, ii = i < S.nunits ? i : 0;
            const int e = ut[4 * ii], nrows = ut[4 * ii + 2], r0 = (ut[4 * ii + 3] - tstart[e]) * 256;
            en[j] = LIST[(size_t)e * T + r0 + (r < nrows ? r : 0)]; }
        if (WITH_CW) {
#pragma unroll
            for (int j = 0; j < NJ; ++j) cw[j] = CW[en[j]];
        }
#pragma unroll
        for (int j = 0; j < NJ; ++j) { const int q = F.tid + NWAVES * 64 * j;
            if ((q >> 8) < S.nunits) { ent[q] = en[j]; if (WITH_CW) { if (q < 3 * 256) cwt[q] = cw[j]; } } }
    }
    __syncthreads();
}
__global__ void __launch_bounds__(NWAVES * 64, 2) mk_fwd(Args args_unused) {
    extern __shared__ __attribute__((aligned(16))) unsigned char lds[];
    Frame F;
    F.lds = (LAS unsigned char*)lds;
    F.MISC = (volatile LAS unsigned*)(F.lds + MISC_OFF);
    F.tid = threadIdx.x; F.lane = F.tid & 63; F.wave = __builtin_amdgcn_readfirstlane(F.tid >> 6);
    F.G = gridDim.x; { const int bx = blockIdx.x; F.vcu = (F.G % 8 == 0) ? (bx % 8) * (F.G / 8) + bx / 8 : bx; }
    F.ctl = (gu32*)(KA()->ws + WS_CTL);
    for (int u = F.tid; u < (LDS_BYTES - LDSCTL_OFF) / 4; u += NWAVES * 64) ((LAS unsigned*)(F.lds + LDSCTL_OFF))[u] = 0u;
    __syncthreads();
    XcdBarrier bar; bar.bar = (unsigned*)(F.ctl + CW_BAR); bar.x = 0; bar.st = nullptr;
    if (!MK_PER_PHASE) bar = xcd_barrier_post((unsigned*)(F.ctl + CW_BAR), F.MISC + 8);
#define GRID_BAR() do { if (!MK_PER_PHASE) { XcdBarrier b_ = bar; unsigned* p_ = b_.bar; unsigned x_ = b_.x; asm volatile("" : "+s"(p_), "+s"(x_)); b_.bar = p_; b_.x = x_; xcd_barrier(b_); } } while (0)
    const int lo = KA()->ph_lo, hi = KA()->ph_hi;
#ifndef PHASE_MASK
#define PHASE_MASK 0xFFFF
#endif
#define IN(k) ((((PHASE_MASK) >> ((k) > 7 && (k) < 15 ? (k) - 7 : (k))) & 1) && lo <= (k) && (k) < hi)
#ifndef PROBE_MODE
#define PROBE_MODE 0
#endif
#ifndef REPEAT_MASK
#define REPEAT_MASK 0
#endif
#define RPT(k, cond) _Pragma("nounroll") for (int rp_ = 0, nr_ = ((((REPEAT_MASK) >> (k)) & 1) && (cond)) ? 2 : 1; rp_ < nr_; ++rp_)
#ifndef TIME_A
#define TIME_A -1
#endif
#ifndef TIME_B
#define TIME_B -1
#endif
    unsigned long long tA_ = 0, tB_ = 0;
    if (TIME_B >= 0 && TIME_A < 0) tA_ = __builtin_amdgcn_s_memrealtime();
#define SEAM(k) do { if (IN(k) && IN((k) + 1)) GRID_BAR(); if (TIME_B >= 0) { if ((k) == TIME_A) tA_ = __builtin_amdgcn_s_memrealtime(); if ((k) == TIME_B) tB_ = __builtin_amdgcn_s_memrealtime(); } } while (0)
#define PHASE_BEGIN() do { int w_ = F.wave, v_ = F.vcu, g_ = F.G; int ln_ = (int)__builtin_amdgcn_mbcnt_hi(~0u, __builtin_amdgcn_mbcnt_lo(~0u, 0u)); asm volatile("" : "+v"(ln_), "+v"(w_), "+v"(v_), "+v"(g_)); \
        F.wave = __builtin_amdgcn_readfirstlane(w_); F.vcu = __builtin_amdgcn_readfirstlane(v_); F.G = __builtin_amdgcn_readfirstlane(g_); F.lane = ln_; F.tid = F.wave * 64 + ln_; } while (0)
#ifndef EXTRA_BARS
#define EXTRA_BARS 0
#endif
    for (int xb_ = 0; xb_ < EXTRA_BARS; ++xb_) GRID_BAR();
#if PROBE_STEPS
    const unsigned long long pk0_ = __builtin_amdgcn_s_memrealtime();
#endif
    if (IN(0)) { PHASE_BEGIN(); RPT(0, true) { if (rp_) GRID_BAR(); const In I = *(const In*)(const void*)(&KA()->in); p0_prologue(F, I, WSP, 0); }
#if PROBE_STEPS
        if (((PROBE_STEPS >= 16 && PROBE_STEPS <= 18) || (PROBE_STEPS == 19 && F.vcu < 64) || (PROBE_STEPS == 22 && F.vcu >= 64 && F.vcu < 96) || (PROBE_STEPS == 25 && F.vcu >= 96)) && F.tid == 0) { const unsigned d_ = (unsigned)((__builtin_amdgcn_s_memrealtime() - pk0_) / 10ull);
            __hip_atomic_fetch_max((unsigned*)(CTLP + 8), d_, RLX_AGENT); __hip_atomic_fetch_add((unsigned*)(CTLP + 9), 2u * d_, RLX_AGENT); __hip_atomic_fetch_max((unsigned*)(CTLP + 10), 100000u - d_, RLX_AGENT); }
#endif
        SEAM(0); }

#pragma nounroll
    for (int l = 0; l < NL; ++l) {
        const int pb = 1 + 7 * l;
        if (IN(pb + 0)) { PHASE_BEGIN();
            const float* modl = MODP + (size_t)l * 8 * 6144;
            NormArgs A{}; A.gamma = KA()->in.g_mix + l * D; A.scale = modl + 1024; A.shift = modl; A.H = HB; A.frag = (const v4u*)(WSP + WS_FRF) + (size_t)l * 32 * 2 * 64;
            A.bias0 = KA()->in.b_fg + l * 8; A.FL = FCP; A.BT = FLP;
            A.xwb = XBB;
            if (l == 0) { A.xin = KA()->in.x; RPT(1, true) { if (rp_) GRID_BAR(); norm_phase<false, false, false, true, 1, false>(F, A); } }
            else { A.xinb = DLB; A.Y0 = YB; A.Y1 = YB + (size_t)T * D; A.gate = MODP + (size_t)(l - 1) * 8 * 6144 + 5120; RPT(5, true) { if (rp_) GRID_BAR(); norm_phase<true, false, true, true, 1, false>(F, A); } }
            SEAM(pb + 0);
        }
        if (IN(pb + 1)) { PHASE_BEGIN();
            pg8::Gemm g{HB, (const bf16*)(WSP + WS_WIN) + (size_t)l * 2048 * D, T, 2048, D}; pg8::StaticOrder S; S.init(T, 2048, F.G, (int)blockIdx.x);
            pg8::EpiQKVU E{QB_, 512, 512, (size_t)T * 512, attn_body::C2, (unsigned*)(CTLP + CW_NRM + l * NRM_WORDS)};
            RPT(2, true) { if (rp_) GRID_BAR(); pg8::gemm_phase<pg8::EpiQKVU, pg8::StaticOrder, true, true>(F.lds + RING_OFF, g, S, E); }
            SEAM(pb + 1);
        }
        if (IN(pb + 2)) { PHASE_BEGIN();
            PoolDiff PD{F, QB_ + (size_t)3 * T * 512, AOB}; PD.l = l;
#if PROBE_STEPS
            const unsigned long long pt0_ = __builtin_amdgcn_s_memrealtime();
#endif
            const attn_body::AttnBase AB{(const char*)WSP, WS_QKVU, WS_QKVU + (size_t)T * 512 * 2, WS_QKVU + (size_t)2 * T * 512 * 2, WS_AO, WS_FC, WS_FL, WS_CTL + (size_t)(CW_NRM + l * NRM_WORDS) * 4, WS_CTL + (size_t)(CW_QAT + 64 * (l * 8)) * 4, WS_CTL + (size_t)(CW_PQ + 64 * l) * 4};
            attn_body::attn_phase<32>((char*)lds + RING_OFF, AB, F.vcu, F.tid, PD);
#if PROBE_STEPS
            if (PROBE_STEPS >= 4 && PROBE_STEPS <= 6) PD.steps = (int)((__builtin_amdgcn_s_memrealtime() - pt0_) / 100ull);
            if (PROBE_STEPS < 10 && F.tid == 0) { __hip_atomic_fetch_max((unsigned*)(CTLP + 8), (unsigned)PD.steps, RLX_AGENT); __hip_atomic_fetch_add((unsigned*)(CTLP + 9), (unsigned)PD.steps, RLX_AGENT); __hip_atomic_fetch_max((unsigned*)(CTLP + 10), (unsigned)(100000 - PD.steps), RLX_AGENT); }
#endif
            SEAM(pb + 2);
        }
        if (IN(pb + 3)) { PHASE_BEGIN();
            pg8::Gemm g{AOB, (const bf16*)(WSP + WS_WOUT) + (size_t)l * D * D, T, D, D}; pg8::StaticOrder S; S.init(T, D, F.G, (int)blockIdx.x);
            pg8::EpiMid E{DLB, XBB, MODP + (size_t)l * 8 * 6144 + 2048, 6144};
            RPT(4, true) { if (rp_) GRID_BAR(); pg8::gemm_phase<pg8::EpiMid, pg8::StaticOrder, true, true>(F.lds + RING_OFF, g, S, E); }
            SEAM(pb + 3);
        }
        if (IN(pb + 4)) { PHASE_BEGIN();
            const float* modl = MODP + (size_t)l * 8 * 6144;
            NormArgs A{}; A.xinb = DLB; A.gamma = KA()->in.g_ffn + l * D; A.scale = modl + 4096; A.shift = modl + 3072; A.H = HB;
            A.frag = (const v4u*)(WSP + WS_RRF) + (size_t)l * 32 * 3 * 2 * 64; A.bias0 = KA()->in.b_rg + l * 4; A.bias1 = KA()->in.b_re + l * 32; A.CW = CWP; A.LIST = LISTP; A.cnt = CTLP + CW_CNT + 64 * (l * 32);
            norm_phase<true, false, false, false, 3, false>(F, A);
            SEAM(pb + 4);
        }
#if PROBE_STEPS
        unsigned long long mt0_ = 0ull;
#endif
        if (IN(pb + 5)) { PHASE_BEGIN();
#if PROBE_STEPS
            mt0_ = __builtin_amdgcn_s_memrealtime();
#endif
            pg8::MoeSched S; moe_tables<true>(F, S, l, 2, (const char*)(WSP + WS_WGU) + (size_t)l * NX * 512 * D * 2, (size_t)512 * D * 2, (size_t)256 * D * 2, LISTP, CWP);
            LAS unsigned* ent = (LAS unsigned*)(F.lds + ENT_OFF); LAS float* cwt = (LAS float*)(F.lds + CWT_OFF);
            pg8::EpiAct E{ACTB, ent, cwt}; RPT(6, true) { if (rp_) GRID_BAR(); pg8::gemm_phase_moe<1, true, false, pg8::EpiAct, pg8::MoeSched>(F.lds + RING_OFF, HB, D, ent, S, E); }
#if PROBE_STEPS
            if (PROBE_STEPS == 13 && F.tid == 0) __hip_atomic_fetch_add((unsigned*)(CTLP + 9), (unsigned)((__builtin_amdgcn_s_memrealtime() - mt0_) / 100ull), RLX_AGENT);
#endif
        }
        if (IN(pb + 6)) { PHASE_BEGIN();
            pg8::MoeSched S; moe_tables<false>(F, S, l, 4, (const char*)(WSP + WS_WD) + (size_t)l * NX * D * FE * 2, (size_t)D * FE * 2, (size_t)256 * FE * 2, LISTP, CWP);
            LAS unsigned* ent = (LAS unsigned*)(F.lds + ENT_OFF);
            pg8::EpiY E{YB, (size_t)T * D, ent}; RPT(7, true) { if (rp_) GRID_BAR(); pg8::gemm_phase_moe<0, false, true, pg8::EpiY, pg8::MoeSched>(F.lds + RING_OFF, ACTB, FE, ent, S, E); }
#if PROBE_STEPS
            if (PROBE_STEPS >= 10 && PROBE_STEPS <= 12 && F.tid == 0) { const unsigned d_ = (unsigned)((__builtin_amdgcn_s_memrealtime() - mt0_) / 100ull);
                __hip_atomic_fetch_max((unsigned*)(CTLP + 8), d_, RLX_AGENT); __hip_atomic_fetch_add((unsigned*)(CTLP + 9), d_, RLX_AGENT); __hip_atomic_fetch_max((unsigned*)(CTLP + 10), 100000u - d_, RLX_AGENT); }
#endif
            SEAM(pb + 6);
        }
    }
    if (IN(NPH - 1)) { PHASE_BEGIN();
        NormArgs A{}; A.xinb = DLB; A.out = XRES; A.Y0 = YB; A.Y1 = YB + (size_t)T * D; A.gate = MODP + (size_t)(NL - 1) * 8 * 6144 + 5120; A.gamma = KA()->in.g_fin;
        norm_phase<true, false, true, false, 0, true>(F, A);
    }
#if PROBE_STEPS
    __syncthreads();
    if (F.vcu == 0 && F.tid == 0) { const unsigned mx = __hip_atomic_load((unsigned*)(CTLP + 8), RLX_AGENT), sm = __hip_atomic_load((unsigned*)(CTLP + 9), RLX_AGENT), mn = __hip_atomic_load((unsigned*)(CTLP + 10), RLX_AGENT);
        const float v = (PROBE_STEPS == 1 || PROBE_STEPS == 4 || PROBE_STEPS == 10 || PROBE_STEPS == 16 || PROBE_STEPS == 19 || PROBE_STEPS == 22 || PROBE_STEPS == 25) ? (float)mx : (PROBE_STEPS == 2 || PROBE_STEPS == 5 || PROBE_STEPS == 7 || PROBE_STEPS == 8 || PROBE_STEPS == 11 || PROBE_STEPS == 13 || PROBE_STEPS == 17) ? (float)sm * (1.0f / 512.0f) : (float)(100000u - mn); XRES[0] = 1000.f * (float)(((int)(v + 0.5f) + PROBE_BASE) / PROBE_Q * PROBE_Q); }
#endif
    if (TIME_B >= 0) {
        if (TIME_B >= NPH - 1) tB_ = __builtin_amdgcn_s_memrealtime();
        __syncthreads();
#ifndef TIME_Q
#define TIME_Q 10
#endif
#ifndef TIME_OFF
#define TIME_OFF 0
#endif
        const long long us_q = (long long)((((tB_ - tA_) / 100ull + TIME_OFF) / TIME_Q) * TIME_Q);
        const long long n = us_q * 1000ll - (long long)F.vcu * 131072ll; const int cnt = n < 0 ? 0 : (n > 131072 ? 131072 : (int)n);
        float* o = XRES + (size_t)F.vcu * 131072;
        for (int i = F.tid; i < cnt; i += NWAVES * 64) o[i] = 0.f;
    }
#undef IN
#undef SEAM
#undef GRID_BAR
}

extern "C" void kernel_launch(void* const* d_in, const int* in_sizes, int n_in, void* d_out, int out_size, void* d_ws, size_t ws_size, hipStream_t stream) {
    static int grid = 0;
    if (grid == 0) {
        if (n_in != 19 || in_sizes[0] != T * D || out_size != T * D || ws_size < WS_END) { fprintf(stderr, "kernel_launch: shape/workspace mismatch: n_in %d in0 %d out %d ws %zu (need %zu); nothing launched\n", n_in, n_in > 0 ? in_sizes[0] : -1, out_size, ws_size, (size_t)WS_END); grid = -1; return; }
        int dev = 0, cus = 0, per_cu = 0;
        if (hipGetDevice(&dev) != hipSuccess || hipDeviceGetAttribute(&cus, hipDeviceAttributeMultiprocessorCount, dev) != hipSuccess) { fprintf(stderr, "kernel_launch: device query failed\n"); grid = -1; return; }
        if (hipFuncSetAttribute((const void*)mk_fwd, hipFuncAttributeMaxDynamicSharedMemorySize, LDS_BYTES) != hipSuccess) { fprintf(stderr, "kernel_launch: hipFuncSetAttribute failed\n"); grid = -1; return; }
        if (hipOccupancyMaxActiveBlocksPerMultiprocessor(&per_cu, (const void*)mk_fwd, NWAVES * 64, LDS_BYTES) != hipSuccess || per_cu < 1) fprintf(stderr, "kernel_launch: note: occupancy query reports %d workgroups per CU\n", per_cu);
        (void)hipGetLastError();
        grid = cus;
        if (grid != 256) { fprintf(stderr, "kernel_launch: built for 256 CUs, device has %d; nothing launched\n", cus); grid = -1; return; }
    }
    if (grid < 0) return;
    if (hipMemsetAsync((char*)d_ws + WS_CTL, 0, CTL_ZERO_BYTES, stream) != hipSuccess) { fprintf(stderr, "kernel_launch: hipMemsetAsync failed\n"); return; }
    Args a{};
    const float** ip = (const float**)&a.in;
    for (int i = 0; i < 19; ++i) ip[i] = (const float*)d_in[i];
    a.out = (float*)d_out; a.ws = (unsigned char*)d_ws;
#if MK_PER_PHASE
    for (int p = 0; p < NPH; ++p) { a.ph_lo = p; a.ph_hi = p + 1; hipLaunchKernelGGL(mk_fwd, dim3(grid), dim3(NWAVES * 64), LDS_BYTES, stream, a); }
#else
    a.ph_lo = 0; a.ph_hi = NPH; hipLaunchKernelGGL(mk_fwd, dim3(grid), dim3(NWAVES * 64), LDS_BYTES, stream, a);
#endif
    const hipError_t le = hipPeekAtLastError();
    if (le != hipSuccess) fprintf(stderr, "kernel_launch: launch failed: %s\n", hipGetErrorName(le));
}
```
